# Optimizing an MI355X kernel written in HIP

```python
import jax, jax.numpy as jnp
from jax import lax
import numpy as np

D_MODEL = 1024
BATCH = 8
SEQ = 8192
DEPTH = 2
DEC_BATCH = 16
DEC_SEQ = 32
PAST_LEN = 1024

CHUNK = 64
N_HEADS = 16
N_KV_HEADS = 2
HEAD_DIM = 64
GROUP = N_HEADS // N_KV_HEADS
Q_DIM = N_HEADS * HEAD_DIM
KV_DIM = N_KV_HEADS * HEAD_DIM
WINDOW = 128
WIN_CHUNKS = WINDOW // CHUNK
SPAN = (WIN_CHUNKS + 1) * CHUNK
D_CONV = D_MODEL
CONV_WIDTH = 3
D_FF = 2816
EPS = 1e-6
ATTN_SCALE = HEAD_DIM ** -0.5
SPLITS = (Q_DIM, KV_DIM, KV_DIM, D_CONV, D_CONV, D_CONV, D_MODEL, D_MODEL)
N_IN = sum(SPLITS)
SPLIT_AT = tuple(sum(SPLITS[:i + 1]) for i in range(len(SPLITS) - 1))

kernel_name = "hybrid_swa_sink_shortconv_macaron_step"


def rms_norm(x, g):
    xf = x.astype(jnp.float32)
    y = xf * lax.rsqrt(jnp.mean(xf * xf, axis=-1, keepdims=True) + EPS)
    return (y * g.astype(jnp.float32)).astype(x.dtype)


def half_ffn(x, g, w_gate, w_up, w_down):
    h = rms_norm(x, g)
    return x + 0.5 * ((jax.nn.silu(h @ w_gate) * (h @ w_up)) @ w_down)


def mixer_inputs(x, g, w_in, b_in):
    h = rms_norm(x, g)
    return jnp.split(h @ w_in + b_in, SPLIT_AT, axis=-1)


def sink_softmax(s, sink):
    m = jnp.maximum(jnp.max(s, axis=-1, keepdims=True), sink)
    e = jnp.exp(s - m)
    return e / (jnp.sum(e, axis=-1, keepdims=True) + jnp.exp(sink - m))


def banded_sink_attention(q, k, v, sinks):
    b, n = q.shape[:2]
    nc = n // CHUNK
    qc = q.reshape(b, nc, CHUNK, N_KV_HEADS, GROUP, HEAD_DIM)

    def windows(t):
        tp = jnp.pad(t.reshape(b, n, N_KV_HEADS, HEAD_DIM),
                     ((0, 0), (WIN_CHUNKS * CHUNK, 0), (0, 0), (0, 0)))
        tp = tp.reshape(b, nc + WIN_CHUNKS, CHUNK, N_KV_HEADS, HEAD_DIM)
        return jnp.concatenate([tp[:, i:i + nc] for i in range(WIN_CHUNKS + 1)], axis=2)

    kw, vw = windows(k), windows(v)
    s = jnp.einsum('bcqhgd,bcjhd->bchgqj', qc, kw,
                   preferred_element_type=jnp.float32) * ATTN_SCALE
    key_chunk = jnp.arange(nc)[:, None] - WIN_CHUNKS + jnp.arange(SPAN)[None, :] // CHUNK
    s = jnp.where((key_chunk >= 0)[None, :, None, None, None, :], s, -jnp.inf)
    sink = sinks.astype(jnp.float32).reshape(1, 1, N_KV_HEADS, GROUP, 1, 1)
    p = sink_softmax(s, sink).astype(vw.dtype)
    o = jnp.einsum('bchgqj,bcjhd->bcqhgd', p, vw)
    return o.reshape(b, n, Q_DIM)


def sample_sink_attention(q, k_all, v_all, sinks):
    b, n = q.shape[:2]
    qs = q.reshape(b, n, N_KV_HEADS, GROUP, HEAD_DIM)
    s = jnp.einsum('bqhgd,bjhd->bhgqj', qs, k_all,
                   preferred_element_type=jnp.float32) * ATTN_SCALE
    sink = sinks.astype(jnp.float32).reshape(1, N_KV_HEADS, GROUP, 1, 1)
    p = sink_softmax(s, sink).astype(v_all.dtype)
    o = jnp.einsum('bhgqj,bjhd->bqhgd', p, v_all)
    return o.reshape(b, n, Q_DIM)


def causal_dwconv(up, w, n):
    out = up[:, 0:n] * w[0]
    for j in range(1, CONV_WIDTH):
        out = out + up[:, j:j + n] * w[j]
    return out


def merge_branches(attn, conv, g_attn, g_conv, w_o_attn, w_o_conv, w_o):
    m = jax.nn.sigmoid(g_attn) * (attn @ w_o_attn) + jax.nn.sigmoid(g_conv) * (conv @ w_o_conv)
    return m @ w_o


def setup_inputs(seed: int = 0) -> dict:
    key = jax.random.key(seed)
    ks = jax.random.split(key, 24)

    def nrm(k, shape, scale):
        return jax.random.normal(k, shape, jnp.float32) * scale

    win_keep = min(WINDOW, PAST_LEN)
    return {
        "x_prompt": nrm(ks[0], (BATCH, SEQ, D_MODEL), 1.0),
        "x_sample": nrm(ks[1], (DEC_BATCH, DEC_SEQ, D_MODEL), 1.0),
        "cache_k": nrm(ks[2], (DEPTH, DEC_BATCH, win_keep, N_KV_HEADS, HEAD_DIM), 1.0),
        "cache_v": nrm(ks[3], (DEPTH, DEC_BATCH, win_keep, N_KV_HEADS, HEAD_DIM), 1.0),
        "state_conv": nrm(ks[4], (DEPTH, DEC_BATCH, CONV_WIDTH - 1, D_CONV), 1.0),
        "norm_ffn1": 1.0 + nrm(ks[5], (DEPTH, D_MODEL), 0.05),
        "w1_gate": nrm(ks[6], (DEPTH, D_MODEL, D_FF), D_MODEL ** -0.5),
        "w1_up": nrm(ks[7], (DEPTH, D_MODEL, D_FF), D_MODEL ** -0.5),
        "w1_down": nrm(ks[8], (DEPTH, D_FF, D_MODEL), D_FF ** -0.5),
        "norm_mix": 1.0 + nrm(ks[9], (DEPTH, D_MODEL), 0.05),
        "w_in": nrm(ks[10], (DEPTH, D_MODEL, N_IN), D_MODEL ** -0.5),
        "b_in": nrm(ks[11], (DEPTH, N_IN), 0.02),
        "sinks": nrm(ks[12], (DEPTH, N_HEADS), 0.5),
        "conv_w": nrm(ks[13], (DEPTH, CONV_WIDTH, D_CONV), CONV_WIDTH ** -0.5),
        "w_o_attn": nrm(ks[14], (DEPTH, Q_DIM, D_MODEL), Q_DIM ** -0.5),
        "w_o_conv": nrm(ks[15], (DEPTH, D_CONV, D_MODEL), D_CONV ** -0.5),
        "w_o": nrm(ks[16], (DEPTH, D_MODEL, D_MODEL), D_MODEL ** -0.5),
        "norm_ffn2": 1.0 + nrm(ks[17], (DEPTH, D_MODEL), 0.05),
        "w2_gate": nrm(ks[18], (DEPTH, D_MODEL, D_FF), D_MODEL ** -0.5),
        "w2_up": nrm(ks[19], (DEPTH, D_MODEL, D_FF), D_MODEL ** -0.5),
        "w2_down": nrm(ks[20], (DEPTH, D_FF, D_MODEL), D_FF ** -0.5),
        "norm_final": 1.0 + nrm(ks[21], (D_MODEL,), 0.05),
    }


def reference(x_prompt, x_sample, cache_k, cache_v, state_conv,
              norm_ffn1, w1_gate, w1_up, w1_down,
              norm_mix, w_in, b_in, sinks, conv_w, w_o_attn, w_o_conv, w_o,
              norm_ffn2, w2_gate, w2_up, w2_down, norm_final):
    xp, xs = x_prompt, x_sample
    n_p, n_s = xp.shape[1], xs.shape[1]
    keep_s = cache_k.shape[2]
    keep_p = min(WINDOW, n_p)
    kp_l, vp_l, cp_l, ks_l, vs_l, cs_l = [], [], [], [], [], []
    for l in range(DEPTH):
        xp = half_ffn(xp, norm_ffn1[l], w1_gate[l], w1_up[l], w1_down[l])
        xs = half_ffn(xs, norm_ffn1[l], w1_gate[l], w1_up[l], w1_down[l])

        q, k, v, b_gate, c_gate, h_conv, g_attn, g_conv = mixer_inputs(xp, norm_mix[l], w_in[l], b_in[l])
        attn = banded_sink_attention(q, k, v, sinks[l])
        u = c_gate * h_conv
        up = jnp.pad(u, ((0, 0), (CONV_WIDTH - 1, 0), (0, 0)))
        conv = b_gate * causal_dwconv(up, conv_w[l], n_p)
        xp = xp + merge_branches(attn, conv, g_attn, g_conv, w_o_attn[l], w_o_conv[l], w_o[l])
        bp = xp.shape[0]
        kp_l.append(k[:, n_p - keep_p:].reshape(bp, keep_p, N_KV_HEADS, HEAD_DIM))
        vp_l.append(v[:, n_p - keep_p:].reshape(bp, keep_p, N_KV_HEADS, HEAD_DIM))
        cp_l.append(u[:, n_p - (CONV_WIDTH - 1):])

        q, k, v, b_gate, c_gate, h_conv, g_attn, g_conv = mixer_inputs(xs, norm_mix[l], w_in[l], b_in[l])
        bs = xs.shape[0]
        k_all = jnp.concatenate([cache_k[l], k.reshape(bs, n_s, N_KV_HEADS, HEAD_DIM)], axis=1)
        v_all = jnp.concatenate([cache_v[l], v.reshape(bs, n_s, N_KV_HEADS, HEAD_DIM)], axis=1)
        attn = sample_sink_attention(q, k_all, v_all, sinks[l])
        u = c_gate * h_conv
        up = jnp.concatenate([state_conv[l], u], axis=1)
        conv = b_gate * causal_dwconv(up, conv_w[l], n_s)
        xs = xs + merge_branches(attn, conv, g_attn, g_conv, w_o_attn[l], w_o_conv[l], w_o[l])
        ks_l.append(k_all[:, -keep_s:])
        vs_l.append(v_all[:, -keep_s:])
        cs_l.append(up[:, -(CONV_WIDTH - 1):])

        xp = half_ffn(xp, norm_ffn2[l], w2_gate[l], w2_up[l], w2_down[l])
        xs = half_ffn(xs, norm_ffn2[l], w2_gate[l], w2_up[l], w2_down[l])

    y_prompt = rms_norm(xp, norm_final)
    y_sample = rms_norm(xs, norm_final)
    return (y_prompt, y_sample, jnp.stack(kp_l), jnp.stack(vp_l), jnp.stack(cp_l),
            jnp.stack(ks_l), jnp.stack(vs_l), jnp.stack(cs_l))
```

```cpp
#include <hip/hip_runtime.h>
#include <hip/hip_cooperative_groups.h>
#include <cstdio>
#include <cstdint>
namespace cg = cooperative_groups;

constexpr int DM = 1024, DFF = 2816, NIN = 6400;
constexpr int NB = 8, SEQ = 8192, SBAT = 16, SSEQ = 32;
constexpr int MP = NB * SEQ, MS = SBAT * SSEQ, MT = MP + MS;
constexpr float EPS = 1e-6f, LOG2E = 1.4426950408889634f;
constexpr float QSCALE = 0.125f * LOG2E;

typedef float f32x2_t __attribute__((ext_vector_type(2)));
typedef __bf16 bf16x2_t __attribute__((ext_vector_type(2)));
__device__ __forceinline__ unsigned cvtpk(float lo, float hi) { f32x2_t v = {lo, hi}; bf16x2_t b = __builtin_convertvector(v, bf16x2_t); return __builtin_bit_cast(unsigned, b); }
__device__ __forceinline__ float bflo(unsigned w) { return __uint_as_float(w << 16); }
__device__ __forceinline__ float bfhi(unsigned w) { return __uint_as_float(w & 0xffff0000u); }
__device__ __forceinline__ float fast_sigmoid(float z) { return __builtin_amdgcn_rcpf(1.0f + __builtin_amdgcn_exp2f(-z * LOG2E)); }

namespace pg8 {
#define PG8_LAS __attribute__((address_space(3)))
typedef unsigned short bf16_t;
typedef short bf16x8 __attribute__((ext_vector_type(8)));
typedef float f32x4 __attribute__((ext_vector_type(4)));
typedef unsigned u32x4 __attribute__((ext_vector_type(4)));
constexpr int BM = 256, BK = 64, HALF = 128, HTB = HALF * BK * 2  , STAGE_BYTES = 8 * HTB, NXCD = 8, WGM = 8;

__host__ __device__ __forceinline__ int lds_byte(int r, int c) { const int st = (r >> 4) * 2 + (c >> 5), rr = r & 15, cc = c & 31, ob = rr * 64 + cc * 2; return st * 1024 + (ob ^ (((ob >> 9) & 1) << 5)); }
__host__ __device__ __forceinline__ void stage_rc(int b, int& R, int& C) { const int st = b / 1024, sb = b % 1024, swz = sb ^ (((sb >> 9) & 1) << 5); R = (st >> 1) * 16 + swz / 64; C = (st & 1) * 32 + (swz % 64) / 2; }
__host__ __device__ __forceinline__ int perm32(int rho) { const int n = rho >> 4, i = rho & 15; return 8 * (i >> 2) + 4 * n + (i & 3); }

struct Unit { int pm, pn; };
struct Gemm { const bf16_t* A; const bf16_t* Bt; int M, N, K; };

struct StaticOrder {
    int nM, nN, nwg, G, c;
    __host__ __device__ void init(int M, int N, int G_, int c_) { nM = M / BM; nN = N / BM; nwg = nM * nN; G = G_; c = c_; }
    __host__ __device__ bool next(int i, Unit& u) const {
        const long L = (long)i * G + c; if (L >= nwg) return false;
        int wgid = (int)L; { const int q = nwg / NXCD, r = nwg % NXCD, xcd = wgid % NXCD, off = wgid / NXCD; wgid = (xcd < r ? xcd * (q + 1) : r * (q + 1) + (xcd - r) * q) + off; }
        const int nig = WGM * nN, gid = wgid / nig, fm = gid * WGM, gsz = (nM - fm) < WGM ? (nM - fm) : WGM;
        u.pm = fm + ((wgid % nig) % gsz); u.pn = (wgid % nig) / gsz; return true;
    }
    __device__ __forceinline__ void a_ready(const Unit&) const {}
    __device__ __forceinline__ void done(const Unit&) const {}
};

__device__ __forceinline__ float row_rs(const float* ss, int row) { return __builtin_amdgcn_rsqf(ss[row] * (1.0f / 1024.0f) + EPS); }

struct EpiSwiGLU {
    static constexpr bool PERM = true, AFTER_DRAIN = false;
    bf16_t* H; const float* ss;
    __device__ __forceinline__ void operator()(const f32x4 (&acc)[2][2][4][2], const Unit& u, int wr, int wc, int fr, int fq) const {
        const int row0 = u.pm * BM + wr * 64 + fr, col0 = u.pn * 128 + wc * 32 + 8 * fq;
#pragma unroll
        for (int ai = 0; ai < 2; ++ai)
#pragma unroll
            for (int m = 0; m < 4; ++m) {
                const int row = row0 + ai * HALF + m * 16; const float rs = row_rs(ss, row);
                float h[8];
#pragma unroll
                for (int n = 0; n < 2; ++n)
#pragma unroll
                    for (int e = 0; e < 4; ++e) { const float g = acc[ai][0][m][n][e] * rs, up = acc[ai][1][m][n][e] * rs; h[n * 4 + e] = g * fast_sigmoid(g) * up; }
                u32x4 w; w.x = cvtpk(h[0], h[1]); w.y = cvtpk(h[2], h[3]); w.z = cvtpk(h[4], h[5]); w.w = cvtpk(h[6], h[7]);
                *(u32x4*)(H + (size_t)row * DFF + col0) = w;
            }
    }
};

struct EpiResid {
    static constexpr bool PERM = true, AFTER_DRAIN = false;
    const float* baseP; const float* baseS; float* out; bf16_t* xb; float* ssn; float scale;
    __device__ __forceinline__ void operator()(const f32x4 (&acc)[2][2][4][2], const Unit& u, int wr, int wc, int fr, int fq) const {
        const int row0 = u.pm * BM + wr * 64 + fr, col0 = u.pn * BM + wc * 32 + 8 * fq;
#pragma unroll
        for (int ai = 0; ai < 2; ++ai)
#pragma unroll
            for (int m = 0; m < 4; ++m) {
                const int row = row0 + ai * HALF + m * 16;
                const float* b = (row < MP) ? baseP + (size_t)row * DM : baseS + (size_t)(row - MP) * DM;
                float sq = 0.f;
#pragma unroll
                for (int bj = 0; bj < 2; ++bj) {
                    const int c = col0 + bj * HALF;
                    const f32x4 b0 = *(const f32x4*)(b + c), b1 = *(const f32x4*)(b + c + 4);
                    const f32x4 o0 = b0 + acc[ai][bj][m][0] * scale, o1 = b1 + acc[ai][bj][m][1] * scale;
                    *(f32x4*)(out + (size_t)row * DM + c) = o0; *(f32x4*)(out + (size_t)row * DM + c + 4) = o1;
                    u32x4 w; w.x = cvtpk(o0[0], o0[1]); w.y = cvtpk(o0[2], o0[3]); w.z = cvtpk(o1[0], o1[1]); w.w = cvtpk(o1[2], o1[3]);
                    *(u32x4*)(xb + (size_t)row * DM + c) = w;
                    sq += (o0[0] * o0[0] + o0[1] * o0[1]) + (o0[2] * o0[2] + o0[3] * o0[3]) + (o1[0] * o1[0] + o1[1] * o1[1]) + (o1[2] * o1[2] + o1[3] * o1[3]);
                }
                sq += __shfl_xor(sq, 16); sq += __shfl_xor(sq, 32);
                if (fq == 0) unsafeAtomicAdd(ssn + row, sq);
            }
    }
};

struct EpiMixIn {
    static constexpr bool PERM = true, AFTER_DRAIN = false;
    const float* ss; const float* bias; bf16_t *Q, *KV, *BG, *U, *SA, *SC;
    __device__ __forceinline__ void operator()(const f32x4 (&acc)[2][2][4][2], const Unit& u, int wr, int wc, int fr, int fq) const {
        const int pn = u.pn; bf16_t* dst; int ld, cbase, mode; float sc = 1.f;
        if (pn < 4) { dst = Q; ld = DM; cbase = pn * 256; mode = 0; sc = QSCALE; }
        else if (pn == 4) { dst = KV; ld = 256; cbase = 0; mode = 0; }
        else if (pn < 9) { dst = BG; ld = DM; cbase = (pn - 5) * 256; mode = 0; }
        else if (pn < 17) { dst = U; ld = DM; cbase = (pn - 9) * 128; mode = 2; }
        else if (pn < 21) { dst = SA; ld = DM; cbase = (pn - 17) * 256; mode = 1; }
        else { dst = SC; ld = DM; cbase = (pn - 21) * 256; mode = 1; }
        const int row0 = u.pm * BM + wr * 64 + fr, cw = wc * 32 + 8 * fq;
        f32x4 bv[2][2];
#pragma unroll
        for (int bj = 0; bj < 2; ++bj)
#pragma unroll
            for (int n = 0; n < 2; ++n) bv[bj][n] = *(const f32x4*)(bias + pn * 256 + bj * HALF + cw + 4 * n);
#pragma unroll
        for (int ai = 0; ai < 2; ++ai)
#pragma unroll
            for (int m = 0; m < 4; ++m) {
                const int row = row0 + ai * HALF + m * 16; const float rs = row_rs(ss, row);
                bf16_t* rowp = dst + (size_t)row * ld + cbase + cw;
                if (mode == 2) {
                    const f32x4 z0 = (acc[ai][0][m][0] * rs + bv[0][0]) * (acc[ai][1][m][0] * rs + bv[1][0]);
                    const f32x4 z1 = (acc[ai][0][m][1] * rs + bv[0][1]) * (acc[ai][1][m][1] * rs + bv[1][1]);
                    u32x4 w; w.x = cvtpk(z0[0], z0[1]); w.y = cvtpk(z0[2], z0[3]); w.z = cvtpk(z1[0], z1[1]); w.w = cvtpk(z1[2], z1[3]);
                    *(u32x4*)rowp = w;
                } else {
#pragma unroll
                    for (int bj = 0; bj < 2; ++bj) {
                        f32x4 z0 = acc[ai][bj][m][0] * rs + bv[bj][0], z1 = acc[ai][bj][m][1] * rs + bv[bj][1];
                        if (mode == 1) {
#pragma unroll
                            for (int e = 0; e < 4; ++e) { z0[e] = fast_sigmoid(z0[e]); z1[e] = fast_sigmoid(z1[e]); }
                        } else { z0 = z0 * sc; z1 = z1 * sc; }
                        u32x4 w; w.x = cvtpk(z0[0], z0[1]); w.y = cvtpk(z0[2], z0[3]); w.z = cvtpk(z1[0], z1[1]); w.w = cvtpk(z1[2], z1[3]);
                        *(u32x4*)(rowp + bj * HALF) = w;
                    }
                }
            }
    }
};

struct EpiGate {
    static constexpr bool PERM = true, AFTER_DRAIN = false;
    bf16_t* G; const bf16_t* ADD;
    __device__ __forceinline__ void operator()(const f32x4 (&acc)[2][2][4][2], const Unit& u, int wr, int wc, int fr, int fq) const {
        const int row0 = u.pm * BM + wr * 64 + fr, col0 = u.pn * BM + wc * 32 + 8 * fq;
#pragma unroll
        for (int ai = 0; ai < 2; ++ai)
#pragma unroll
            for (int m = 0; m < 4; ++m) {
                const int row = row0 + ai * HALF + m * 16;
#pragma unroll
                for (int bj = 0; bj < 2; ++bj) {
                    const size_t idx = (size_t)row * DM + col0 + bj * HALF;
                    const u32x4 g = *(const u32x4*)(G + idx);
                    u32x4 a = (u32x4){0u, 0u, 0u, 0u}; if (ADD) a = *(const u32x4*)(ADD + idx);
                    const f32x4 p0 = acc[ai][bj][m][0], p1 = acc[ai][bj][m][1];
                    u32x4 w;
                    w.x = cvtpk(bflo(a.x) + bflo(g.x) * p0[0], bfhi(a.x) + bfhi(g.x) * p0[1]);
                    w.y = cvtpk(bflo(a.y) + bflo(g.y) * p0[2], bfhi(a.y) + bfhi(g.y) * p0[3]);
                    w.z = cvtpk(bflo(a.z) + bflo(g.z) * p1[0], bfhi(a.z) + bfhi(g.z) * p1[1]);
                    w.w = cvtpk(bflo(a.w) + bflo(g.w) * p1[2], bfhi(a.w) + bfhi(g.w) * p1[3]);
                    *(u32x4*)(G + idx) = w;
                }
            }
    }
};

template <class Epi, class Sched, bool ALIGN_EPI = false, bool SP2 = false>
__device__ __forceinline__ void gemm_phase(PG8_LAS unsigned char* lds, const Gemm g, const Sched& S, const Epi& E) {
    int tid_ = threadIdx.x; asm volatile("" : "+v"(tid_));
    const int tid = tid_, wid = __builtin_amdgcn_readfirstlane(tid >> 6), lane = tid & 63, wr = wid >> 2, wc = wid & 3, fr = lane & 15, fq = lane >> 4;
    const int K = g.K, nt = K / BK;
    unsigned voffA[2], voffB[2];
#pragma unroll
    for (int i = 0; i < 2; ++i) { int R, C; stage_rc(tid * 16 + i * 8192, R, C); const int Rb = Epi::PERM ? ((R & ~31) + perm32(R & 31)) : R;
        voffA[i] = (unsigned)(R * K + C) * 2u; voffB[i] = (unsigned)(Rb * K + C) * 2u; }
    const size_t kstep = (size_t)(BK * 2);
    const size_t hstep = (size_t)HALF * K * 2;
    const size_t tstep = 2 * hstep;
    const unsigned ldsw = (unsigned)wid * 1024u;
    const int aoff = lds_byte(wr * 64 + fr, fq * 8), boff = lds_byte(wc * 32 + fr, fq * 8);
#define PG8_SA(b, h) (((b) * 2 + (h)) * HTB)
#define PG8_SB(b, h) ((4 + (b) * 2 + (h)) * HTB)
#define PG8_STAGE(bufoff, gbase, voff) do { _Pragma("unroll") for (int _i = 0; _i < 2; ++_i) \
        __builtin_amdgcn_global_load_lds((const unsigned*)((const char*)(gbase) + (voff)[_i]), (PG8_LAS unsigned*)(lds + (bufoff) + ldsw + _i * 8192), 16, 0, 0); } while (0)
#define PG8_LDA(dst, b, h) do { _Pragma("unroll") for (int m = 0; m < 4; ++m) _Pragma("unroll") for (int k = 0; k < 2; ++k) dst[m][k] = *(const PG8_LAS bf16x8*)(lds + PG8_SA(b, h) + aoff + m * 2048 + k * 1024); } while (0)
#define PG8_LDB(dst, b, h) do { _Pragma("unroll") for (int n = 0; n < 2; ++n) _Pragma("unroll") for (int k = 0; k < 2; ++k) dst[n][k] = *(const PG8_LAS bf16x8*)(lds + PG8_SB(b, h) + boff + n * 2048 + k * 1024); } while (0)
#define PG8_MMA(ai, bj, At, Bt) do { __builtin_amdgcn_s_setprio(1); _Pragma("unroll") for (int m = 0; m < 4; ++m) _Pragma("unroll") for (int n = 0; n < 2; ++n) _Pragma("unroll") for (int k = 0; k < 2; ++k) \
        acc[ai][bj][m][n] = __builtin_amdgcn_mfma_f32_16x16x32_bf16(Bt[n][k], At[m][k], acc[ai][bj][m][n], 0, 0, 0); __builtin_amdgcn_s_setprio(0); } while (0)
#define PG8_WAIT_V(n) asm volatile("s_waitcnt vmcnt(" #n ")" ::: "memory")
#define PG8_WAIT_L(n) asm volatile("s_waitcnt lgkmcnt(" #n ")" ::: "memory")
#define PG8_BAR __builtin_amdgcn_s_barrier()
#define PG8_SCHED __builtin_amdgcn_sched_barrier(0)
    Unit cur, nxt; int ui = 0;
    if (!S.next(0, cur)) return;
    f32x4 acc[2][2][4][2];
#pragma unroll
    for (int a = 0; a < 2; ++a)
#pragma unroll
        for (int b = 0; b < 2; ++b)
#pragma unroll
            for (int m = 0; m < 4; ++m)
#pragma unroll
                for (int n = 0; n < 2; ++n) acc[a][b][m][n] = (f32x4){0.f, 0.f, 0.f, 0.f};
    bf16x8 At[4][2], B0[2][2], B1[2][2];
    const char* cA = (const char*)g.A + (size_t)cur.pm * tstep; const char* cB = (const char*)g.Bt + (size_t)cur.pn * tstep;
    S.a_ready(cur);
    if constexpr (SP2) {
        PG8_STAGE(PG8_SB(0, 0), cB, voffB); PG8_STAGE(PG8_SB(0, 1), cB + hstep, voffB); PG8_STAGE(PG8_SA(0, 0), cA, voffA); PG8_STAGE(PG8_SA(0, 1), cA + hstep, voffA);
        if (wr == 1) PG8_BAR;
        PG8_WAIT_V(2); PG8_BAR;
        PG8_STAGE(PG8_SB(1, 0), cB + kstep, voffB); PG8_STAGE(PG8_SA(1, 0), cA + kstep, voffA); PG8_STAGE(PG8_SB(1, 1), cB + hstep + kstep, voffB);
        PG8_WAIT_V(6); PG8_BAR;
    } else {
        PG8_STAGE(PG8_SB(0, 0), cB, voffB); PG8_STAGE(PG8_SA(0, 0), cA, voffA); PG8_STAGE(PG8_SB(0, 1), cB + hstep, voffB); PG8_STAGE(PG8_SA(0, 1), cA + hstep, voffA);
        if (wr == 1) PG8_BAR;
        PG8_WAIT_V(4); PG8_BAR;
        PG8_STAGE(PG8_SB(1, 0), cB + kstep, voffB); PG8_STAGE(PG8_SA(1, 0), cA + kstep, voffA); PG8_STAGE(PG8_SB(1, 1), cB + hstep + kstep, voffB);
        PG8_WAIT_V(6); PG8_BAR;
    }
    for (;;) {
        const bool has_next = S.next(ui + 1, nxt);
        const char* nA = has_next ? (const char*)g.A + (size_t)nxt.pm * tstep : cA; const char* nB = has_next ? (const char*)g.Bt + (size_t)nxt.pn * tstep : cB;
        for (int t = 0; t < nt; t += 2) {
            const bool last = (t == nt - 2);
            const char* a1 = cA + (size_t)(t + 1) * kstep;
            const char* a2 = last ? nA : cA + (size_t)(t + 2) * kstep; const char* b2 = last ? nB : cB + (size_t)(t + 2) * kstep;
            const char* a3 = a2 + kstep; const char* b3 = b2 + kstep;
            if (last && has_next) S.a_ready(nxt);
            if constexpr (SP2) {
            PG8_LDB(B0, 0, 0); PG8_LDB(B1, 0, 1); PG8_SCHED; PG8_LDA(At, 0, 0); PG8_STAGE(PG8_SA(1, 1), a1 + hstep, voffA);
            PG8_WAIT_V(8); PG8_WAIT_L(0); PG8_BAR; PG8_MMA(0, 0, At, B0); PG8_MMA(0, 1, At, B1); PG8_BAR; PG8_SCHED;
            PG8_LDA(At, 0, 1); PG8_STAGE(PG8_SB(0, 0), b2, voffB); PG8_STAGE(PG8_SB(0, 1), b2 + hstep, voffB); PG8_STAGE(PG8_SA(0, 0), a2, voffA);
            PG8_WAIT_V(8); PG8_WAIT_L(0); PG8_BAR; PG8_MMA(1, 0, At, B0); PG8_MMA(1, 1, At, B1); PG8_BAR; PG8_SCHED;
            PG8_LDB(B0, 1, 0); PG8_LDB(B1, 1, 1); PG8_SCHED; PG8_LDA(At, 1, 0); PG8_STAGE(PG8_SA(0, 1), a2 + hstep, voffA);
            PG8_WAIT_V(8); PG8_WAIT_L(0); PG8_BAR; PG8_MMA(0, 0, At, B0); PG8_MMA(0, 1, At, B1); PG8_BAR; PG8_SCHED;
            PG8_LDA(At, 1, 1); PG8_STAGE(PG8_SB(1, 0), b3, voffB); PG8_STAGE(PG8_SB(1, 1), b3 + hstep, voffB); PG8_STAGE(PG8_SA(1, 0), a3, voffA);
            PG8_WAIT_V(8); PG8_WAIT_L(0); PG8_BAR; PG8_MMA(1, 0, At, B0); PG8_MMA(1, 1, At, B1); PG8_BAR; PG8_SCHED;
            } else {
            PG8_LDB(B0, 0, 0); PG8_SCHED; PG8_LDA(At, 0, 0); PG8_STAGE(PG8_SA(1, 1), a1 + hstep, voffA);
            PG8_WAIT_L(8); PG8_BAR; PG8_WAIT_L(0); PG8_MMA(0, 0, At, B0); PG8_BAR; PG8_SCHED;
            PG8_LDB(B1, 0, 1); PG8_STAGE(PG8_SB(0, 0), b2, voffB);
            PG8_BAR; PG8_WAIT_L(0); PG8_MMA(0, 1, At, B1); PG8_BAR;
            PG8_LDA(At, 0, 1); PG8_STAGE(PG8_SA(0, 0), a2, voffA);
            PG8_BAR; PG8_WAIT_L(0); PG8_MMA(1, 0, At, B0); PG8_BAR; PG8_SCHED;
            PG8_STAGE(PG8_SB(0, 1), b2 + hstep, voffB);
            PG8_WAIT_V(6); PG8_BAR; PG8_MMA(1, 1, At, B1); PG8_BAR;
            PG8_LDB(B0, 1, 0); PG8_SCHED; PG8_LDA(At, 1, 0); PG8_STAGE(PG8_SA(0, 1), a2 + hstep, voffA);
            PG8_WAIT_L(8); PG8_BAR; PG8_WAIT_L(0); PG8_MMA(0, 0, At, B0); PG8_BAR; PG8_SCHED;
            PG8_LDB(B1, 1, 1); PG8_STAGE(PG8_SB(1, 0), b3, voffB);
            PG8_BAR; PG8_WAIT_L(0); PG8_MMA(0, 1, At, B1); PG8_BAR;
            PG8_LDA(At, 1, 1); PG8_STAGE(PG8_SA(1, 0), a3, voffA);
            PG8_BAR; PG8_WAIT_L(0); PG8_MMA(1, 0, At, B0); PG8_BAR; PG8_SCHED;
            PG8_STAGE(PG8_SB(1, 1), b3 + hstep, voffB);
            PG8_WAIT_V(6); PG8_BAR; PG8_MMA(1, 1, At, B1); PG8_BAR;
            }
        }
        if constexpr (ALIGN_EPI) { if (wr == 0) PG8_BAR; }
        if constexpr (!Epi::AFTER_DRAIN) { E(acc, cur, wr, wc, fr, fq); S.done(cur); }
        if (!has_next) break;
#pragma unroll
        for (int a = 0; a < 2; ++a)
#pragma unroll
            for (int b = 0; b < 2; ++b)
#pragma unroll
                for (int m = 0; m < 4; ++m)
#pragma unroll
                    for (int n = 0; n < 2; ++n) acc[a][b][m][n] = (f32x4){0.f, 0.f, 0.f, 0.f};
        cur = nxt; cA = nA; cB = nB; ++ui;
        if constexpr (ALIGN_EPI) { if (wr == 1) PG8_BAR; }
    }
    PG8_WAIT_V(0);
    if constexpr (!ALIGN_EPI) { if (wr == 0) PG8_BAR; }
    PG8_BAR;
    if constexpr (Epi::AFTER_DRAIN) { E.fused(acc, cur, wr, wc, fr, fq, lds, wid, lane); S.done(cur); }
#undef PG8_SA
#undef PG8_SB
#undef PG8_STAGE
#undef PG8_LDA
#undef PG8_LDB
#undef PG8_MMA
#undef PG8_WAIT_V
#undef PG8_WAIT_L
#undef PG8_BAR
#undef PG8_SCHED
}
}

#define GAS __attribute__((address_space(1)))
#define LAS __attribute__((address_space(3)))
typedef unsigned short bf16;
typedef float f32x4 __attribute__((ext_vector_type(4)));
typedef float f32x16 __attribute__((ext_vector_type(16)));
typedef unsigned u32x4 __attribute__((ext_vector_type(4)));
typedef short bf16x8 __attribute__((ext_vector_type(8)));
typedef short s16x4 __attribute__((ext_vector_type(4)));
constexpr size_t MiB = 1u << 20;
constexpr size_t WS_SS = 0;
constexpr size_t WS_BIAS = 3 * MiB;
constexpr size_t WS_W = 4 * MiB;
constexpr size_t E_W1GU = 0, E_W1D = E_W1GU + (size_t)2 * DFF * DM, E_WIN = E_W1D + (size_t)DM * DFF, E_WOA = E_WIN + (size_t)NIN * DM, E_WOC = E_WOA + (size_t)DM * DM,
                 E_WO = E_WOC + (size_t)DM * DM, E_W2GU = E_WO + (size_t)DM * DM, E_W2D = E_W2GU + (size_t)2 * DFF * DM, E_LAYER = E_W2D + (size_t)DM * DFF;
constexpr size_t WS_XB = 116 * MiB;
constexpr size_t ACT = (size_t)MT * DM * 2;
constexpr size_t WS_Q = 246 * MiB, WS_BG = WS_Q + ACT, WS_U = WS_BG + ACT, WS_SA = WS_U + ACT, WS_SC = WS_SA + ACT, WS_KV = WS_SC + ACT, WS_END = WS_KV + (size_t)MT * 256 * 2;
constexpr size_t WS_H = WS_Q;
static_assert(WS_W + 2 * E_LAYER * 2 <= WS_XB && WS_XB + ACT <= WS_Q && WS_H + (size_t)MT * DFF * 2 <= WS_SA && WS_END <= (size_t)1024 * MiB, "d_ws map");
constexpr size_t O_YP = 0, O_YS = (size_t)MP * DM, O_KP = O_YS + (size_t)MS * DM, O_VP = O_KP + 2 * 8 * 128 * 128, O_CP = O_VP + 2 * 8 * 128 * 128, O_KS = O_CP + 2 * 8 * 2 * 1024,
                 O_VS = O_KS + 2 * 16 * 128 * 128, O_CS = O_VS + 2 * 16 * 128 * 128, O_END = O_CS + 2 * 16 * 2 * 1024;

#ifndef MK_SKIP
#define MK_SKIP 0
#endif
constexpr int NWAVES = 8, NTHR = 512;
constexpr int LDS_BYTES = 135168;

struct Args {
    const float* x_prompt; const float* x_sample; const float* cache_k; const float* cache_v; const float* state_conv;
    const float* norm_ffn1; const float* w1_gate; const float* w1_up; const float* w1_down;
    const float* norm_mix; const float* w_in; const float* b_in; const float* sinks; const float* conv_w; const float* w_o_attn; const float* w_o_conv; const float* w_o;
    const float* norm_ffn2; const float* w2_gate; const float* w2_up; const float* w2_down; const float* norm_final;
    float* out; unsigned char* ws;
};

__device__ __forceinline__ float wave_sum(float v) {
#pragma unroll
    for (int o = 1; o < 64; o <<= 1) v += __shfl_xor(v, o);
    return v;
}
#define LDS_WAIT() asm volatile("s_waitcnt lgkmcnt(0)" ::: "memory")

__device__ __forceinline__ void transpose_item(const float* W, int K, int N, const float* gain, bf16* WT, int dst_row0, LAS float* scr, int k0, int n0, int lane) {
#pragma unroll 8
    for (int i = 0; i < 32; ++i) { const int kk = 2 * i + (lane >> 5); float v = W[(size_t)(k0 + kk) * N + n0 + (lane & 31)]; if (gain) v *= gain[k0 + kk]; scr[kk * 33 + (lane & 31)] = v; }
    LDS_WAIT(); asm volatile("" ::: "memory");
    const int c = lane & 7;
#pragma unroll
    for (int j = 0; j < 4; ++j) { const int n = (lane >> 3) + 8 * j; const LAS float* s = scr + (8 * c) * 33 + n;
        u32x4 o; o.x = cvtpk(s[0 * 33], s[1 * 33]); o.y = cvtpk(s[2 * 33], s[3 * 33]); o.z = cvtpk(s[4 * 33], s[5 * 33]); o.w = cvtpk(s[6 * 33], s[7 * 33]);
        *(u32x4*)(WT + (size_t)(dst_row0 + n) * K + k0 + 8 * c) = o; }
    LDS_WAIT(); asm volatile("" ::: "memory");
}
__device__ __forceinline__ int win_map(int n) {
    if (n < 2304 || n >= 4352) return n;
    if (n < 3328) { const int f = n - 2304; return 2304 + 256 * (f >> 7) + (f & 127); }
    const int f = n - 3328; return 2304 + 256 * (f >> 7) + 128 + (f & 127);
}
__device__ __forceinline__ int gu_map(int f, int up) { return 256 * (f >> 7) + 128 * up + (f & 127); }

__device__ __forceinline__ void prologue(const Args& a, LAS unsigned char* lds, int tid, int lane, int wave) {
    LAS float* scr = (LAS float*)(lds + wave * 16384);
    const int gw = blockIdx.x * NWAVES + wave, NGW = gridDim.x * NWAVES;
    bf16* Wb = (bf16*)(a.ws + WS_W);
    constexpr int I_G = 16 * 88, I_D = 44 * 32, I_IN = 16 * 200, I_O = 16 * 32, I_LAYER = 6 * I_G + I_IN + 3 * I_O;
    static_assert(I_G == I_D, "item counts");
    for (int it = gw; it < 2 * I_LAYER; it += NGW) {
        const int l = it / I_LAYER; int r = it - l * I_LAYER; bf16* Wl = Wb + (size_t)l * E_LAYER;
        if (r < 2 * I_G) { const int up = r >= I_G; if (up) r -= I_G; const int kb = r / 88, nb = r % 88;
            transpose_item((up ? a.w1_up : a.w1_gate) + (size_t)l * DM * DFF, DM, DFF, a.norm_ffn1 + l * DM, Wl + E_W1GU, gu_map(nb * 32, up), scr, kb * 64, nb * 32, lane); continue; } r -= 2 * I_G;
        if (r < I_D) { const int kb = r / 32, nb = r % 32; transpose_item(a.w1_down + (size_t)l * DFF * DM, DFF, DM, nullptr, Wl + E_W1D, nb * 32, scr, kb * 64, nb * 32, lane); continue; } r -= I_D;
        if (r < I_IN) { const int kb = r / 200, nb = r % 200; transpose_item(a.w_in + (size_t)l * DM * NIN, DM, NIN, a.norm_mix + l * DM, Wl + E_WIN, win_map(nb * 32), scr, kb * 64, nb * 32, lane); continue; } r -= I_IN;
        if (r < 3 * I_O) { const int w = r / I_O; r -= w * I_O; const int kb = r / 32, nb = r % 32; const float* src = (w == 0 ? a.w_o_attn : w == 1 ? a.w_o_conv : a.w_o) + (size_t)l * DM * DM;
            transpose_item(src, DM, DM, nullptr, Wl + (w == 0 ? E_WOA : w == 1 ? E_WOC : E_WO), nb * 32, scr, kb * 64, nb * 32, lane); continue; } r -= 3 * I_O;
        if (r < 2 * I_G) { const int up = r >= I_G; if (up) r -= I_G; const int kb = r / 88, nb = r % 88;
            transpose_item((up ? a.w2_up : a.w2_gate) + (size_t)l * DM * DFF, DM, DFF, a.norm_ffn2 + l * DM, Wl + E_W2GU, gu_map(nb * 32, up), scr, kb * 64, nb * 32, lane); continue; } r -= 2 * I_G;
        { const int kb = r / 32, nb = r % 32; transpose_item(a.w2_down + (size_t)l * DFF * DM, DFF, DM, nullptr, Wl + E_W2D, nb * 32, scr, kb * 64, nb * 32, lane); }
    }
    float* ss = (float*)(a.ws + WS_SS); bf16* XB = (bf16*)(a.ws + WS_XB);
    for (int m = gw; m < MT; m += NGW) {
        const float* xr = (m < MP) ? a.x_prompt + (size_t)m * DM : a.x_sample + (size_t)(m - MP) * DM;
        f32x4 v[4]; float s = 0.f;
#pragma unroll
        for (int j = 0; j < 4; ++j) { v[j] = ((const f32x4*)xr)[lane + 64 * j]; s += (v[j].x * v[j].x + v[j].y * v[j].y) + (v[j].z * v[j].z + v[j].w * v[j].w); }
        s = wave_sum(s); if (lane == 0) ss[m] = s;
        unsigned long long* o8 = (unsigned long long*)(XB + (size_t)m * DM) + lane;
#pragma unroll
        for (int j = 0; j < 4; ++j) o8[64 * j] = (unsigned long long)cvtpk(v[j].x, v[j].y) | ((unsigned long long)cvtpk(v[j].z, v[j].w) << 32);
    }
    const int gt = blockIdx.x * NTHR + tid, NGT = gridDim.x * NTHR;
    for (int i = gt; i < 6 * MT; i += NGT) ss[MT + i] = 0.f;
    float* bp = (float*)(a.ws + WS_BIAS);
    for (int i = gt; i < 2 * NIN; i += NGT) { const int l = i / NIN, n = i - l * NIN; bp[l * NIN + win_map(n)] = a.b_in[i]; }
}

constexpr int KS_STRIDE = 144, VT_STRIDE = 408;
constexpr int LDS_KS = 0, LDS_VT = 192 * KS_STRIDE, LDS_WSF = LDS_VT + 64 * VT_STRIDE, ATT_LDS = LDS_WSF + NWAVES * 32 * 4;
constexpr int N_ATT_ITEMS = 32 + NB * 128 * 2;
__device__ __forceinline__ int crow(int r, int hi) { return (r & 3) + 8 * (r >> 2) + 4 * hi; }

__device__ __forceinline__ void attn_item(LAS unsigned char* lds, bf16* QO, const bf16* KV, const float* ck, const float* cv, const float* sinks, int item, int tid, int lane, int wave) {
    int qrow0, nqb, blo, bhi, h, sb = 0; long kvrow0 = 0; bool sample;
    if (item < 32) { sample = true; sb = item >> 1; h = item & 1; qrow0 = MP + sb * 32; nqb = 1; blo = 0; bhi = 5; }
    else { sample = false; const int it = item - 32; h = it & 1; const int c = (it >> 1) & 127, b = it >> 8; qrow0 = b * SEQ + c * 64; nqb = 2; blo = c >= 2 ? 0 : 2 * (2 - c); bhi = 6; kvrow0 = (long)b * SEQ + (long)(c - 2) * 64; }
    for (int ch = tid; ch < 1536; ch += NTHR) {
        const int j = ch >> 3, dg = ch & 7, blk = j >> 5;
        if (blk >= blo && blk < bhi) {
            u32x4 kx, vx;
            if (sample && j < 128) {
                const size_t o = ((size_t)(sb * 128 + j)) * 128 + h * 64 + dg * 8;
                const f32x4 k0 = *(const f32x4*)(ck + o), k1 = *(const f32x4*)(ck + o + 4), v0 = *(const f32x4*)(cv + o), v1 = *(const f32x4*)(cv + o + 4);
                kx.x = cvtpk(k0[0], k0[1]); kx.y = cvtpk(k0[2], k0[3]); kx.z = cvtpk(k1[0], k1[1]); kx.w = cvtpk(k1[2], k1[3]);
                vx.x = cvtpk(v0[0], v0[1]); vx.y = cvtpk(v0[2], v0[3]); vx.z = cvtpk(v1[0], v1[1]); vx.w = cvtpk(v1[2], v1[3]);
            } else {
                const long row = sample ? (long)(MP + sb * 32 + (j - 128)) : kvrow0 + j;
                const bf16* p = KV + (size_t)row * 256 + h * 64 + dg * 8;
                kx = *(const u32x4*)p; vx = *(const u32x4*)(p + 128);
            }
            *(LAS u32x4*)(lds + LDS_KS + j * KS_STRIDE + dg * 16) = kx;
            LAS unsigned short* vt = (LAS unsigned short*)(lds + LDS_VT + (dg * 8) * VT_STRIDE + j * 2);
            vt[0 * (VT_STRIDE / 2)] = (unsigned short)(vx.x & 0xffffu); vt[1 * (VT_STRIDE / 2)] = (unsigned short)(vx.x >> 16);
            vt[2 * (VT_STRIDE / 2)] = (unsigned short)(vx.y & 0xffffu); vt[3 * (VT_STRIDE / 2)] = (unsigned short)(vx.y >> 16);
            vt[4 * (VT_STRIDE / 2)] = (unsigned short)(vx.z & 0xffffu); vt[5 * (VT_STRIDE / 2)] = (unsigned short)(vx.z >> 16);
            vt[6 * (VT_STRIDE / 2)] = (unsigned short)(vx.w & 0xffffu); vt[7 * (VT_STRIDE / 2)] = (unsigned short)(vx.w >> 16);
        }
    }
    __syncthreads();
    const int r32 = lane & 31, hi = lane >> 5, head = h * 8 + wave;
    const float sink2 = sinks[head] * LOG2E;
    LAS float* wsf = (LAS float*)(lds + LDS_WSF) + wave * 32;
    for (int qb = 0; qb < nqb; ++qb) {
        bf16* qp = QO + (size_t)(qrow0 + qb * 32 + r32) * DM + head * 64 + hi * 8;
        bf16x8 qf[4];
#pragma unroll
        for (int d0 = 0; d0 < 4; ++d0) qf[d0] = *(const bf16x8*)(qp + d0 * 16);
        f32x16 s[6];
#pragma unroll
        for (int kvb = 0; kvb < 6; ++kvb) {
            if (kvb >= blo && kvb < bhi) {
                f32x16 acc;
#pragma unroll
                for (int i = 0; i < 16; ++i) acc[i] = 0.f;
#pragma unroll
                for (int d0 = 0; d0 < 4; ++d0) { const bf16x8 kf = *(const LAS bf16x8*)(lds + LDS_KS + (kvb * 32 + r32) * KS_STRIDE + d0 * 32 + hi * 16);
                    acc = __builtin_amdgcn_mfma_f32_32x32x16_bf16(kf, qf[d0], acc, 0, 0, 0); }
                s[kvb] = acc;
            } else {
#pragma unroll
                for (int i = 0; i < 16; ++i) s[kvb][i] = -1e30f;
            }
        }
        float mx = sink2;
#pragma unroll
        for (int kvb = 0; kvb < 6; ++kvb)
#pragma unroll
            for (int i = 0; i < 16; ++i) mx = fmaxf(mx, s[kvb][i]);
        mx = fmaxf(mx, __shfl_xor(mx, 32));
        float sum = 0.f;
#pragma unroll
        for (int kvb = 0; kvb < 6; ++kvb)
#pragma unroll
            for (int i = 0; i < 16; ++i) { const float e = __builtin_amdgcn_exp2f(s[kvb][i] - mx); s[kvb][i] = e; sum += e; }
        sum += __shfl_xor(sum, 32);
        const float l = sum + __builtin_amdgcn_exp2f(sink2 - mx);
        f32x16 o[2];
#pragma unroll
        for (int i = 0; i < 16; ++i) { o[0][i] = 0.f; o[1][i] = 0.f; }
#pragma unroll
        for (int kvb = 0; kvb < 6; ++kvb) {
            if (kvb >= blo && kvb < bhi) {
#pragma unroll
                for (int st = 0; st < 2; ++st) {
                    u32x4 pw; pw.x = cvtpk(s[kvb][8 * st + 0], s[kvb][8 * st + 1]); pw.y = cvtpk(s[kvb][8 * st + 2], s[kvb][8 * st + 3]);
                    pw.z = cvtpk(s[kvb][8 * st + 4], s[kvb][8 * st + 5]); pw.w = cvtpk(s[kvb][8 * st + 6], s[kvb][8 * st + 7]);
                    const bf16x8 pf = __builtin_bit_cast(bf16x8, pw);
#pragma unroll
                    for (int db = 0; db < 2; ++db) {
                        const LAS unsigned char* vp = lds + LDS_VT + (db * 32 + r32) * VT_STRIDE + (kvb * 32 + 16 * st + 4 * hi) * 2;
                        const s16x4 lo = *(const LAS s16x4*)vp, hh = *(const LAS s16x4*)(vp + 16);
                        const bf16x8 vf = __builtin_shufflevector(lo, hh, 0, 1, 2, 3, 4, 5, 6, 7);
                        o[db] = __builtin_amdgcn_mfma_f32_32x32x16_bf16(pf, vf, o[db], 0, 0, 0);
                    }
                }
            }
        }
        if (hi == 0) wsf[r32] = l;
        LDS_WAIT(); __builtin_amdgcn_wave_barrier(); asm volatile("" ::: "memory");
        bf16* op = QO + (size_t)(qrow0 + qb * 32) * DM + head * 64 + r32;
#pragma unroll
        for (int i = 0; i < 16; ++i) {
            const int q = crow(i, hi); const float rl = __builtin_amdgcn_rcpf(wsf[q]);
            const unsigned w0 = cvtpk(o[0][i] * rl, o[1][i] * rl);
            op[(size_t)q * DM] = (unsigned short)(w0 & 0xffffu); op[(size_t)q * DM + 32] = (unsigned short)(w0 >> 16);
        }
        LDS_WAIT(); __builtin_amdgcn_wave_barrier(); asm volatile("" ::: "memory");
    }
    __syncthreads();
}

__device__ __forceinline__ void conv_chunk(bf16* BG, const bf16* U, const float* cw, const float* st  , int chunk, int tid) {
    const int cgp = tid & 127, rsub = tid >> 7, c0 = cgp * 8;
    const int t0 = chunk * 16 + rsub * 4;
    float w[3][8];
#pragma unroll
    for (int j = 0; j < 3; ++j) { const f32x4 a = *(const f32x4*)(cw + j * DM + c0), b = *(const f32x4*)(cw + j * DM + c0 + 4);
#pragma unroll
        for (int e = 0; e < 4; ++e) { w[j][e] = a[e]; w[j][4 + e] = b[e]; } }
    float p2[8], p1[8];
    const int pos = (t0 < MP) ? (t0 & (SEQ - 1)) : ((t0 - MP) & (SSEQ - 1));
    if (pos == 0) {
        if (t0 < MP) {
#pragma unroll
            for (int e = 0; e < 8; ++e) { p2[e] = 0.f; p1[e] = 0.f; }
        } else {
            const float* s0 = st + (size_t)((t0 - MP) / SSEQ) * 2 * DM + c0;
            const f32x4 a = *(const f32x4*)s0, b = *(const f32x4*)(s0 + 4), c = *(const f32x4*)(s0 + DM), d = *(const f32x4*)(s0 + DM + 4);
#pragma unroll
            for (int e = 0; e < 4; ++e) { p2[e] = a[e]; p2[4 + e] = b[e]; p1[e] = c[e]; p1[4 + e] = d[e]; }
        }
    } else {
        const u32x4 a = *(const u32x4*)(U + (size_t)(t0 - 2) * DM + c0), b = *(const u32x4*)(U + (size_t)(t0 - 1) * DM + c0);
        p2[0] = bflo(a.x); p2[1] = bfhi(a.x); p2[2] = bflo(a.y); p2[3] = bfhi(a.y); p2[4] = bflo(a.z); p2[5] = bfhi(a.z); p2[6] = bflo(a.w); p2[7] = bfhi(a.w);
        p1[0] = bflo(b.x); p1[1] = bfhi(b.x); p1[2] = bflo(b.y); p1[3] = bfhi(b.y); p1[4] = bflo(b.z); p1[5] = bfhi(b.z); p1[6] = bflo(b.w); p1[7] = bfhi(b.w);
    }
#pragma unroll
    for (int r = 0; r < 4; ++r) {
        const size_t idx = (size_t)(t0 + r) * DM + c0;
        const u32x4 uu = *(const u32x4*)(U + idx), gg = *(const u32x4*)(BG + idx);
        float cu[8], g[8], o[8];
        cu[0] = bflo(uu.x); cu[1] = bfhi(uu.x); cu[2] = bflo(uu.y); cu[3] = bfhi(uu.y); cu[4] = bflo(uu.z); cu[5] = bfhi(uu.z); cu[6] = bflo(uu.w); cu[7] = bfhi(uu.w);
        g[0] = bflo(gg.x); g[1] = bfhi(gg.x); g[2] = bflo(gg.y); g[3] = bfhi(gg.y); g[4] = bflo(gg.z); g[5] = bfhi(gg.z); g[6] = bflo(gg.w); g[7] = bfhi(gg.w);
#pragma unroll
        for (int e = 0; e < 8; ++e) { o[e] = g[e] * (w[0][e] * p2[e] + w[1][e] * p1[e] + w[2][e] * cu[e]); p2[e] = p1[e]; p1[e] = cu[e]; }
        u32x4 ww; ww.x = cvtpk(o[0], o[1]); ww.y = cvtpk(o[2], o[3]); ww.z = cvtpk(o[4], o[5]); ww.w = cvtpk(o[6], o[7]);
        *(u32x4*)(BG + idx) = ww;
    }
}

__device__ __forceinline__ f32x4 bf4(const bf16* p) { const uint2 w = *(const uint2*)p; return (f32x4){bflo(w.x), bfhi(w.x), bflo(w.y), bfhi(w.y)}; }
__device__ __forceinline__ void state_copies(const Args& a, int l, const bf16* KV, const bf16* U, int gt, int NGT) {
    constexpr int N_KP = 8 * 128 * 128 / 4, N_CP = 8 * 2 * 1024 / 4, N_KS = 16 * 128 * 128 / 4, N_CS = 16 * 2 * 1024 / 4;
    constexpr int TOT = 2 * N_KP + N_CP + 2 * N_KS + N_CS;
    float* out = a.out;
    for (int i = gt; i < TOT; i += NGT) {
        int r = i;
        if (r < 2 * N_KP) { const int v = r >= N_KP; if (v) r -= N_KP; const int e = r * 4, hd = e & 127, j = (e >> 7) & 127, b = e >> 14;
            *(f32x4*)(out + (v ? O_VP : O_KP) + (size_t)l * 8 * 128 * 128 + e) = bf4(KV + (size_t)(b * SEQ + SEQ - 128 + j) * 256 + v * 128 + hd); continue; } r -= 2 * N_KP;
        if (r < N_CP) { const int e = r * 4, c = e & 1023, ii = (e >> 10) & 1, b = e >> 11;
            *(f32x4*)(out + O_CP + (size_t)l * 8 * 2 * 1024 + e) = bf4(U + (size_t)(b * SEQ + SEQ - 2 + ii) * DM + c); continue; } r -= N_CP;
        if (r < 2 * N_KS) { const int v = r >= N_KS; if (v) r -= N_KS; const int e = r * 4, hd = e & 127, j = (e >> 7) & 127, b = e >> 14;
            f32x4 val;
            if (j < 96) val = *(const f32x4*)((v ? a.cache_v : a.cache_k) + ((size_t)(l * 16 + b) * 128 + 32 + j) * 128 + hd);
            else val = bf4(KV + (size_t)(MP + b * SSEQ + j - 96) * 256 + v * 128 + hd);
            *(f32x4*)(out + (v ? O_VS : O_KS) + (size_t)l * 16 * 128 * 128 + e) = val; continue; } r -= 2 * N_KS;
        { const int e = r * 4, c = e & 1023, ii = (e >> 10) & 1, b = e >> 11;
            *(f32x4*)(out + O_CS + (size_t)l * 16 * 2 * 1024 + e) = bf4(U + (size_t)(MP + b * SSEQ + SSEQ - 2 + ii) * DM + c); }
    }
}

__device__ __forceinline__ int opaque_tid() { int t = threadIdx.x; asm volatile("" : "+v"(t)); return t; }
__global__ void __launch_bounds__(NTHR, 2) fwd_megakernel(Args a) {
    extern __shared__ __attribute__((aligned(16))) unsigned char lds_raw[];
    LAS unsigned char* lds = (LAS unsigned char*)lds_raw;
    cg::grid_group grid = cg::this_grid();
    const int G = gridDim.x, bx = blockIdx.x;
    unsigned char* ws = a.ws;
    float* ss = (float*)(ws + WS_SS);
    bf16* XB = (bf16*)(ws + WS_XB); bf16* H = (bf16*)(ws + WS_H);
    bf16 *Q = (bf16*)(ws + WS_Q), *BG = (bf16*)(ws + WS_BG), *U = (bf16*)(ws + WS_U), *SA = (bf16*)(ws + WS_SA), *SC = (bf16*)(ws + WS_SC), *KV = (bf16*)(ws + WS_KV);
    float* xout = a.out;

#if !(MK_SKIP & 1)
    { const int tid = opaque_tid(), lane = tid & 63, wave = __builtin_amdgcn_readfirstlane(tid >> 6); prologue(a, lds, tid, lane, wave); }
#endif
    grid.sync();

#pragma nounroll
    for (int l = 0; l < 2; ++l) {
        const bf16* Wl = (const bf16*)(ws + WS_W) + (size_t)l * E_LAYER;
#if !(MK_SKIP & 2)
        { pg8::Gemm g{XB, Wl + E_W1GU, MT, 2 * DFF, DM}; pg8::StaticOrder S; S.init(MT, 2 * DFF, G, bx); pg8::EpiSwiGLU E{H, ss + (size_t)(3 * l) * MT};
          pg8::gemm_phase<pg8::EpiSwiGLU, pg8::StaticOrder, true, true>(lds, g, S, E); }
#endif
        grid.sync();
#if !(MK_SKIP & 4)
        { pg8::Gemm g{H, Wl + E_W1D, MT, DM, DFF}; pg8::StaticOrder S; S.init(MT, DM, G, bx);
          pg8::EpiResid E{l == 0 ? a.x_prompt : xout, l == 0 ? a.x_sample : xout + (size_t)MP * DM, xout, XB, ss + (size_t)(3 * l + 1) * MT, 0.5f};
          pg8::gemm_phase<pg8::EpiResid, pg8::StaticOrder, true, true>(lds, g, S, E); }
#endif
        grid.sync();
#if !(MK_SKIP & 8)
        { pg8::Gemm g{XB, Wl + E_WIN, MT, NIN, DM}; pg8::StaticOrder S; S.init(MT, NIN, G, bx);
          pg8::EpiMixIn E{ss + (size_t)(3 * l + 1) * MT, (const float*)(ws + WS_BIAS) + l * NIN, Q, KV, BG, U, SA, SC};
          pg8::gemm_phase<pg8::EpiMixIn, pg8::StaticOrder, true, true>(lds, g, S, E); }
#endif
        grid.sync();
#if !(MK_SKIP & 16)
        { const int tid = opaque_tid(), lane = tid & 63, wave = __builtin_amdgcn_readfirstlane(tid >> 6);
          const float* ck = a.cache_k + (size_t)l * 16 * 128 * 128; const float* cv = a.cache_v + (size_t)l * 16 * 128 * 128;
          for (int it = bx; it < N_ATT_ITEMS; it += G) attn_item(lds, Q, KV, ck, cv, a.sinks + l * 16, it, tid, lane, wave);
          for (int ch = bx; ch < MT / 16; ch += G) conv_chunk(BG, U, a.conv_w + (size_t)l * 3 * DM, a.state_conv + (size_t)l * 16 * 2 * DM, ch, tid);
          state_copies(a, l, KV, U, bx * NTHR + tid, G * NTHR); }
#endif
        grid.sync();
#if !(MK_SKIP & 32)
        { pg8::Gemm g{Q, Wl + E_WOA, MT, DM, DM}; pg8::StaticOrder S; S.init(MT, DM, G, bx); pg8::EpiGate E{SA, nullptr};
          pg8::gemm_phase<pg8::EpiGate, pg8::StaticOrder, true, true>(lds, g, S, E); }
        { pg8::Gemm g{BG, Wl + E_WOC, MT, DM, DM}; pg8::StaticOrder S; S.init(MT, DM, G, bx); pg8::EpiGate E{SC, SA};
          pg8::gemm_phase<pg8::EpiGate, pg8::StaticOrder, true, true>(lds, g, S, E); }
#endif
        grid.sync();
#if !(MK_SKIP & 64)
        { pg8::Gemm g{SC, Wl + E_WO, MT, DM, DM}; pg8::StaticOrder S; S.init(MT, DM, G, bx);
          pg8::EpiResid E{xout, xout + (size_t)MP * DM, xout, XB, ss + (size_t)(3 * l + 2) * MT, 1.0f};
          pg8::gemm_phase<pg8::EpiResid, pg8::StaticOrder, true, true>(lds, g, S, E); }
#endif
        grid.sync();
#if !(MK_SKIP & 128)
        { pg8::Gemm g{XB, Wl + E_W2GU, MT, 2 * DFF, DM}; pg8::StaticOrder S; S.init(MT, 2 * DFF, G, bx); pg8::EpiSwiGLU E{H, ss + (size_t)(3 * l + 2) * MT};
          pg8::gemm_phase<pg8::EpiSwiGLU, pg8::StaticOrder, true, true>(lds, g, S, E); }
#endif
        grid.sync();
#if !(MK_SKIP & 256)
        { pg8::Gemm g{H, Wl + E_W2D, MT, DM, DFF}; pg8::StaticOrder S; S.init(MT, DM, G, bx);
          pg8::EpiResid E{xout, xout + (size_t)MP * DM, xout, XB, ss + (size_t)(3 * l + 3) * MT, 0.5f};
          pg8::gemm_phase<pg8::EpiResid, pg8::StaticOrder, true, true>(lds, g, S, E); }
#endif
        grid.sync();
    }
    { const int tid = opaque_tid(), lane = tid & 63, wave = __builtin_amdgcn_readfirstlane(tid >> 6);
      const int gw = bx * NWAVES + wave, NGW = G * NWAVES; const float* ssf = ss + (size_t)6 * MT;
      f32x4 gv[4];
#pragma unroll
      for (int j = 0; j < 4; ++j) gv[j] = ((const f32x4*)a.norm_final)[lane + 64 * j];
      for (int m = gw; m < MT; m += NGW) { const float rs = __builtin_amdgcn_rsqf(ssf[m] * (1.0f / 1024.0f) + EPS); f32x4* xr = (f32x4*)(xout + (size_t)m * DM);
#pragma unroll
          for (int j = 0; j < 4; ++j) { const f32x4 v = xr[lane + 64 * j]; xr[lane + 64 * j] = v * rs * gv[j]; } } }
}

extern "C" void kernel_launch(void* const* d_in, const int* in_sizes, int n_in, void* d_out, int out_size, void* d_ws, size_t ws_size, hipStream_t stream) {
    static int grid = 0;
    if (grid == 0) {
        if (n_in != 22 || in_sizes[0] != MP * DM || (size_t)out_size != O_END || ws_size < WS_END) { fprintf(stderr, "kernel_launch: unexpected shapes (n_in %d, in0 %d, out %d, ws %zu)\n", n_in, n_in > 0 ? in_sizes[0] : -1, out_size, ws_size); grid = -1; return; }
        int dev = 0, cus = 0, per_cu = 0;
        hipGetDevice(&dev); hipDeviceGetAttribute(&cus, hipDeviceAttributeMultiprocessorCount, dev);
        if (hipFuncSetAttribute((const void*)fwd_megakernel, hipFuncAttributeMaxDynamicSharedMemorySize, LDS_BYTES) != hipSuccess) { fprintf(stderr, "kernel_launch: hipFuncSetAttribute failed\n"); grid = -1; return; }
        if (hipOccupancyMaxActiveBlocksPerMultiprocessor(&per_cu, (const void*)fwd_megakernel, NTHR, LDS_BYTES) != hipSuccess || per_cu < 1) { fprintf(stderr, "kernel_launch: occupancy query says %d\n", per_cu); per_cu = 1; }
        (void)hipGetLastError();
        grid = cus;
    }
    if (grid < 0) return;
    Args a{};
    a.x_prompt = (const float*)d_in[0]; a.x_sample = (const float*)d_in[1]; a.cache_k = (const float*)d_in[2]; a.cache_v = (const float*)d_in[3]; a.state_conv = (const float*)d_in[4];
    a.norm_ffn1 = (const float*)d_in[5]; a.w1_gate = (const float*)d_in[6]; a.w1_up = (const float*)d_in[7]; a.w1_down = (const float*)d_in[8];
    a.norm_mix = (const float*)d_in[9]; a.w_in = (const float*)d_in[10]; a.b_in = (const float*)d_in[11]; a.sinks = (const float*)d_in[12]; a.conv_w = (const float*)d_in[13];
    a.w_o_attn = (const float*)d_in[14]; a.w_o_conv = (const float*)d_in[15]; a.w_o = (const float*)d_in[16];
    a.norm_ffn2 = (const float*)d_in[17]; a.w2_gate = (const float*)d_in[18]; a.w2_up = (const float*)d_in[19]; a.w2_down = (const float*)d_in[20]; a.norm_final = (const float*)d_in[21];
    a.out = (float*)d_out; a.ws = (unsigned char*)d_ws;
    void* args[] = {&a};
    hipError_t e = hipLaunchCooperativeKernel((const void*)fwd_megakernel, dim3(grid), dim3(NTHR), args, LDS_BYTES, stream);
    if (e != hipSuccess) fprintf(stderr, "kernel_launch: cooperative launch failed: %s (grid %d)\n", hipGetErrorString(e), grid);
}
```

```cpp
#include <hip/hip_runtime.h>
#include <hip/hip_cooperative_groups.h>
#include <cstdio>
#include <cstdint>
namespace cg = cooperative_groups;

constexpr int DM = 1024, DFF = 2816, NIN = 6400;
constexpr int NB = 8, SEQ = 8192, SBAT = 16, SSEQ = 32;
constexpr int MP = NB * SEQ, MS = SBAT * SSEQ, MT = MP + MS;
constexpr float EPS = 1e-6f, LOG2E = 1.4426950408889634f;
constexpr float QSCALE = 0.125f * LOG2E;

typedef float f32x2_t __attribute__((ext_vector_type(2)));
typedef __bf16 bf16x2_t __attribute__((ext_vector_type(2)));
__device__ __forceinline__ unsigned cvtpk(float lo, float hi) { f32x2_t v = {lo, hi}; bf16x2_t b = __builtin_convertvector(v, bf16x2_t); return __builtin_bit_cast(unsigned, b); }
__device__ __forceinline__ float bflo(unsigned w) { return __uint_as_float(w << 16); }
__device__ __forceinline__ float bfhi(unsigned w) { return __uint_as_float(w & 0xffff0000u); }
__device__ __forceinline__ float fast_sigmoid(float z) { return __builtin_amdgcn_rcpf(1.0f + __builtin_amdgcn_exp2f(-z * LOG2E)); }

namespace pg8 {
#define PG8_LAS __attribute__((address_space(3)))
typedef unsigned short bf16_t;
typedef short bf16x8 __attribute__((ext_vector_type(8)));
typedef float f32x4 __attribute__((ext_vector_type(4)));
typedef unsigned u32x4 __attribute__((ext_vector_type(4)));
constexpr int BM = 256, BK = 64, HALF = 128, HTB = HALF * BK * 2  , STAGE_BYTES = 8 * HTB, NXCD = 8, WGM = 8;

__host__ __device__ __forceinline__ int lds_byte(int r, int c) { const int st = (r >> 4) * 2 + (c >> 5), rr = r & 15, cc = c & 31, ob = rr * 64 + cc * 2; return st * 1024 + (ob ^ (((ob >> 9) & 1) << 5)); }
__host__ __device__ __forceinline__ void stage_rc(int b, int& R, int& C) { const int st = b / 1024, sb = b % 1024, swz = sb ^ (((sb >> 9) & 1) << 5); R = (st >> 1) * 16 + swz / 64; C = (st & 1) * 32 + (swz % 64) / 2; }
__host__ __device__ __forceinline__ int perm32(int rho) { const int n = rho >> 4, i = rho & 15; return 8 * (i >> 2) + 4 * n + (i & 3); }

struct Unit { int pm, pn; };
struct Gemm { const bf16_t* A; const bf16_t* Bt; int M, N, K; };

struct StaticOrder {
    int nM, nN, nwg, G, c;
    __host__ __device__ void init(int M, int N, int G_, int c_) { nM = M / BM; nN = N / BM; nwg = nM * nN; G = G_; c = c_; }
    __host__ __device__ bool next(int i, Unit& u) const {
        const long L = (long)i * G + c; if (L >= nwg) return false;
        int wgid = (int)L; { const int q = nwg / NXCD, r = nwg % NXCD, xcd = wgid % NXCD, off = wgid / NXCD; wgid = (xcd < r ? xcd * (q + 1) : r * (q + 1) + (xcd - r) * q) + off; }
        const int nig = WGM * nN, gid = wgid / nig, fm = gid * WGM, gsz = (nM - fm) < WGM ? (nM - fm) : WGM;
        u.pm = fm + ((wgid % nig) % gsz); u.pn = (wgid % nig) / gsz; return true;
    }
    __device__ __forceinline__ void a_ready(const Unit&) const {}
    __device__ __forceinline__ void done(const Unit&) const {}
};

__device__ __forceinline__ float row_rs(const float* ss, int row) { const f32x4* p = (const f32x4*)(ss + (size_t)row * 16); const f32x4 a = p[0], b = p[1], c = p[2], d = p[3];
    const float s = ((a[0] + a[1]) + (a[2] + a[3])) + ((b[0] + b[1]) + (b[2] + b[3])) + ((c[0] + c[1]) + (c[2] + c[3])) + ((d[0] + d[1]) + (d[2] + d[3]));
    return __builtin_amdgcn_rsqf(s * (1.0f / 1024.0f) + EPS); }

struct EpiSwiGLU {
    static constexpr bool PERM = true, AFTER_DRAIN = false;
    bf16_t* H; const float* ss;
    __device__ __forceinline__ void operator()(const f32x4 (&acc)[2][2][4][2], const Unit& u, int wr, int wc, int fr, int fq) const {
        const int row0 = u.pm * BM + wr * 64 + fr, col0 = u.pn * 128 + wc * 32 + 8 * fq;
#pragma unroll
        for (int ai = 0; ai < 2; ++ai)
#pragma unroll
            for (int m = 0; m < 4; ++m) {
                const int row = row0 + ai * HALF + m * 16; const float rs = row_rs(ss, row);
                float h[8];
#pragma unroll
                for (int n = 0; n < 2; ++n)
#pragma unroll
                    for (int e = 0; e < 4; ++e) { const float g = acc[ai][0][m][n][e] * rs, up = acc[ai][1][m][n][e] * rs; h[n * 4 + e] = g * fast_sigmoid(g) * up; }
                u32x4 w; w.x = cvtpk(h[0], h[1]); w.y = cvtpk(h[2], h[3]); w.z = cvtpk(h[4], h[5]); w.w = cvtpk(h[6], h[7]);
                *(u32x4*)(H + (size_t)row * DFF + col0) = w;
            }
    }
};

struct EpiResid {
    static constexpr bool PERM = true, AFTER_DRAIN = false;
    bf16_t* xb; float* ssn; float scale;
    __device__ __forceinline__ void operator()(const f32x4 (&acc)[2][2][4][2], const Unit& u, int wr, int wc, int fr, int fq) const {
        const int row0 = u.pm * BM + wr * 64 + fr, col0 = u.pn * BM + wc * 32 + 8 * fq;
#pragma unroll
        for (int ai = 0; ai < 2; ++ai)
#pragma unroll
            for (int m = 0; m < 4; ++m) {
                const int row = row0 + ai * HALF + m * 16;
                bf16_t* xr = xb + (size_t)row * DM + col0;
                const u32x4 g0 = *(const u32x4*)xr, g1 = *(const u32x4*)(xr + HALF);
                float sq = 0.f;
#pragma unroll
                for (int bj = 0; bj < 2; ++bj) {
                    const u32x4 g = bj ? g1 : g0; const f32x4 p0 = acc[ai][bj][m][0], p1 = acc[ai][bj][m][1];
                    const float o0 = bflo(g.x) + scale * p0[0], o1 = bfhi(g.x) + scale * p0[1], o2 = bflo(g.y) + scale * p0[2], o3 = bfhi(g.y) + scale * p0[3];
                    const float o4 = bflo(g.z) + scale * p1[0], o5 = bfhi(g.z) + scale * p1[1], o6 = bflo(g.w) + scale * p1[2], o7 = bfhi(g.w) + scale * p1[3];
                    u32x4 w; w.x = cvtpk(o0, o1); w.y = cvtpk(o2, o3); w.z = cvtpk(o4, o5); w.w = cvtpk(o6, o7);
                    *(u32x4*)(xr + bj * HALF) = w;
                    sq += (o0 * o0 + o1 * o1) + (o2 * o2 + o3 * o3) + (o4 * o4 + o5 * o5) + (o6 * o6 + o7 * o7);
                }
                sq += __shfl_xor(sq, 16); sq += __shfl_xor(sq, 32);
                if (fq == 0) ssn[(size_t)row * 16 + u.pn * 4 + wc] = sq;
            }
    }
};

struct EpiMixIn {
    static constexpr bool PERM = true, AFTER_DRAIN = false;
    const float* ss; const float* bias; bf16_t *Q, *KV, *BG, *U, *SA, *SC;
    __device__ __forceinline__ void operator()(const f32x4 (&acc)[2][2][4][2], const Unit& u, int wr, int wc, int fr, int fq) const {
        const int pn = u.pn; bf16_t* dst; int ld, cbase, mode; float sc = 1.f;
        if (pn < 4) { dst = Q; ld = DM; cbase = pn * 256; mode = 0; sc = QSCALE; }
        else if (pn == 4) { dst = KV; ld = 256; cbase = 0; mode = 0; }
        else if (pn < 9) { dst = BG; ld = DM; cbase = (pn - 5) * 256; mode = 0; }
        else if (pn < 17) { dst = U; ld = DM; cbase = (pn - 9) * 128; mode = 2; }
        else if (pn < 21) { dst = SA; ld = DM; cbase = (pn - 17) * 256; mode = 1; }
        else { dst = SC; ld = DM; cbase = (pn - 21) * 256; mode = 1; }
        const int row0 = u.pm * BM + wr * 64 + fr, cw = wc * 32 + 8 * fq;
        f32x4 bv[2][2];
#pragma unroll
        for (int bj = 0; bj < 2; ++bj)
#pragma unroll
            for (int n = 0; n < 2; ++n) bv[bj][n] = *(const f32x4*)(bias + pn * 256 + bj * HALF + cw + 4 * n);
#pragma unroll
        for (int ai = 0; ai < 2; ++ai)
#pragma unroll
            for (int m = 0; m < 4; ++m) {
                const int row = row0 + ai * HALF + m * 16; const float rs = row_rs(ss, row);
                bf16_t* rowp = dst + (size_t)row * ld + cbase + cw;
                if (mode == 2) {
                    const f32x4 z0 = (acc[ai][0][m][0] * rs + bv[0][0]) * (acc[ai][1][m][0] * rs + bv[1][0]);
                    const f32x4 z1 = (acc[ai][0][m][1] * rs + bv[0][1]) * (acc[ai][1][m][1] * rs + bv[1][1]);
                    u32x4 w; w.x = cvtpk(z0[0], z0[1]); w.y = cvtpk(z0[2], z0[3]); w.z = cvtpk(z1[0], z1[1]); w.w = cvtpk(z1[2], z1[3]);
                    *(u32x4*)rowp = w;
                } else {
#pragma unroll
                    for (int bj = 0; bj < 2; ++bj) {
                        f32x4 z0 = acc[ai][bj][m][0] * rs + bv[bj][0], z1 = acc[ai][bj][m][1] * rs + bv[bj][1];
                        if (mode == 1) {
#pragma unroll
                            for (int e = 0; e < 4; ++e) { z0[e] = fast_sigmoid(z0[e]); z1[e] = fast_sigmoid(z1[e]); }
                        } else { z0 = z0 * sc; z1 = z1 * sc; }
                        u32x4 w; w.x = cvtpk(z0[0], z0[1]); w.y = cvtpk(z0[2], z0[3]); w.z = cvtpk(z1[0], z1[1]); w.w = cvtpk(z1[2], z1[3]);
                        *(u32x4*)(rowp + bj * HALF) = w;
                    }
                }
            }
    }
};

struct EpiGate {
    static constexpr bool PERM = true, AFTER_DRAIN = false;
    bf16_t* G; const bf16_t* ADD;
    __device__ __forceinline__ void operator()(const f32x4 (&acc)[2][2][4][2], const Unit& u, int wr, int wc, int fr, int fq) const {
        const int row0 = u.pm * BM + wr * 64 + fr, col0 = u.pn * BM + wc * 32 + 8 * fq;
#pragma unroll
        for (int ai = 0; ai < 2; ++ai)
#pragma unroll
            for (int m = 0; m < 4; ++m) {
                const int row = row0 + ai * HALF + m * 16;
#pragma unroll
                for (int bj = 0; bj < 2; ++bj) {
                    const size_t idx = (size_t)row * DM + col0 + bj * HALF;
                    const u32x4 g = *(const u32x4*)(G + idx);
                    u32x4 a = (u32x4){0u, 0u, 0u, 0u}; if (ADD) a = *(const u32x4*)(ADD + idx);
                    const f32x4 p0 = acc[ai][bj][m][0], p1 = acc[ai][bj][m][1];
                    u32x4 w;
                    w.x = cvtpk(bflo(a.x) + bflo(g.x) * p0[0], bfhi(a.x) + bfhi(g.x) * p0[1]);
                    w.y = cvtpk(bflo(a.y) + bflo(g.y) * p0[2], bfhi(a.y) + bfhi(g.y) * p0[3]);
                    w.z = cvtpk(bflo(a.z) + bflo(g.z) * p1[0], bfhi(a.z) + bfhi(g.z) * p1[1]);
                    w.w = cvtpk(bflo(a.w) + bflo(g.w) * p1[2], bfhi(a.w) + bfhi(g.w) * p1[3]);
                    *(u32x4*)(G + idx) = w;
                }
            }
    }
};

template <class Epi, class Sched, bool ALIGN_EPI = false, bool SP2 = false>
__device__ __forceinline__ void gemm_phase(PG8_LAS unsigned char* lds, const Gemm g, const Sched& S, const Epi& E) {
    int tid_ = threadIdx.x; asm volatile("" : "+v"(tid_));
    const int tid = tid_, wid = __builtin_amdgcn_readfirstlane(tid >> 6), lane = tid & 63, wr = wid >> 2, wc = wid & 3, fr = lane & 15, fq = lane >> 4;
    const int K = g.K, nt = K / BK;
    unsigned voffA[2], voffB[2];
#pragma unroll
    for (int i = 0; i < 2; ++i) { int R, C; stage_rc(tid * 16 + i * 8192, R, C); const int Rb = Epi::PERM ? ((R & ~31) + perm32(R & 31)) : R;
        voffA[i] = (unsigned)(R * K + C) * 2u; voffB[i] = (unsigned)(Rb * K + C) * 2u; }
    const size_t kstep = (size_t)(BK * 2);
    const size_t hstep = (size_t)HALF * K * 2;
    const size_t tstep = 2 * hstep;
    const unsigned ldsw = (unsigned)wid * 1024u;
    const int aoff = lds_byte(wr * 64 + fr, fq * 8), boff = lds_byte(wc * 32 + fr, fq * 8);
#define PG8_SA(b, h) (((b) * 2 + (h)) * HTB)
#define PG8_SB(b, h) ((4 + (b) * 2 + (h)) * HTB)
#define PG8_STAGE(bufoff, gbase, voff) do { _Pragma("unroll") for (int _i = 0; _i < 2; ++_i) \
        __builtin_amdgcn_global_load_lds((const unsigned*)((const char*)(gbase) + (voff)[_i]), (PG8_LAS unsigned*)(lds + (bufoff) + ldsw + _i * 8192), 16, 0, 0); } while (0)
#define PG8_LDA(dst, b, h) do { _Pragma("unroll") for (int m = 0; m < 4; ++m) _Pragma("unroll") for (int k = 0; k < 2; ++k) dst[m][k] = *(const PG8_LAS bf16x8*)(lds + PG8_SA(b, h) + aoff + m * 2048 + k * 1024); } while (0)
#define PG8_LDB(dst, b, h) do { _Pragma("unroll") for (int n = 0; n < 2; ++n) _Pragma("unroll") for (int k = 0; k < 2; ++k) dst[n][k] = *(const PG8_LAS bf16x8*)(lds + PG8_SB(b, h) + boff + n * 2048 + k * 1024); } while (0)
#define PG8_MMA(ai, bj, At, Bt) do { __builtin_amdgcn_s_setprio(1); _Pragma("unroll") for (int m = 0; m < 4; ++m) _Pragma("unroll") for (int n = 0; n < 2; ++n) _Pragma("unroll") for (int k = 0; k < 2; ++k) \
        acc[ai][bj][m][n] = __builtin_amdgcn_mfma_f32_16x16x32_bf16(Bt[n][k], At[m][k], acc[ai][bj][m][n], 0, 0, 0); __builtin_amdgcn_s_setprio(0); } while (0)
#define PG8_WAIT_V(n) asm volatile("s_waitcnt vmcnt(" #n ")" ::: "memory")
#define PG8_WAIT_L(n) asm volatile("s_waitcnt lgkmcnt(" #n ")" ::: "memory")
#define PG8_BAR __builtin_amdgcn_s_barrier()
#define PG8_SCHED __builtin_amdgcn_sched_barrier(0)
    Unit cur, nxt; int ui = 0;
    if (!S.next(0, cur)) return;
    f32x4 acc[2][2][4][2];
#pragma unroll
    for (int a = 0; a < 2; ++a)
#pragma unroll
        for (int b = 0; b < 2; ++b)
#pragma unroll
            for (int m = 0; m < 4; ++m)
#pragma unroll
                for (int n = 0; n < 2; ++n) acc[a][b][m][n] = (f32x4){0.f, 0.f, 0.f, 0.f};
    bf16x8 At[4][2], B0[2][2], B1[2][2];
    const char* cA = (const char*)g.A + (size_t)cur.pm * tstep; const char* cB = (const char*)g.Bt + (size_t)cur.pn * tstep;
    S.a_ready(cur);
    if constexpr (SP2) {
        PG8_STAGE(PG8_SB(0, 0), cB, voffB); PG8_STAGE(PG8_SB(0, 1), cB + hstep, voffB); PG8_STAGE(PG8_SA(0, 0), cA, voffA); PG8_STAGE(PG8_SA(0, 1), cA + hstep, voffA);
        if (wr == 1) PG8_BAR;
        PG8_WAIT_V(2); PG8_BAR;
        PG8_STAGE(PG8_SB(1, 0), cB + kstep, voffB); PG8_STAGE(PG8_SA(1, 0), cA + kstep, voffA); PG8_STAGE(PG8_SB(1, 1), cB + hstep + kstep, voffB);
        PG8_WAIT_V(6); PG8_BAR;
    } else {
        PG8_STAGE(PG8_SB(0, 0), cB, voffB); PG8_STAGE(PG8_SA(0, 0), cA, voffA); PG8_STAGE(PG8_SB(0, 1), cB + hstep, voffB); PG8_STAGE(PG8_SA(0, 1), cA + hstep, voffA);
        if (wr == 1) PG8_BAR;
        PG8_WAIT_V(4); PG8_BAR;
        PG8_STAGE(PG8_SB(1, 0), cB + kstep, voffB); PG8_STAGE(PG8_SA(1, 0), cA + kstep, voffA); PG8_STAGE(PG8_SB(1, 1), cB + hstep + kstep, voffB);
        PG8_WAIT_V(6); PG8_BAR;
    }
    for (;;) {
        const bool has_next = S.next(ui + 1, nxt);
        const char* nA = has_next ? (const char*)g.A + (size_t)nxt.pm * tstep : cA; const char* nB = has_next ? (const char*)g.Bt + (size_t)nxt.pn * tstep : cB;
        for (int t = 0; t < nt; t += 2) {
            const bool last = (t == nt - 2);
            const char* a1 = cA + (size_t)(t + 1) * kstep;
            const char* a2 = last ? nA : cA + (size_t)(t + 2) * kstep; const char* b2 = last ? nB : cB + (size_t)(t + 2) * kstep;
            const char* a3 = a2 + kstep; const char* b3 = b2 + kstep;
            if (last && has_next) S.a_ready(nxt);
            if constexpr (SP2) {
            PG8_LDB(B0, 0, 0); PG8_LDB(B1, 0, 1); PG8_SCHED; PG8_LDA(At, 0, 0); PG8_STAGE(PG8_SA(1, 1), a1 + hstep, voffA);
            PG8_WAIT_V(8); PG8_WAIT_L(0); PG8_BAR; PG8_MMA(0, 0, At, B0); PG8_MMA(0, 1, At, B1); PG8_BAR; PG8_SCHED;
            PG8_LDA(At, 0, 1); PG8_STAGE(PG8_SB(0, 0), b2, voffB); PG8_STAGE(PG8_SB(0, 1), b2 + hstep, voffB); PG8_STAGE(PG8_SA(0, 0), a2, voffA);
            PG8_WAIT_V(8); PG8_WAIT_L(0); PG8_BAR; PG8_MMA(1, 0, At, B0); PG8_MMA(1, 1, At, B1); PG8_BAR; PG8_SCHED;
            PG8_LDB(B0, 1, 0); PG8_LDB(B1, 1, 1); PG8_SCHED; PG8_LDA(At, 1, 0); PG8_STAGE(PG8_SA(0, 1), a2 + hstep, voffA);
            PG8_WAIT_V(8); PG8_WAIT_L(0); PG8_BAR; PG8_MMA(0, 0, At, B0); PG8_MMA(0, 1, At, B1); PG8_BAR; PG8_SCHED;
            PG8_LDA(At, 1, 1); PG8_STAGE(PG8_SB(1, 0), b3, voffB); PG8_STAGE(PG8_SB(1, 1), b3 + hstep, voffB); PG8_STAGE(PG8_SA(1, 0), a3, voffA);
            PG8_WAIT_V(8); PG8_WAIT_L(0); PG8_BAR; PG8_MMA(1, 0, At, B0); PG8_MMA(1, 1, At, B1); PG8_BAR; PG8_SCHED;
            } else {
            PG8_LDB(B0, 0, 0); PG8_SCHED; PG8_LDA(At, 0, 0); PG8_STAGE(PG8_SA(1, 1), a1 + hstep, voffA);
            PG8_WAIT_L(8); PG8_BAR; PG8_WAIT_L(0); PG8_MMA(0, 0, At, B0); PG8_BAR; PG8_SCHED;
            PG8_LDB(B1, 0, 1); PG8_STAGE(PG8_SB(0, 0), b2, voffB);
            PG8_BAR; PG8_WAIT_L(0); PG8_MMA(0, 1, At, B1); PG8_BAR;
            PG8_LDA(At, 0, 1); PG8_STAGE(PG8_SA(0, 0), a2, voffA);
            PG8_BAR; PG8_WAIT_L(0); PG8_MMA(1, 0, At, B0); PG8_BAR; PG8_SCHED;
            PG8_STAGE(PG8_SB(0, 1), b2 + hstep, voffB);
            PG8_WAIT_V(6); PG8_BAR; PG8_MMA(1, 1, At, B1); PG8_BAR;
            PG8_LDB(B0, 1, 0); PG8_SCHED; PG8_LDA(At, 1, 0); PG8_STAGE(PG8_SA(0, 1), a2 + hstep, voffA);
            PG8_WAIT_L(8); PG8_BAR; PG8_WAIT_L(0); PG8_MMA(0, 0, At, B0); PG8_BAR; PG8_SCHED;
            PG8_LDB(B1, 1, 1); PG8_STAGE(PG8_SB(1, 0), b3, voffB);
            PG8_BAR; PG8_WAIT_L(0); PG8_MMA(0, 1, At, B1); PG8_BAR;
            PG8_LDA(At, 1, 1); PG8_STAGE(PG8_SA(1, 0), a3, voffA);
            PG8_BAR; PG8_WAIT_L(0); PG8_MMA(1, 0, At, B0); PG8_BAR; PG8_SCHED;
            PG8_STAGE(PG8_SB(1, 1), b3 + hstep, voffB);
            PG8_WAIT_V(6); PG8_BAR; PG8_MMA(1, 1, At, B1); PG8_BAR;
            }
        }
        if constexpr (ALIGN_EPI) { if (wr == 0) PG8_BAR; }
        if constexpr (!Epi::AFTER_DRAIN) { E(acc, cur, wr, wc, fr, fq); S.done(cur); }
        if (!has_next) break;
#pragma unroll
        for (int a = 0; a < 2; ++a)
#pragma unroll
            for (int b = 0; b < 2; ++b)
#pragma unroll
                for (int m = 0; m < 4; ++m)
#pragma unroll
                    for (int n = 0; n < 2; ++n) acc[a][b][m][n] = (f32x4){0.f, 0.f, 0.f, 0.f};
        cur = nxt; cA = nA; cB = nB; ++ui;
        if constexpr (ALIGN_EPI) { if (wr == 1) PG8_BAR; }
    }
    PG8_WAIT_V(0);
    if constexpr (!ALIGN_EPI) { if (wr == 0) PG8_BAR; }
    PG8_BAR;
    if constexpr (Epi::AFTER_DRAIN) { E.fused(acc, cur, wr, wc, fr, fq, lds, wid, lane); S.done(cur); }
#undef PG8_SA
#undef PG8_SB
#undef PG8_STAGE
#undef PG8_LDA
#undef PG8_LDB
#undef PG8_MMA
#undef PG8_WAIT_V
#undef PG8_WAIT_L
#undef PG8_BAR
#undef PG8_SCHED
}
}

#define GAS __attribute__((address_space(1)))
#define LAS __attribute__((address_space(3)))
typedef unsigned short bf16;
typedef float f32x4 __attribute__((ext_vector_type(4)));
typedef float f32x16 __attribute__((ext_vector_type(16)));
typedef unsigned u32x4 __attribute__((ext_vector_type(4)));
typedef short bf16x8 __attribute__((ext_vector_type(8)));
typedef short s16x4 __attribute__((ext_vector_type(4)));
constexpr size_t MiB = 1u << 20;
constexpr size_t WS_SS = 960 * MiB;
constexpr size_t WS_BAR = 2 * MiB;
constexpr size_t WS_BIAS = 3 * MiB;
constexpr size_t WS_W = 4 * MiB;
constexpr size_t E_W1GU = 0, E_W1D = E_W1GU + (size_t)2 * DFF * DM, E_WIN = E_W1D + (size_t)DM * DFF, E_WOA = E_WIN + (size_t)NIN * DM, E_WOC = E_WOA + (size_t)DM * DM,
                 E_WO = E_WOC + (size_t)DM * DM, E_W2GU = E_WO + (size_t)DM * DM, E_W2D = E_W2GU + (size_t)2 * DFF * DM, E_LAYER = E_W2D + (size_t)DM * DFF;
constexpr size_t WS_XB = 116 * MiB;
constexpr size_t ACT = (size_t)MT * DM * 2;
constexpr size_t WS_Q = 246 * MiB, WS_BG = WS_Q + ACT, WS_U = WS_BG + ACT, WS_SA = WS_U + ACT, WS_SC = WS_SA + ACT, WS_KV = WS_SC + ACT, WS_END = WS_KV + (size_t)MT * 256 * 2;
constexpr size_t WS_H = WS_Q;
static_assert(WS_W + 2 * E_LAYER * 2 <= WS_XB && WS_XB + ACT <= WS_Q && WS_H + (size_t)MT * DFF * 2 <= WS_SA && WS_END <= WS_SS && WS_SS + (size_t)7 * MT * 64 <= (size_t)1024 * MiB, "d_ws map");
constexpr size_t O_YP = 0, O_YS = (size_t)MP * DM, O_KP = O_YS + (size_t)MS * DM, O_VP = O_KP + 2 * 8 * 128 * 128, O_CP = O_VP + 2 * 8 * 128 * 128, O_KS = O_CP + 2 * 8 * 2 * 1024,
                 O_VS = O_KS + 2 * 16 * 128 * 128, O_CS = O_VS + 2 * 16 * 128 * 128, O_END = O_CS + 2 * 16 * 2 * 1024;

#ifndef MK_SKIP
#define MK_SKIP 0
#endif
#ifndef MK_DUP
#define MK_DUP 0
#endif
constexpr int NWAVES = 8, NTHR = 512;
constexpr int LDS_BYTES = 135168;

struct Args {
    const float* x_prompt; const float* x_sample; const float* cache_k; const float* cache_v; const float* state_conv;
    const float* norm_ffn1; const float* w1_gate; const float* w1_up; const float* w1_down;
    const float* norm_mix; const float* w_in; const float* b_in; const float* sinks; const float* conv_w; const float* w_o_attn; const float* w_o_conv; const float* w_o;
    const float* norm_ffn2; const float* w2_gate; const float* w2_up; const float* w2_down; const float* norm_final;
    float* out; unsigned char* ws;
};

__device__ __forceinline__ float wave_sum(float v) {
#pragma unroll
    for (int o = 1; o < 64; o <<= 1) v += __shfl_xor(v, o);
    return v;
}
#define LDS_WAIT() asm volatile("s_waitcnt lgkmcnt(0)" ::: "memory")

__device__ __forceinline__ void transpose_item(const float* W, int K, int N, const float* gain, bf16* WT, int dst_row0, LAS float* scr, int k0, int n0, int lane) {
#pragma unroll 8
    for (int i = 0; i < 32; ++i) { const int kk = 2 * i + (lane >> 5); float v = W[(size_t)(k0 + kk) * N + n0 + (lane & 31)]; if (gain) v *= gain[k0 + kk]; scr[kk * 33 + (lane & 31)] = v; }
    LDS_WAIT(); asm volatile("" ::: "memory");
    const int c = lane & 7;
#pragma unroll
    for (int j = 0; j < 4; ++j) { const int n = (lane >> 3) + 8 * j; const LAS float* s = scr + (8 * c) * 33 + n;
        u32x4 o; o.x = cvtpk(s[0 * 33], s[1 * 33]); o.y = cvtpk(s[2 * 33], s[3 * 33]); o.z = cvtpk(s[4 * 33], s[5 * 33]); o.w = cvtpk(s[6 * 33], s[7 * 33]);
        *(u32x4*)(WT + (size_t)(dst_row0 + n) * K + k0 + 8 * c) = o; }
    LDS_WAIT(); asm volatile("" ::: "memory");
}
__device__ __forceinline__ int win_map(int n) {
    if (n < 2304 || n >= 4352) return n;
    if (n < 3328) { const int f = n - 2304; return 2304 + 256 * (f >> 7) + (f & 127); }
    const int f = n - 3328; return 2304 + 256 * (f >> 7) + 128 + (f & 127);
}
__device__ __forceinline__ int gu_map(int f, int up) { return 256 * (f >> 7) + 128 * up + (f & 127); }

__device__ __forceinline__ void prologue(const Args& a, LAS unsigned char* lds, int tid, int lane, int wave) {
    LAS float* scr = (LAS float*)(lds + wave * 16384);
    const int gw = blockIdx.x * NWAVES + wave, NGW = gridDim.x * NWAVES;
    bf16* Wb = (bf16*)(a.ws + WS_W);
    constexpr int I_G = 16 * 88, I_D = 44 * 32, I_IN = 16 * 200, I_O = 16 * 32, I_LAYER = 6 * I_G + I_IN + 3 * I_O;
    static_assert(I_G == I_D, "item counts");
    for (int it = gw; it < 2 * I_LAYER; it += NGW) {
        const int l = it / I_LAYER; int r = it - l * I_LAYER; bf16* Wl = Wb + (size_t)l * E_LAYER;
        if (r < 2 * I_G) { const int up = r >= I_G; if (up) r -= I_G; const int kb = r / 88, nb = r % 88;
            transpose_item((up ? a.w1_up : a.w1_gate) + (size_t)l * DM * DFF, DM, DFF, a.norm_ffn1 + l * DM, Wl + E_W1GU, gu_map(nb * 32, up), scr, kb * 64, nb * 32, lane); continue; } r -= 2 * I_G;
        if (r < I_D) { const int kb = r / 32, nb = r % 32; transpose_item(a.w1_down + (size_t)l * DFF * DM, DFF, DM, nullptr, Wl + E_W1D, nb * 32, scr, kb * 64, nb * 32, lane); continue; } r -= I_D;
        if (r < I_IN) { const int kb = r / 200, nb = r % 200; transpose_item(a.w_in + (size_t)l * DM * NIN, DM, NIN, a.norm_mix + l * DM, Wl + E_WIN, win_map(nb * 32), scr, kb * 64, nb * 32, lane); continue; } r -= I_IN;
        if (r < 3 * I_O) { const int w = r / I_O; r -= w * I_O; const int kb = r / 32, nb = r % 32; const float* src = (w == 0 ? a.w_o_attn : w == 1 ? a.w_o_conv : a.w_o) + (size_t)l * DM * DM;
            transpose_item(src, DM, DM, nullptr, Wl + (w == 0 ? E_WOA : w == 1 ? E_WOC : E_WO), nb * 32, scr, kb * 64, nb * 32, lane); continue; } r -= 3 * I_O;
        if (r < 2 * I_G) { const int up = r >= I_G; if (up) r -= I_G; const int kb = r / 88, nb = r % 88;
            transpose_item((up ? a.w2_up : a.w2_gate) + (size_t)l * DM * DFF, DM, DFF, a.norm_ffn2 + l * DM, Wl + E_W2GU, gu_map(nb * 32, up), scr, kb * 64, nb * 32, lane); continue; } r -= 2 * I_G;
        { const int kb = r / 32, nb = r % 32; transpose_item(a.w2_down + (size_t)l * DFF * DM, DFF, DM, nullptr, Wl + E_W2D, nb * 32, scr, kb * 64, nb * 32, lane); }
    }
    float* ss = (float*)(a.ws + WS_SS); bf16* XB = (bf16*)(a.ws + WS_XB);
    for (int m = gw; m < MT; m += NGW) {
        const float* xr = (m < MP) ? a.x_prompt + (size_t)m * DM : a.x_sample + (size_t)(m - MP) * DM;
        f32x4 v[4]; float s = 0.f;
#pragma unroll
        for (int j = 0; j < 4; ++j) { v[j] = ((const f32x4*)xr)[lane + 64 * j]; s += (v[j].x * v[j].x + v[j].y * v[j].y) + (v[j].z * v[j].z + v[j].w * v[j].w); }
        s = wave_sum(s); if (lane < 16) ss[(size_t)m * 16 + lane] = (lane == 0) ? s : 0.f;
        unsigned long long* o8 = (unsigned long long*)(XB + (size_t)m * DM) + lane;
#pragma unroll
        for (int j = 0; j < 4; ++j) o8[64 * j] = (unsigned long long)cvtpk(v[j].x, v[j].y) | ((unsigned long long)cvtpk(v[j].z, v[j].w) << 32);
    }
    const int gt = blockIdx.x * NTHR + tid, NGT = gridDim.x * NTHR;
    { unsigned* bw = (unsigned*)(a.ws + WS_BAR); for (int i = gt; i < 3456  ; i += NGT) bw[i] = 0u; }
    float* bp = (float*)(a.ws + WS_BIAS);
    for (int i = gt; i < 2 * NIN; i += NGT) { const int l = i / NIN, n = i - l * NIN; bp[l * NIN + win_map(n)] = a.b_in[i]; }
}

constexpr int KS_STRIDE = 144, VT_STRIDE = 408;
constexpr int LDS_KS = 0, LDS_VT = 192 * KS_STRIDE, LDS_WSF = LDS_VT + 64 * VT_STRIDE, ATT_LDS = LDS_WSF + NWAVES * 32 * 4;
constexpr int N_ATT_ITEMS = 32 + NB * 128 * 2;
__device__ __forceinline__ int crow(int r, int hi) { return (r & 3) + 8 * (r >> 2) + 4 * hi; }

__device__ __forceinline__ void attn_item(LAS unsigned char* lds, const bf16* QI, bf16* AO, const bf16* KV, const float* ck, const float* cv, const float* sinks, int item, int tid, int lane, int wave) {
    int qrow0, nqb, blo, bhi, h, sb = 0; long kvrow0 = 0; bool sample;
    if (item < 32) { sample = true; sb = item >> 1; h = item & 1; qrow0 = MP + sb * 32; nqb = 1; blo = 0; bhi = 5; }
    else { sample = false; const int it = item - 32; h = it & 1; const int c = (it >> 1) & 127, b = it >> 8; qrow0 = b * SEQ + c * 64; nqb = 2; blo = c >= 2 ? 0 : 2 * (2 - c); bhi = 6; kvrow0 = (long)b * SEQ + (long)(c - 2) * 64; }
    for (int ch = tid; ch < 1536; ch += NTHR) {
        const int j = ch >> 3, dg = ch & 7, blk = j >> 5;
        if (blk >= blo && blk < bhi) {
            u32x4 kx, vx;
            if (sample && j < 128) {
                const size_t o = ((size_t)(sb * 128 + j)) * 128 + h * 64 + dg * 8;
                const f32x4 k0 = *(const f32x4*)(ck + o), k1 = *(const f32x4*)(ck + o + 4), v0 = *(const f32x4*)(cv + o), v1 = *(const f32x4*)(cv + o + 4);
                kx.x = cvtpk(k0[0], k0[1]); kx.y = cvtpk(k0[2], k0[3]); kx.z = cvtpk(k1[0], k1[1]); kx.w = cvtpk(k1[2], k1[3]);
                vx.x = cvtpk(v0[0], v0[1]); vx.y = cvtpk(v0[2], v0[3]); vx.z = cvtpk(v1[0], v1[1]); vx.w = cvtpk(v1[2], v1[3]);
            } else {
                const long row = sample ? (long)(MP + sb * 32 + (j - 128)) : kvrow0 + j;
                const bf16* p = KV + (size_t)row * 256 + h * 64 + dg * 8;
                kx = *(const u32x4*)p; vx = *(const u32x4*)(p + 128);
            }
            *(LAS u32x4*)(lds + LDS_KS + j * KS_STRIDE + dg * 16) = kx;
            LAS unsigned short* vt = (LAS unsigned short*)(lds + LDS_VT + (dg * 8) * VT_STRIDE + j * 2);
            vt[0 * (VT_STRIDE / 2)] = (unsigned short)(vx.x & 0xffffu); vt[1 * (VT_STRIDE / 2)] = (unsigned short)(vx.x >> 16);
            vt[2 * (VT_STRIDE / 2)] = (unsigned short)(vx.y & 0xffffu); vt[3 * (VT_STRIDE / 2)] = (unsigned short)(vx.y >> 16);
            vt[4 * (VT_STRIDE / 2)] = (unsigned short)(vx.z & 0xffffu); vt[5 * (VT_STRIDE / 2)] = (unsigned short)(vx.z >> 16);
            vt[6 * (VT_STRIDE / 2)] = (unsigned short)(vx.w & 0xffffu); vt[7 * (VT_STRIDE / 2)] = (unsigned short)(vx.w >> 16);
        }
    }
    __syncthreads();
    const int r32 = lane & 31, hi = lane >> 5, head = h * 8 + wave;
    const float sink2 = sinks[head] * LOG2E;
    LAS float* wsf = (LAS float*)(lds + LDS_WSF) + wave * 32;
    for (int qb = 0; qb < nqb; ++qb) {
        const bf16* qp = QI + (size_t)(qrow0 + qb * 32 + r32) * DM + head * 64 + hi * 8;
        bf16x8 qf[4];
#pragma unroll
        for (int d0 = 0; d0 < 4; ++d0) qf[d0] = *(const bf16x8*)(qp + d0 * 16);
        f32x16 s[6];
#pragma unroll
        for (int kvb = 0; kvb < 6; ++kvb) {
            if (kvb >= blo && kvb < bhi) {
                f32x16 acc;
#pragma unroll
                for (int i = 0; i < 16; ++i) acc[i] = 0.f;
#pragma unroll
                for (int d0 = 0; d0 < 4; ++d0) { const bf16x8 kf = *(const LAS bf16x8*)(lds + LDS_KS + (kvb * 32 + r32) * KS_STRIDE + d0 * 32 + hi * 16);
                    acc = __builtin_amdgcn_mfma_f32_32x32x16_bf16(kf, qf[d0], acc, 0, 0, 0); }
                s[kvb] = acc;
            } else {
#pragma unroll
                for (int i = 0; i < 16; ++i) s[kvb][i] = -1e30f;
            }
        }
        float mx = sink2;
#pragma unroll
        for (int kvb = 0; kvb < 6; ++kvb)
#pragma unroll
            for (int i = 0; i < 16; ++i) mx = fmaxf(mx, s[kvb][i]);
        mx = fmaxf(mx, __shfl_xor(mx, 32));
        float sum = 0.f;
#pragma unroll
        for (int kvb = 0; kvb < 6; ++kvb)
#pragma unroll
            for (int i = 0; i < 16; ++i) { const float e = __builtin_amdgcn_exp2f(s[kvb][i] - mx); s[kvb][i] = e; sum += e; }
        sum += __shfl_xor(sum, 32);
        const float l = sum + __builtin_amdgcn_exp2f(sink2 - mx);
        f32x16 o[2];
#pragma unroll
        for (int i = 0; i < 16; ++i) { o[0][i] = 0.f; o[1][i] = 0.f; }
#pragma unroll
        for (int kvb = 0; kvb < 6; ++kvb) {
            if (kvb >= blo && kvb < bhi) {
#pragma unroll
                for (int st = 0; st < 2; ++st) {
                    u32x4 pw; pw.x = cvtpk(s[kvb][8 * st + 0], s[kvb][8 * st + 1]); pw.y = cvtpk(s[kvb][8 * st + 2], s[kvb][8 * st + 3]);
                    pw.z = cvtpk(s[kvb][8 * st + 4], s[kvb][8 * st + 5]); pw.w = cvtpk(s[kvb][8 * st + 6], s[kvb][8 * st + 7]);
                    const bf16x8 pf = __builtin_bit_cast(bf16x8, pw);
#pragma unroll
                    for (int db = 0; db < 2; ++db) {
                        const LAS unsigned char* vp = lds + LDS_VT + (db * 32 + r32) * VT_STRIDE + (kvb * 32 + 16 * st + 4 * hi) * 2;
                        const s16x4 lo = *(const LAS s16x4*)vp, hh = *(const LAS s16x4*)(vp + 16);
                        const bf16x8 vf = __builtin_shufflevector(lo, hh, 0, 1, 2, 3, 4, 5, 6, 7);
                        o[db] = __builtin_amdgcn_mfma_f32_32x32x16_bf16(pf, vf, o[db], 0, 0, 0);
                    }
                }
            }
        }
        if (hi == 0) wsf[r32] = l;
        LDS_WAIT(); __builtin_amdgcn_wave_barrier(); asm volatile("" ::: "memory");
        bf16* op = AO + (size_t)(qrow0 + qb * 32) * DM + head * 64 + r32;
#pragma unroll
        for (int i = 0; i < 16; ++i) {
            const int q = crow(i, hi); const float rl = __builtin_amdgcn_rcpf(wsf[q]);
            const unsigned w0 = cvtpk(o[0][i] * rl, o[1][i] * rl);
            op[(size_t)q * DM] = (unsigned short)(w0 & 0xffffu); op[(size_t)q * DM + 32] = (unsigned short)(w0 >> 16);
        }
        LDS_WAIT(); __builtin_amdgcn_wave_barrier(); asm volatile("" ::: "memory");
    }
    __syncthreads();
}

__device__ __forceinline__ void conv_chunk(bf16* BG, const bf16* U, const float* cw, const float* st  , int chunk, int tid) {
    const int cgp = tid & 127, rsub = tid >> 7, c0 = cgp * 8;
    const int t0 = chunk * 16 + rsub * 4;
    float w[3][8];
#pragma unroll
    for (int j = 0; j < 3; ++j) { const f32x4 a = *(const f32x4*)(cw + j * DM + c0), b = *(const f32x4*)(cw + j * DM + c0 + 4);
#pragma unroll
        for (int e = 0; e < 4; ++e) { w[j][e] = a[e]; w[j][4 + e] = b[e]; } }
    float p2[8], p1[8];
    const int pos = (t0 < MP) ? (t0 & (SEQ - 1)) : ((t0 - MP) & (SSEQ - 1));
    if (pos == 0) {
        if (t0 < MP) {
#pragma unroll
            for (int e = 0; e < 8; ++e) { p2[e] = 0.f; p1[e] = 0.f; }
        } else {
            const float* s0 = st + (size_t)((t0 - MP) / SSEQ) * 2 * DM + c0;
            const f32x4 a = *(const f32x4*)s0, b = *(const f32x4*)(s0 + 4), c = *(const f32x4*)(s0 + DM), d = *(const f32x4*)(s0 + DM + 4);
#pragma unroll
            for (int e = 0; e < 4; ++e) { p2[e] = a[e]; p2[4 + e] = b[e]; p1[e] = c[e]; p1[4 + e] = d[e]; }
        }
    } else {
        const u32x4 a = *(const u32x4*)(U + (size_t)(t0 - 2) * DM + c0), b = *(const u32x4*)(U + (size_t)(t0 - 1) * DM + c0);
        p2[0] = bflo(a.x); p2[1] = bfhi(a.x); p2[2] = bflo(a.y); p2[3] = bfhi(a.y); p2[4] = bflo(a.z); p2[5] = bfhi(a.z); p2[6] = bflo(a.w); p2[7] = bfhi(a.w);
        p1[0] = bflo(b.x); p1[1] = bfhi(b.x); p1[2] = bflo(b.y); p1[3] = bfhi(b.y); p1[4] = bflo(b.z); p1[5] = bfhi(b.z); p1[6] = bflo(b.w); p1[7] = bfhi(b.w);
    }
#pragma unroll
    for (int r = 0; r < 4; ++r) {
        const size_t idx = (size_t)(t0 + r) * DM + c0;
        const u32x4 uu = *(const u32x4*)(U + idx), gg = *(const u32x4*)(BG + idx);
        float cu[8], g[8], o[8];
        cu[0] = bflo(uu.x); cu[1] = bfhi(uu.x); cu[2] = bflo(uu.y); cu[3] = bfhi(uu.y); cu[4] = bflo(uu.z); cu[5] = bfhi(uu.z); cu[6] = bflo(uu.w); cu[7] = bfhi(uu.w);
        g[0] = bflo(gg.x); g[1] = bfhi(gg.x); g[2] = bflo(gg.y); g[3] = bfhi(gg.y); g[4] = bflo(gg.z); g[5] = bfhi(gg.z); g[6] = bflo(gg.w); g[7] = bfhi(gg.w);
#pragma unroll
        for (int e = 0; e < 8; ++e) { o[e] = g[e] * (w[0][e] * p2[e] + w[1][e] * p1[e] + w[2][e] * cu[e]); p2[e] = p1[e]; p1[e] = cu[e]; }
        u32x4 ww; ww.x = cvtpk(o[0], o[1]); ww.y = cvtpk(o[2], o[3]); ww.z = cvtpk(o[4], o[5]); ww.w = cvtpk(o[6], o[7]);
        *(u32x4*)(BG + idx) = ww;
    }
}

__device__ __forceinline__ f32x4 bf4(const bf16* p) { const uint2 w = *(const uint2*)p; return (f32x4){bflo(w.x), bfhi(w.x), bflo(w.y), bfhi(w.y)}; }
__device__ __forceinline__ void state_copies(const Args& a, int l, const bf16* KV, const bf16* U, int gt, int NGT) {
    constexpr int N_KP = 8 * 128 * 128 / 4, N_CP = 8 * 2 * 1024 / 4, N_KS = 16 * 128 * 128 / 4, N_CS = 16 * 2 * 1024 / 4;
    constexpr int TOT = 2 * N_KP + N_CP + 2 * N_KS + N_CS;
    float* out = a.out;
    for (int i = gt; i < TOT; i += NGT) {
        int r = i;
        if (r < 2 * N_KP) { const int v = r >= N_KP; if (v) r -= N_KP; const int e = r * 4, hd = e & 127, j = (e >> 7) & 127, b = e >> 14;
            *(f32x4*)(out + (v ? O_VP : O_KP) + (size_t)l * 8 * 128 * 128 + e) = bf4(KV + (size_t)(b * SEQ + SEQ - 128 + j) * 256 + v * 128 + hd); continue; } r -= 2 * N_KP;
        if (r < N_CP) { const int e = r * 4, c = e & 1023, ii = (e >> 10) & 1, b = e >> 11;
            *(f32x4*)(out + O_CP + (size_t)l * 8 * 2 * 1024 + e) = bf4(U + (size_t)(b * SEQ + SEQ - 2 + ii) * DM + c); continue; } r -= N_CP;
        if (r < 2 * N_KS) { const int v = r >= N_KS; if (v) r -= N_KS; const int e = r * 4, hd = e & 127, j = (e >> 7) & 127, b = e >> 14;
            f32x4 val;
            if (j < 96) val = *(const f32x4*)((v ? a.cache_v : a.cache_k) + ((size_t)(l * 16 + b) * 128 + 32 + j) * 128 + hd);
            else val = bf4(KV + (size_t)(MP + b * SSEQ + j - 96) * 256 + v * 128 + hd);
            *(f32x4*)(out + (v ? O_VS : O_KS) + (size_t)l * 16 * 128 * 128 + e) = val; continue; } r -= 2 * N_KS;
        { const int e = r * 4, c = e & 1023, ii = (e >> 10) & 1, b = e >> 11;
            *(f32x4*)(out + O_CS + (size_t)l * 16 * 2 * 1024 + e) = bf4(U + (size_t)(MP + b * SSEQ + SSEQ - 2 + ii) * DM + c); }
    }
}

#define RLX_AGENT __ATOMIC_RELAXED, __HIP_MEMORY_SCOPE_AGENT
#define XB_TMO      128
#define XB_XCNT(j)  (256  + 64 * (j))
#define XB_XSUB(j)  (1280 + 64 * (j))
#define XB_XGEN(j)  (2304 + 64 * (j))
#define XB_TOP      3328
#define XB_TOPGEN   3392
#define XCD_BAR_WORDS 3456
#define XB_SPIN_CAP (1u << 18)

__device__ __forceinline__ unsigned xb_ld(unsigned* p)              { return __hip_atomic_load(p, __ATOMIC_RELAXED, __HIP_MEMORY_SCOPE_AGENT); }
__device__ __forceinline__ unsigned xb_add(unsigned* p, unsigned v) { return __hip_atomic_fetch_add(p, v, __ATOMIC_RELAXED, __HIP_MEMORY_SCOPE_AGENT); }
__device__ __forceinline__ unsigned xb_xcc_id() { return (unsigned)__builtin_amdgcn_s_getreg((3 << 11) | 20) & 0xFu; }
#define XB_SPIN(cond, bar) do { unsigned _sp = 0; while (cond) { __builtin_amdgcn_s_sleep(1); \
    if ((++_sp & 255u) == 0u) { if (xb_ld(&(bar)[XB_TMO])) break; if (_sp > XB_SPIN_CAP) { atomicAdd(&(bar)[XB_TMO], 1u); break; } } } } while (0)

struct XcdBarrier {
    unsigned* bar; unsigned x;
    volatile LAS unsigned* st;
};

__device__ __forceinline__ XcdBarrier xcd_barrier_post(unsigned* bar, volatile LAS unsigned* st) {
    XcdBarrier b; b.bar = bar; b.x = xb_xcc_id(); b.st = st;
    if (threadIdx.x == 0) (void)xb_add(&bar[XB_XCNT(b.x)], 1u);
    return b;
}
__device__ __forceinline__ void xcd_barrier_complete(unsigned* bar, unsigned x, unsigned& nloc, unsigned& nx) {
    const unsigned G = gridDim.x * gridDim.y * gridDim.z;
    unsigned sum, cnt, mine, sp = 0u;
    for (;;) {
        sum = 0u; cnt = 0u; mine = 0u;
#pragma unroll
        for (unsigned j = 0; j < 16; ++j) { const unsigned c = xb_ld(&bar[XB_XCNT(j)]); sum += c; cnt += (c > 0u) ? 1u : 0u; mine = (j == x) ? c : mine; }
        if (sum == G) break;
        __builtin_amdgcn_s_sleep(1);
        if ((++sp & 255u) == 0u) { if (xb_ld(&bar[XB_TMO])) break; if (sp > XB_SPIN_CAP) { atomicAdd(&bar[XB_TMO], 1u); break; } }
    }
    nloc = mine > 0u ? mine : 1u; nx = cnt > 0u ? cnt : 1u;
}

__device__ __forceinline__ void xcd_barrier(const XcdBarrier& b) {
    asm volatile("s_waitcnt vmcnt(0)" ::: "memory");
    __syncthreads();
    if (threadIdx.x == 0) {
        unsigned* bar = b.bar;
        __builtin_amdgcn_s_waitcnt(0);
        unsigned nloc = b.st[0], nx = b.st[1];
        if (nloc == 0u) { xcd_barrier_complete(bar, b.x, nloc, nx); b.st[0] = nloc; b.st[1] = nx; }
        const unsigned old = xb_add(&bar[XB_XSUB(b.x)], 1u);
        const unsigned gen = old / nloc;
        if (old + 1u == (gen + 1u) * nloc) {
            __builtin_amdgcn_fence(__ATOMIC_RELEASE, "agent");
            asm volatile("s_waitcnt vmcnt(0)" ::: "memory");
            const unsigned og = xb_add(&bar[XB_TOP], 1u);
            const unsigned tg = og / nx;
            if (og + 1u == (tg + 1u) * nx) xb_add(&bar[XB_TOPGEN], 1u);
            else XB_SPIN(xb_ld(&bar[XB_TOPGEN]) == tg, bar);
            __builtin_amdgcn_fence(__ATOMIC_ACQUIRE, "agent");
            xb_add(&bar[XB_XGEN(b.x)], 1u);
            asm volatile("s_waitcnt vmcnt(0)" ::: "memory");
        } else {
            XB_SPIN(xb_ld(&bar[XB_XGEN(b.x)]) == gen, bar);
            __builtin_amdgcn_fence(__ATOMIC_ACQUIRE, "agent");
            asm volatile("s_waitcnt vmcnt(0)" ::: "memory");
        }
    }
    __syncthreads();
}

__device__ __forceinline__ int opaque_tid() { int t = threadIdx.x; asm volatile("" : "+v"(t)); return t; }
__global__ void __launch_bounds__(NTHR, 2) fwd_megakernel(Args a) {
    extern __shared__ __attribute__((aligned(16))) unsigned char lds_raw[];
    LAS unsigned char* lds = (LAS unsigned char*)lds_raw;
    cg::grid_group grid = cg::this_grid();
    volatile LAS unsigned* bar_st = (volatile LAS unsigned*)(lds + 131072 + 64);
    if (threadIdx.x < 2) bar_st[threadIdx.x] = 0u;
    __syncthreads();
    const int G = gridDim.x, bx = blockIdx.x;
    unsigned char* ws = a.ws;
    float* ss = (float*)(ws + WS_SS);
    bf16* XB = (bf16*)(ws + WS_XB); bf16* H = (bf16*)(ws + WS_H);
    bf16 *Q = (bf16*)(ws + WS_Q), *BG = (bf16*)(ws + WS_BG), *U = (bf16*)(ws + WS_U), *SA = (bf16*)(ws + WS_SA), *SC = (bf16*)(ws + WS_SC), *KV = (bf16*)(ws + WS_KV);
    float* xout = a.out;

#if !(MK_SKIP & 1)
    { const int tid = opaque_tid(), lane = tid & 63, wave = __builtin_amdgcn_readfirstlane(tid >> 6); prologue(a, lds, tid, lane, wave);
      if (MK_DUP & 1) { __syncthreads(); prologue(a, lds, tid, lane, wave); } }
#endif
    grid.sync();
    const XcdBarrier bar = xcd_barrier_post((unsigned*)(a.ws + WS_BAR), bar_st);

#pragma nounroll
    for (int l = 0; l < 2; ++l) {
        const bf16* Wl = (const bf16*)(ws + WS_W) + (size_t)l * E_LAYER;
#if !(MK_SKIP & 2)
        { pg8::Gemm g{XB, Wl + E_W1GU, MT, 2 * DFF, DM}; pg8::StaticOrder S; S.init(MT, 2 * DFF, G, bx); pg8::EpiSwiGLU E{H, ss + (size_t)(3 * l) * MT * 16};
          pg8::gemm_phase<pg8::EpiSwiGLU, pg8::StaticOrder, true, true>(lds, g, S, E);
          if (MK_DUP & 2) pg8::gemm_phase<pg8::EpiSwiGLU, pg8::StaticOrder, true, true>(lds, g, S, E); }
#endif
        xcd_barrier(bar);
        if (MK_DUP & 8) xcd_barrier(bar);
#if !(MK_SKIP & 4)
        { pg8::Gemm g{H, Wl + E_W1D, MT, DM, DFF}; pg8::StaticOrder S; S.init(MT, DM, G, bx);
          pg8::EpiResid E{XB, ss + (size_t)(3 * l + 1) * MT * 16, 0.5f};
          pg8::gemm_phase<pg8::EpiResid, pg8::StaticOrder, true, true>(lds, g, S, E); }
#endif
        xcd_barrier(bar);
        if (MK_DUP & 8) xcd_barrier(bar);
#if !(MK_SKIP & 8)
        { pg8::Gemm g{XB, Wl + E_WIN, MT, NIN, DM}; pg8::StaticOrder S; S.init(MT, NIN, G, bx);
          pg8::EpiMixIn E{ss + (size_t)(3 * l + 1) * MT * 16, (const float*)(ws + WS_BIAS) + l * NIN, Q, KV, BG, U, SA, SC};
          pg8::gemm_phase<pg8::EpiMixIn, pg8::StaticOrder, true, true>(lds, g, S, E); }
#endif
        xcd_barrier(bar);
        if (MK_DUP & 8) xcd_barrier(bar);
#if !(MK_SKIP & 16)
        { const int tid = opaque_tid(), lane = tid & 63, wave = __builtin_amdgcn_readfirstlane(tid >> 6);
          const float* ck = a.cache_k + (size_t)l * 16 * 128 * 128; const float* cv = a.cache_v + (size_t)l * 16 * 128 * 128;
          for (int it = bx; it < N_ATT_ITEMS; it += G) attn_item(lds, Q, Q, KV, ck, cv, a.sinks + l * 16, it, tid, lane, wave);
          for (int ch = bx; ch < MT / 16; ch += G) conv_chunk(BG, U, a.conv_w + (size_t)l * 3 * DM, a.state_conv + (size_t)l * 16 * 2 * DM, ch, tid);
          state_copies(a, l, KV, U, bx * NTHR + tid, G * NTHR); }
#endif
        xcd_barrier(bar);
        if (MK_DUP & 8) xcd_barrier(bar);
#if !(MK_SKIP & 32)
        { pg8::Gemm g{Q, Wl + E_WOA, MT, DM, DM}; pg8::StaticOrder S; S.init(MT, DM, G, bx); pg8::EpiGate E{SA, nullptr};
          pg8::gemm_phase<pg8::EpiGate, pg8::StaticOrder, true, true>(lds, g, S, E); }
        { pg8::Gemm g{BG, Wl + E_WOC, MT, DM, DM}; pg8::StaticOrder S; S.init(MT, DM, G, bx); pg8::EpiGate E{SC, SA};
          pg8::gemm_phase<pg8::EpiGate, pg8::StaticOrder, true, true>(lds, g, S, E); }
#endif
        xcd_barrier(bar);
        if (MK_DUP & 8) xcd_barrier(bar);
#if !(MK_SKIP & 64)
        { pg8::Gemm g{SC, Wl + E_WO, MT, DM, DM}; pg8::StaticOrder S; S.init(MT, DM, G, bx);
          pg8::EpiResid E{XB, ss + (size_t)(3 * l + 2) * MT * 16, 1.0f};
          pg8::gemm_phase<pg8::EpiResid, pg8::StaticOrder, true, true>(lds, g, S, E); }
#endif
        xcd_barrier(bar);
        if (MK_DUP & 8) xcd_barrier(bar);
#if !(MK_SKIP & 128)
        { pg8::Gemm g{XB, Wl + E_W2GU, MT, 2 * DFF, DM}; pg8::StaticOrder S; S.init(MT, 2 * DFF, G, bx); pg8::EpiSwiGLU E{H, ss + (size_t)(3 * l + 2) * MT * 16};
          pg8::gemm_phase<pg8::EpiSwiGLU, pg8::StaticOrder, true, true>(lds, g, S, E); }
#endif
        xcd_barrier(bar);
        if (MK_DUP & 8) xcd_barrier(bar);
#if !(MK_SKIP & 256)
        { pg8::Gemm g{H, Wl + E_W2D, MT, DM, DFF}; pg8::StaticOrder S; S.init(MT, DM, G, bx);
          pg8::EpiResid E{XB, ss + (size_t)(3 * l + 3) * MT * 16, 0.5f};
          pg8::gemm_phase<pg8::EpiResid, pg8::StaticOrder, true, true>(lds, g, S, E); }
#endif
        xcd_barrier(bar);
        if (MK_DUP & 8) xcd_barrier(bar);
    }
    { const int tid = opaque_tid(), lane = tid & 63, wave = __builtin_amdgcn_readfirstlane(tid >> 6);
      const int gw = bx * NWAVES + wave, NGW = G * NWAVES; const float* ssf = ss + (size_t)6 * MT * 16;
      f32x4 gv[4];
#pragma unroll
      for (int j = 0; j < 4; ++j) gv[j] = ((const f32x4*)a.norm_final)[lane + 64 * j];
      for (int m = gw; m < MT; m += NGW) { const float rs = pg8::row_rs(ssf, m); f32x4* yr = (f32x4*)(xout + (size_t)m * DM); const uint2* xr = (const uint2*)(XB + (size_t)m * DM);
#pragma unroll
          for (int j = 0; j < 4; ++j) { const uint2 w = xr[lane + 64 * j]; const f32x4 v = (f32x4){bflo(w.x), bfhi(w.x), bflo(w.y), bfhi(w.y)}; yr[lane + 64 * j] = v * rs * gv[j]; } } }
}

extern "C" void kernel_launch(void* const* d_in, const int* in_sizes, int n_in, void* d_out, int out_size, void* d_ws, size_t ws_size, hipStream_t stream) {
    static int grid = 0;
    if (grid == 0) {
        if (n_in != 22 || in_sizes[0] != MP * DM || (size_t)out_size != O_END || ws_size < WS_SS + (size_t)7 * MT * 64) { fprintf(stderr, "kernel_launch: unexpected shapes (n_in %d, in0 %d, out %d, ws %zu)\n", n_in, n_in > 0 ? in_sizes[0] : -1, out_size, ws_size); grid = -1; return; }
        int dev = 0, cus = 0, per_cu = 0;
        hipGetDevice(&dev); hipDeviceGetAttribute(&cus, hipDeviceAttributeMultiprocessorCount, dev);
        if (hipFuncSetAttribute((const void*)fwd_megakernel, hipFuncAttributeMaxDynamicSharedMemorySize, LDS_BYTES) != hipSuccess) { fprintf(stderr, "kernel_launch: hipFuncSetAttribute failed\n"); grid = -1; return; }
        if (hipOccupancyMaxActiveBlocksPerMultiprocessor(&per_cu, (const void*)fwd_megakernel, NTHR, LDS_BYTES) != hipSuccess || per_cu < 1) { fprintf(stderr, "kernel_launch: occupancy query says %d\n", per_cu); per_cu = 1; }
        (void)hipGetLastError();
        grid = cus;
    }
    if (grid < 0) return;
    Args a{};
    a.x_prompt = (const float*)d_in[0]; a.x_sample = (const float*)d_in[1]; a.cache_k = (const float*)d_in[2]; a.cache_v = (const float*)d_in[3]; a.state_conv = (const float*)d_in[4];
    a.norm_ffn1 = (const float*)d_in[5]; a.w1_gate = (const float*)d_in[6]; a.w1_up = (const float*)d_in[7]; a.w1_down = (const float*)d_in[8];
    a.norm_mix = (const float*)d_in[9]; a.w_in = (const float*)d_in[10]; a.b_in = (const float*)d_in[11]; a.sinks = (const float*)d_in[12]; a.conv_w = (const float*)d_in[13];
    a.w_o_attn = (const float*)d_in[14]; a.w_o_conv = (const float*)d_in[15]; a.w_o = (const float*)d_in[16];
    a.norm_ffn2 = (const float*)d_in[17]; a.w2_gate = (const float*)d_in[18]; a.w2_up = (const float*)d_in[19]; a.w2_down = (const float*)d_in[20]; a.norm_final = (const float*)d_in[21];
    a.out = (float*)d_out; a.ws = (unsigned char*)d_ws;
    void* args[] = {&a};
    hipError_t e = hipLaunchCooperativeKernel((const void*)fwd_megakernel, dim3(grid), dim3(NTHR), args, LDS_BYTES, stream);
    if (e != hipSuccess) fprintf(stderr, "kernel_launch: cooperative launch failed: %s (grid %d)\n", hipGetErrorString(e), grid);
}
```

```cpp
#include <hip/hip_runtime.h>
#include <hip/hip_cooperative_groups.h>
#include <cstdio>
#include <cstdint>
namespace cg = cooperative_groups;

constexpr int DM = 1024, DFF = 2816, NIN = 6400;
constexpr int NB = 8, SEQ = 8192, SBAT = 16, SSEQ = 32;
constexpr int MP = NB * SEQ, MS = SBAT * SSEQ, MT = MP + MS;
constexpr float EPS = 1e-6f, LOG2E = 1.4426950408889634f;
constexpr float QSCALE = 0.125f * LOG2E;

typedef float f32x2_t __attribute__((ext_vector_type(2)));
typedef __bf16 bf16x2_t __attribute__((ext_vector_type(2)));
__device__ __forceinline__ unsigned cvtpk(float lo, float hi) { f32x2_t v = {lo, hi}; bf16x2_t b = __builtin_convertvector(v, bf16x2_t); return __builtin_bit_cast(unsigned, b); }
__device__ __forceinline__ float bflo(unsigned w) { return __uint_as_float(w << 16); }
__device__ __forceinline__ float bfhi(unsigned w) { return __uint_as_float(w & 0xffff0000u); }
__device__ __forceinline__ float fast_sigmoid(float z) { return __builtin_amdgcn_rcpf(1.0f + __builtin_amdgcn_exp2f(-z * LOG2E)); }

namespace pg8 {
#define PG8_LAS __attribute__((address_space(3)))
typedef unsigned short bf16_t;
typedef short bf16x8 __attribute__((ext_vector_type(8)));
typedef float f32x4 __attribute__((ext_vector_type(4)));
typedef unsigned u32x4 __attribute__((ext_vector_type(4)));
constexpr int BM = 256, BK = 64, HALF = 128, HTB = HALF * BK * 2  , STAGE_BYTES = 8 * HTB, NXCD = 8, WGM = 8;

__host__ __device__ __forceinline__ int lds_byte(int r, int c) { const int st = (r >> 4) * 2 + (c >> 5), rr = r & 15, cc = c & 31, ob = rr * 64 + cc * 2; return st * 1024 + (ob ^ (((ob >> 9) & 1) << 5)); }
__host__ __device__ __forceinline__ void stage_rc(int b, int& R, int& C) { const int st = b / 1024, sb = b % 1024, swz = sb ^ (((sb >> 9) & 1) << 5); R = (st >> 1) * 16 + swz / 64; C = (st & 1) * 32 + (swz % 64) / 2; }
__host__ __device__ __forceinline__ int perm32(int rho) { const int n = rho >> 4, i = rho & 15; return 8 * (i >> 2) + 4 * n + (i & 3); }

struct Unit { int pm, pn; };
struct Gemm { const bf16_t* A; const bf16_t* Bt; int M, N, K; };

struct StaticOrder {
    int nM, nN, nwg, G, c;
    __host__ __device__ void init(int M, int N, int G_, int c_) { nM = M / BM; nN = N / BM; nwg = nM * nN; G = G_; c = c_; }
    __host__ __device__ bool next(int i, Unit& u) const {
        const long L = (long)i * G + c; if (L >= nwg) return false;
        int wgid = (int)L; { const int q = nwg / NXCD, r = nwg % NXCD, xcd = wgid % NXCD, off = wgid / NXCD; wgid = (xcd < r ? xcd * (q + 1) : r * (q + 1) + (xcd - r) * q) + off; }
        const int nig = WGM * nN, gid = wgid / nig, fm = gid * WGM, gsz = (nM - fm) < WGM ? (nM - fm) : WGM;
        u.pm = fm + ((wgid % nig) % gsz); u.pn = (wgid % nig) / gsz; return true;
    }
    __device__ __forceinline__ void a_ready(const Unit&) const {}
    __device__ __forceinline__ void done(const Unit&) const {}
};

__device__ __forceinline__ float row_rs(const float* ss, int row) { const f32x4* p = (const f32x4*)(ss + (size_t)row * 16); const f32x4 a = p[0], b = p[1], c = p[2], d = p[3];
    const float s = ((a[0] + a[1]) + (a[2] + a[3])) + ((b[0] + b[1]) + (b[2] + b[3])) + ((c[0] + c[1]) + (c[2] + c[3])) + ((d[0] + d[1]) + (d[2] + d[3]));
    return __builtin_amdgcn_rsqf(s * (1.0f / 1024.0f) + EPS); }

struct EpiSwiGLU {
    static constexpr bool PERM = true, AFTER_DRAIN = false;
    bf16_t* H; const float* ss;
    __device__ __forceinline__ void operator()(const f32x4 (&acc)[2][2][4][2], const Unit& u, int wr, int wc, int fr, int fq) const {
        const int row0 = u.pm * BM + wr * 64 + fr, col0 = u.pn * 128 + wc * 32 + 8 * fq;
#pragma unroll
        for (int ai = 0; ai < 2; ++ai)
#pragma unroll
            for (int m = 0; m < 4; ++m) {
                const int row = row0 + ai * HALF + m * 16; const float rs = row_rs(ss, row);
                float h[8];
#pragma unroll
                for (int n = 0; n < 2; ++n)
#pragma unroll
                    for (int e = 0; e < 4; ++e) { const float g = acc[ai][0][m][n][e] * rs, up = acc[ai][1][m][n][e] * rs; h[n * 4 + e] = g * fast_sigmoid(g) * up; }
                u32x4 w; w.x = cvtpk(h[0], h[1]); w.y = cvtpk(h[2], h[3]); w.z = cvtpk(h[4], h[5]); w.w = cvtpk(h[6], h[7]);
                *(u32x4*)(H + (size_t)row * DFF + col0) = w;
            }
    }
};

struct EpiResid {
    static constexpr bool PERM = true, AFTER_DRAIN = false;
    bf16_t* xb; float* ssn; float scale;
    __device__ __forceinline__ void operator()(const f32x4 (&acc)[2][2][4][2], const Unit& u, int wr, int wc, int fr, int fq) const {
        const int row0 = u.pm * BM + wr * 64 + fr, col0 = u.pn * BM + wc * 32 + 8 * fq;
#pragma unroll
        for (int ai = 0; ai < 2; ++ai)
#pragma unroll
            for (int m = 0; m < 4; ++m) {
                const int row = row0 + ai * HALF + m * 16;
                bf16_t* xr = xb + (size_t)row * DM + col0;
                const u32x4 g0 = *(const u32x4*)xr, g1 = *(const u32x4*)(xr + HALF);
                float sq = 0.f;
#pragma unroll
                for (int bj = 0; bj < 2; ++bj) {
                    const u32x4 g = bj ? g1 : g0; const f32x4 p0 = acc[ai][bj][m][0], p1 = acc[ai][bj][m][1];
                    const float o0 = bflo(g.x) + scale * p0[0], o1 = bfhi(g.x) + scale * p0[1], o2 = bflo(g.y) + scale * p0[2], o3 = bfhi(g.y) + scale * p0[3];
                    const float o4 = bflo(g.z) + scale * p1[0], o5 = bfhi(g.z) + scale * p1[1], o6 = bflo(g.w) + scale * p1[2], o7 = bfhi(g.w) + scale * p1[3];
                    u32x4 w; w.x = cvtpk(o0, o1); w.y = cvtpk(o2, o3); w.z = cvtpk(o4, o5); w.w = cvtpk(o6, o7);
                    *(u32x4*)(xr + bj * HALF) = w;
                    sq += (o0 * o0 + o1 * o1) + (o2 * o2 + o3 * o3) + (o4 * o4 + o5 * o5) + (o6 * o6 + o7 * o7);
                }
                sq += __shfl_xor(sq, 16); sq += __shfl_xor(sq, 32);
                if (fq == 0) ssn[(size_t)row * 16 + u.pn * 4 + wc] = sq;
            }
    }
};

struct EpiMixIn {
    static constexpr bool PERM = true, AFTER_DRAIN = false;
    const float* ss; const float* bias; bf16_t *Q, *KV, *BG, *U, *SA, *SC;
    __device__ __forceinline__ void operator()(const f32x4 (&acc)[2][2][4][2], const Unit& u, int wr, int wc, int fr, int fq) const {
        const int pn = u.pn; bf16_t* dst; int ld, cbase, mode; float sc = 1.f;
        if (pn < 4) { dst = Q; ld = DM; cbase = pn * 256; mode = 0; sc = QSCALE; }
        else if (pn == 4) { dst = KV; ld = 256; cbase = 0; mode = 0; }
        else if (pn < 9) { dst = BG; ld = DM; cbase = (pn - 5) * 256; mode = 0; }
        else if (pn < 17) { dst = U; ld = DM; cbase = (pn - 9) * 128; mode = 2; }
        else if (pn < 21) { dst = SA; ld = DM; cbase = (pn - 17) * 256; mode = 1; }
        else { dst = SC; ld = DM; cbase = (pn - 21) * 256; mode = 1; }
        const int row0 = u.pm * BM + wr * 64 + fr, cw = wc * 32 + 8 * fq;
        f32x4 bv[2][2];
#pragma unroll
        for (int bj = 0; bj < 2; ++bj)
#pragma unroll
            for (int n = 0; n < 2; ++n) bv[bj][n] = *(const f32x4*)(bias + pn * 256 + bj * HALF + cw + 4 * n);
#pragma unroll
        for (int ai = 0; ai < 2; ++ai)
#pragma unroll
            for (int m = 0; m < 4; ++m) {
                const int row = row0 + ai * HALF + m * 16; const float rs = row_rs(ss, row);
                bf16_t* rowp = dst + (size_t)row * ld + cbase + cw;
                if (mode == 2) {
                    const f32x4 z0 = (acc[ai][0][m][0] * rs + bv[0][0]) * (acc[ai][1][m][0] * rs + bv[1][0]);
                    const f32x4 z1 = (acc[ai][0][m][1] * rs + bv[0][1]) * (acc[ai][1][m][1] * rs + bv[1][1]);
                    u32x4 w; w.x = cvtpk(z0[0], z0[1]); w.y = cvtpk(z0[2], z0[3]); w.z = cvtpk(z1[0], z1[1]); w.w = cvtpk(z1[2], z1[3]);
                    *(u32x4*)rowp = w;
                } else {
#pragma unroll
                    for (int bj = 0; bj < 2; ++bj) {
                        f32x4 z0 = acc[ai][bj][m][0] * rs + bv[bj][0], z1 = acc[ai][bj][m][1] * rs + bv[bj][1];
                        if (mode == 1) {
#pragma unroll
                            for (int e = 0; e < 4; ++e) { z0[e] = fast_sigmoid(z0[e]); z1[e] = fast_sigmoid(z1[e]); }
                        } else { z0 = z0 * sc; z1 = z1 * sc; }
                        u32x4 w; w.x = cvtpk(z0[0], z0[1]); w.y = cvtpk(z0[2], z0[3]); w.z = cvtpk(z1[0], z1[1]); w.w = cvtpk(z1[2], z1[3]);
                        *(u32x4*)(rowp + bj * HALF) = w;
                    }
                }
            }
    }
};

struct EpiGate {
    static constexpr bool PERM = true, AFTER_DRAIN = false;
    bf16_t* G; const bf16_t* ADD;
    __device__ __forceinline__ void operator()(const f32x4 (&acc)[2][2][4][2], const Unit& u, int wr, int wc, int fr, int fq) const {
        const int row0 = u.pm * BM + wr * 64 + fr, col0 = u.pn * BM + wc * 32 + 8 * fq;
#pragma unroll
        for (int ai = 0; ai < 2; ++ai)
#pragma unroll
            for (int m = 0; m < 4; ++m) {
                const int row = row0 + ai * HALF + m * 16;
#pragma unroll
                for (int bj = 0; bj < 2; ++bj) {
                    const size_t idx = (size_t)row * DM + col0 + bj * HALF;
                    const u32x4 g = *(const u32x4*)(G + idx);
                    u32x4 a = (u32x4){0u, 0u, 0u, 0u}; if (ADD) a = *(const u32x4*)(ADD + idx);
                    const f32x4 p0 = acc[ai][bj][m][0], p1 = acc[ai][bj][m][1];
                    u32x4 w;
                    w.x = cvtpk(bflo(a.x) + bflo(g.x) * p0[0], bfhi(a.x) + bfhi(g.x) * p0[1]);
                    w.y = cvtpk(bflo(a.y) + bflo(g.y) * p0[2], bfhi(a.y) + bfhi(g.y) * p0[3]);
                    w.z = cvtpk(bflo(a.z) + bflo(g.z) * p1[0], bfhi(a.z) + bfhi(g.z) * p1[1]);
                    w.w = cvtpk(bflo(a.w) + bflo(g.w) * p1[2], bfhi(a.w) + bfhi(g.w) * p1[3]);
                    *(u32x4*)(G + idx) = w;
                }
            }
    }
};

template <class Epi, class Sched, bool ALIGN_EPI = false, bool SP2 = false>
__device__ __forceinline__ void gemm_phase(PG8_LAS unsigned char* lds, const Gemm g, const Sched& S, const Epi& E) {
    int tid_ = threadIdx.x; asm volatile("" : "+v"(tid_));
    const int tid = tid_, wid = __builtin_amdgcn_readfirstlane(tid >> 6), lane = tid & 63, wr = wid >> 2, wc = wid & 3, fr = lane & 15, fq = lane >> 4;
    const int K = g.K, nt = K / BK;
    unsigned voffA[2], voffB[2];
#pragma unroll
    for (int i = 0; i < 2; ++i) { int R, C; stage_rc(tid * 16 + i * 8192, R, C); const int Rb = Epi::PERM ? ((R & ~31) + perm32(R & 31)) : R;
        voffA[i] = (unsigned)(R * K + C) * 2u; voffB[i] = (unsigned)(Rb * K + C) * 2u; }
    const size_t kstep = (size_t)(BK * 2);
    const size_t hstep = (size_t)HALF * K * 2;
    const size_t tstep = 2 * hstep;
    const unsigned ldsw = (unsigned)wid * 1024u;
    const int aoff = lds_byte(wr * 64 + fr, fq * 8), boff = lds_byte(wc * 32 + fr, fq * 8);
#define PG8_SA(b, h) (((b) * 2 + (h)) * HTB)
#define PG8_SB(b, h) ((4 + (b) * 2 + (h)) * HTB)
#define PG8_STAGE(bufoff, gbase, voff) do { _Pragma("unroll") for (int _i = 0; _i < 2; ++_i) \
        __builtin_amdgcn_global_load_lds((const unsigned*)((const char*)(gbase) + (voff)[_i]), (PG8_LAS unsigned*)(lds + (bufoff) + ldsw + _i * 8192), 16, 0, 0); } while (0)
#define PG8_LDA(dst, b, h) do { _Pragma("unroll") for (int m = 0; m < 4; ++m) _Pragma("unroll") for (int k = 0; k < 2; ++k) dst[m][k] = *(const PG8_LAS bf16x8*)(lds + PG8_SA(b, h) + aoff + m * 2048 + k * 1024); } while (0)
#define PG8_LDB(dst, b, h) do { _Pragma("unroll") for (int n = 0; n < 2; ++n) _Pragma("unroll") for (int k = 0; k < 2; ++k) dst[n][k] = *(const PG8_LAS bf16x8*)(lds + PG8_SB(b, h) + boff + n * 2048 + k * 1024); } while (0)
#define PG8_MMA(ai, bj, At, Bt) do { __builtin_amdgcn_s_setprio(1); _Pragma("unroll") for (int m = 0; m < 4; ++m) _Pragma("unroll") for (int n = 0; n < 2; ++n) _Pragma("unroll") for (int k = 0; k < 2; ++k) \
        acc[ai][bj][m][n] = __builtin_amdgcn_mfma_f32_16x16x32_bf16(Bt[n][k], At[m][k], acc[ai][bj][m][n], 0, 0, 0); __builtin_amdgcn_s_setprio(0); } while (0)
#define PG8_WAIT_V(n) asm volatile("s_waitcnt vmcnt(" #n ")" ::: "memory")
#define PG8_WAIT_L(n) asm volatile("s_waitcnt lgkmcnt(" #n ")" ::: "memory")
#define PG8_BAR __builtin_amdgcn_s_barrier()
#define PG8_SCHED __builtin_amdgcn_sched_barrier(0)
    Unit cur, nxt; int ui = 0;
    if (!S.next(0, cur)) return;
    f32x4 acc[2][2][4][2];
#pragma unroll
    for (int a = 0; a < 2; ++a)
#pragma unroll
        for (int b = 0; b < 2; ++b)
#pragma unroll
            for (int m = 0; m < 4; ++m)
#pragma unroll
                for (int n = 0; n < 2; ++n) acc[a][b][m][n] = (f32x4){0.f, 0.f, 0.f, 0.f};
    bf16x8 At[4][2], B0[2][2], B1[2][2];
    const char* cA = (const char*)g.A + (size_t)cur.pm * tstep; const char* cB = (const char*)g.Bt + (size_t)cur.pn * tstep;
    S.a_ready(cur);
    if constexpr (SP2) {
        PG8_STAGE(PG8_SB(0, 0), cB, voffB); PG8_STAGE(PG8_SB(0, 1), cB + hstep, voffB); PG8_STAGE(PG8_SA(0, 0), cA, voffA); PG8_STAGE(PG8_SA(0, 1), cA + hstep, voffA);
        if (wr == 1) PG8_BAR;
        PG8_WAIT_V(2); PG8_BAR;
        PG8_STAGE(PG8_SB(1, 0), cB + kstep, voffB); PG8_STAGE(PG8_SA(1, 0), cA + kstep, voffA); PG8_STAGE(PG8_SB(1, 1), cB + hstep + kstep, voffB);
        PG8_WAIT_V(6); PG8_BAR;
    } else {
        PG8_STAGE(PG8_SB(0, 0), cB, voffB); PG8_STAGE(PG8_SA(0, 0), cA, voffA); PG8_STAGE(PG8_SB(0, 1), cB + hstep, voffB); PG8_STAGE(PG8_SA(0, 1), cA + hstep, voffA);
        if (wr == 1) PG8_BAR;
        PG8_WAIT_V(4); PG8_BAR;
        PG8_STAGE(PG8_SB(1, 0), cB + kstep, voffB); PG8_STAGE(PG8_SA(1, 0), cA + kstep, voffA); PG8_STAGE(PG8_SB(1, 1), cB + hstep + kstep, voffB);
        PG8_WAIT_V(6); PG8_BAR;
    }
    for (;;) {
        const bool has_next = S.next(ui + 1, nxt);
        const char* nA = has_next ? (const char*)g.A + (size_t)nxt.pm * tstep : cA; const char* nB = has_next ? (const char*)g.Bt + (size_t)nxt.pn * tstep : cB;
        for (int t = 0; t < nt; t += 2) {
            const bool last = (t == nt - 2);
            const char* a1 = cA + (size_t)(t + 1) * kstep;
            const char* a2 = last ? nA : cA + (size_t)(t + 2) * kstep; const char* b2 = last ? nB : cB + (size_t)(t + 2) * kstep;
            const char* a3 = a2 + kstep; const char* b3 = b2 + kstep;
            if (last && has_next) S.a_ready(nxt);
            if constexpr (SP2) {
            PG8_LDB(B0, 0, 0); PG8_LDB(B1, 0, 1); PG8_SCHED; PG8_LDA(At, 0, 0); PG8_STAGE(PG8_SA(1, 1), a1 + hstep, voffA);
            PG8_WAIT_V(8); PG8_WAIT_L(0); PG8_BAR; PG8_MMA(0, 0, At, B0); PG8_MMA(0, 1, At, B1); PG8_BAR; PG8_SCHED;
            PG8_LDA(At, 0, 1); PG8_STAGE(PG8_SB(0, 0), b2, voffB); PG8_STAGE(PG8_SB(0, 1), b2 + hstep, voffB); PG8_STAGE(PG8_SA(0, 0), a2, voffA);
            PG8_WAIT_V(8); PG8_WAIT_L(0); PG8_BAR; PG8_MMA(1, 0, At, B0); PG8_MMA(1, 1, At, B1); PG8_BAR; PG8_SCHED;
            PG8_LDB(B0, 1, 0); PG8_LDB(B1, 1, 1); PG8_SCHED; PG8_LDA(At, 1, 0); PG8_STAGE(PG8_SA(0, 1), a2 + hstep, voffA);
            PG8_WAIT_V(8); PG8_WAIT_L(0); PG8_BAR; PG8_MMA(0, 0, At, B0); PG8_MMA(0, 1, At, B1); PG8_BAR; PG8_SCHED;
            PG8_LDA(At, 1, 1); PG8_STAGE(PG8_SB(1, 0), b3, voffB); PG8_STAGE(PG8_SB(1, 1), b3 + hstep, voffB); PG8_STAGE(PG8_SA(1, 0), a3, voffA);
            PG8_WAIT_V(8); PG8_WAIT_L(0); PG8_BAR; PG8_MMA(1, 0, At, B0); PG8_MMA(1, 1, At, B1); PG8_BAR; PG8_SCHED;
            } else {
            PG8_LDB(B0, 0, 0); PG8_SCHED; PG8_LDA(At, 0, 0); PG8_STAGE(PG8_SA(1, 1), a1 + hstep, voffA);
            PG8_WAIT_L(8); PG8_BAR; PG8_WAIT_L(0); PG8_MMA(0, 0, At, B0); PG8_BAR; PG8_SCHED;
            PG8_LDB(B1, 0, 1); PG8_STAGE(PG8_SB(0, 0), b2, voffB);
            PG8_BAR; PG8_WAIT_L(0); PG8_MMA(0, 1, At, B1); PG8_BAR;
            PG8_LDA(At, 0, 1); PG8_STAGE(PG8_SA(0, 0), a2, voffA);
            PG8_BAR; PG8_WAIT_L(0); PG8_MMA(1, 0, At, B0); PG8_BAR; PG8_SCHED;
            PG8_STAGE(PG8_SB(0, 1), b2 + hstep, voffB);
            PG8_WAIT_V(6); PG8_BAR; PG8_MMA(1, 1, At, B1); PG8_BAR;
            PG8_LDB(B0, 1, 0); PG8_SCHED; PG8_LDA(At, 1, 0); PG8_STAGE(PG8_SA(0, 1), a2 + hstep, voffA);
            PG8_WAIT_L(8); PG8_BAR; PG8_WAIT_L(0); PG8_MMA(0, 0, At, B0); PG8_BAR; PG8_SCHED;
            PG8_LDB(B1, 1, 1); PG8_STAGE(PG8_SB(1, 0), b3, voffB);
            PG8_BAR; PG8_WAIT_L(0); PG8_MMA(0, 1, At, B1); PG8_BAR;
            PG8_LDA(At, 1, 1); PG8_STAGE(PG8_SA(1, 0), a3, voffA);
            PG8_BAR; PG8_WAIT_L(0); PG8_MMA(1, 0, At, B0); PG8_BAR; PG8_SCHED;
            PG8_STAGE(PG8_SB(1, 1), b3 + hstep, voffB);
            PG8_WAIT_V(6); PG8_BAR; PG8_MMA(1, 1, At, B1); PG8_BAR;
            }
        }
        if constexpr (ALIGN_EPI) { if (wr == 0) PG8_BAR; }
        if constexpr (!Epi::AFTER_DRAIN) { E(acc, cur, wr, wc, fr, fq); S.done(cur); }
        if (!has_next) break;
#pragma unroll
        for (int a = 0; a < 2; ++a)
#pragma unroll
            for (int b = 0; b < 2; ++b)
#pragma unroll
                for (int m = 0; m < 4; ++m)
#pragma unroll
                    for (int n = 0; n < 2; ++n) acc[a][b][m][n] = (f32x4){0.f, 0.f, 0.f, 0.f};
        cur = nxt; cA = nA; cB = nB; ++ui;
        if constexpr (ALIGN_EPI) { if (wr == 1) PG8_BAR; }
    }
    PG8_WAIT_V(0);
    if constexpr (!ALIGN_EPI) { if (wr == 0) PG8_BAR; }
    PG8_BAR;
    if constexpr (Epi::AFTER_DRAIN) { E.fused(acc, cur, wr, wc, fr, fq, lds, wid, lane); S.done(cur); }
#undef PG8_SA
#undef PG8_SB
#undef PG8_STAGE
#undef PG8_LDA
#undef PG8_LDB
#undef PG8_MMA
#undef PG8_WAIT_V
#undef PG8_WAIT_L
#undef PG8_BAR
#undef PG8_SCHED
}
}

#define GAS __attribute__((address_space(1)))
#define LAS __attribute__((address_space(3)))
typedef unsigned short bf16;
typedef float f32x4 __attribute__((ext_vector_type(4)));
typedef float f32x16 __attribute__((ext_vector_type(16)));
typedef unsigned u32x4 __attribute__((ext_vector_type(4)));
typedef short bf16x8 __attribute__((ext_vector_type(8)));
typedef short s16x4 __attribute__((ext_vector_type(4)));
constexpr size_t MiB = 1u << 20;
constexpr size_t WS_SS = 960 * MiB;
constexpr size_t WS_BAR = 2 * MiB;
constexpr size_t WS_BIAS = 3 * MiB;
constexpr size_t WS_W = 4 * MiB;
constexpr size_t E_W1GU = 0, E_W1D = E_W1GU + (size_t)2 * DFF * DM, E_WIN = E_W1D + (size_t)DM * DFF, E_WOA = E_WIN + (size_t)NIN * DM, E_WOC = E_WOA + (size_t)DM * DM,
                 E_WO = E_WOC + (size_t)DM * DM, E_W2GU = E_WO + (size_t)DM * DM, E_W2D = E_W2GU + (size_t)2 * DFF * DM, E_LAYER = E_W2D + (size_t)DM * DFF;
constexpr size_t WS_XB = 116 * MiB;
constexpr size_t ACT = (size_t)MT * DM * 2;
constexpr size_t WS_Q = 246 * MiB, WS_BG = WS_Q + ACT, WS_U = WS_BG + ACT, WS_SA = WS_U + ACT, WS_SC = WS_SA + ACT, WS_KV = WS_SC + ACT, WS_END = WS_KV + (size_t)MT * 256 * 2;
constexpr size_t WS_H = WS_Q;
static_assert(WS_W + 2 * E_LAYER * 2 <= WS_XB && WS_XB + ACT <= WS_Q && WS_H + (size_t)MT * DFF * 2 <= WS_SA && WS_END <= WS_SS && WS_SS + (size_t)7 * MT * 64 <= (size_t)1024 * MiB, "d_ws map");
constexpr size_t O_YP = 0, O_YS = (size_t)MP * DM, O_KP = O_YS + (size_t)MS * DM, O_VP = O_KP + 2 * 8 * 128 * 128, O_CP = O_VP + 2 * 8 * 128 * 128, O_KS = O_CP + 2 * 8 * 2 * 1024,
                 O_VS = O_KS + 2 * 16 * 128 * 128, O_CS = O_VS + 2 * 16 * 128 * 128, O_END = O_CS + 2 * 16 * 2 * 1024;

#ifndef MK_SKIP
#define MK_SKIP 0
#endif
#ifndef MK_DUP
#define MK_DUP 0
#endif
constexpr int NWAVES = 8, NTHR = 512;
constexpr int LDS_BYTES = 135168;

struct Args {
    const float* x_prompt; const float* x_sample; const float* cache_k; const float* cache_v; const float* state_conv;
    const float* norm_ffn1; const float* w1_gate; const float* w1_up; const float* w1_down;
    const float* norm_mix; const float* w_in; const float* b_in; const float* sinks; const float* conv_w; const float* w_o_attn; const float* w_o_conv; const float* w_o;
    const float* norm_ffn2; const float* w2_gate; const float* w2_up; const float* w2_down; const float* norm_final;
    float* out; unsigned char* ws;
};

__device__ __forceinline__ float wave_sum(float v) {
#pragma unroll
    for (int o = 1; o < 64; o <<= 1) v += __shfl_xor(v, o);
    return v;
}
#define LDS_WAIT() asm volatile("s_waitcnt lgkmcnt(0)" ::: "memory")

__device__ __forceinline__ void transpose_item(const float* W, int K, int N, const float* gain, bf16* WT, int dst_row0, LAS float* scr, int k0, int n0, int lane) {
#pragma unroll 8
    for (int i = 0; i < 32; ++i) { const int kk = 2 * i + (lane >> 5); float v = W[(size_t)(k0 + kk) * N + n0 + (lane & 31)]; if (gain) v *= gain[k0 + kk]; scr[kk * 33 + (lane & 31)] = v; }
    LDS_WAIT(); asm volatile("" ::: "memory");
    const int c = lane & 7;
#pragma unroll
    for (int j = 0; j < 4; ++j) { const int n = (lane >> 3) + 8 * j; const LAS float* s = scr + (8 * c) * 33 + n;
        u32x4 o; o.x = cvtpk(s[0 * 33], s[1 * 33]); o.y = cvtpk(s[2 * 33], s[3 * 33]); o.z = cvtpk(s[4 * 33], s[5 * 33]); o.w = cvtpk(s[6 * 33], s[7 * 33]);
        *(u32x4*)(WT + (size_t)(dst_row0 + n) * K + k0 + 8 * c) = o; }
    LDS_WAIT(); asm volatile("" ::: "memory");
}
__device__ __forceinline__ int win_map(int n) {
    if (n < 2304 || n >= 4352) return n;
    if (n < 3328) { const int f = n - 2304; return 2304 + 256 * (f >> 7) + (f & 127); }
    const int f = n - 3328; return 2304 + 256 * (f >> 7) + 128 + (f & 127);
}
__device__ __forceinline__ int gu_map(int f, int up) { return 256 * (f >> 7) + 128 * up + (f & 127); }

__device__ __forceinline__ void prologue(const Args& a, LAS unsigned char* lds, int tid, int lane, int wave) {
    LAS float* scr = (LAS float*)(lds + wave * 16384);
    const int gw = blockIdx.x * NWAVES + wave, NGW = gridDim.x * NWAVES;
    bf16* Wb = (bf16*)(a.ws + WS_W);
    constexpr int I_G = 16 * 88, I_D = 44 * 32, I_IN = 16 * 200, I_O = 16 * 32, I_LAYER = 6 * I_G + I_IN + 3 * I_O;
    static_assert(I_G == I_D, "item counts");
    for (int it = gw; it < 2 * I_LAYER; it += NGW) {
        const int l = it / I_LAYER; int r = it - l * I_LAYER; bf16* Wl = Wb + (size_t)l * E_LAYER;
        if (r < 2 * I_G) { const int up = r >= I_G; if (up) r -= I_G; const int kb = r / 88, nb = r % 88;
            transpose_item((up ? a.w1_up : a.w1_gate) + (size_t)l * DM * DFF, DM, DFF, a.norm_ffn1 + l * DM, Wl + E_W1GU, gu_map(nb * 32, up), scr, kb * 64, nb * 32, lane); continue; } r -= 2 * I_G;
        if (r < I_D) { const int kb = r / 32, nb = r % 32; transpose_item(a.w1_down + (size_t)l * DFF * DM, DFF, DM, nullptr, Wl + E_W1D, nb * 32, scr, kb * 64, nb * 32, lane); continue; } r -= I_D;
        if (r < I_IN) { const int kb = r / 200, nb = r % 200; transpose_item(a.w_in + (size_t)l * DM * NIN, DM, NIN, a.norm_mix + l * DM, Wl + E_WIN, win_map(nb * 32), scr, kb * 64, nb * 32, lane); continue; } r -= I_IN;
        if (r < 3 * I_O) { const int w = r / I_O; r -= w * I_O; const int kb = r / 32, nb = r % 32; const float* src = (w == 0 ? a.w_o_attn : w == 1 ? a.w_o_conv : a.w_o) + (size_t)l * DM * DM;
            transpose_item(src, DM, DM, nullptr, Wl + (w == 0 ? E_WOA : w == 1 ? E_WOC : E_WO), nb * 32, scr, kb * 64, nb * 32, lane); continue; } r -= 3 * I_O;
        if (r < 2 * I_G) { const int up = r >= I_G; if (up) r -= I_G; const int kb = r / 88, nb = r % 88;
            transpose_item((up ? a.w2_up : a.w2_gate) + (size_t)l * DM * DFF, DM, DFF, a.norm_ffn2 + l * DM, Wl + E_W2GU, gu_map(nb * 32, up), scr, kb * 64, nb * 32, lane); continue; } r -= 2 * I_G;
        { const int kb = r / 32, nb = r % 32; transpose_item(a.w2_down + (size_t)l * DFF * DM, DFF, DM, nullptr, Wl + E_W2D, nb * 32, scr, kb * 64, nb * 32, lane); }
    }
    float* ss = (float*)(a.ws + WS_SS); bf16* XB = (bf16*)(a.ws + WS_XB);
    for (int m = gw; m < MT; m += NGW) {
        const float* xr = (m < MP) ? a.x_prompt + (size_t)m * DM : a.x_sample + (size_t)(m - MP) * DM;
        f32x4 v[4]; float s = 0.f;
#pragma unroll
        for (int j = 0; j < 4; ++j) { v[j] = ((const f32x4*)xr)[lane + 64 * j]; s += (v[j].x * v[j].x + v[j].y * v[j].y) + (v[j].z * v[j].z + v[j].w * v[j].w); }
        s = wave_sum(s); if (lane < 16) ss[(size_t)m * 16 + lane] = (lane == 0) ? s : 0.f;
        unsigned long long* o8 = (unsigned long long*)(XB + (size_t)m * DM) + lane;
#pragma unroll
        for (int j = 0; j < 4; ++j) o8[64 * j] = (unsigned long long)cvtpk(v[j].x, v[j].y) | ((unsigned long long)cvtpk(v[j].z, v[j].w) << 32);
    }
    const int gt = blockIdx.x * NTHR + tid, NGT = gridDim.x * NTHR;
    { unsigned* bw = (unsigned*)(a.ws + WS_BAR); for (int i = gt; i < 3456  ; i += NGT) bw[i] = 0u; }
    float* bp = (float*)(a.ws + WS_BIAS);
    for (int i = gt; i < 2 * NIN; i += NGT) { const int l = i / NIN, n = i - l * NIN; bp[l * NIN + win_map(n)] = a.b_in[i]; }
}

constexpr int KS_STRIDE = 144, VT_STRIDE = 408;
constexpr int LDS_KS = 0, LDS_VT = 192 * KS_STRIDE, LDS_WSF = LDS_VT + 64 * VT_STRIDE, ATT_LDS = LDS_WSF + NWAVES * 32 * 4;
constexpr int N_ATT_ITEMS = 32 + NB * 128 * 2;
__device__ __forceinline__ int crow(int r, int hi) { return (r & 3) + 8 * (r >> 2) + 4 * hi; }

__device__ __forceinline__ void attn_item(LAS unsigned char* lds, const bf16* QI, bf16* AO, const bf16* KV, const float* ck, const float* cv, const float* sinks, int item, int tid, int lane, int wave) {
    int qrow0, nqb, blo, bhi, h, sb = 0; long kvrow0 = 0; bool sample;
    if (item < 32) { sample = true; sb = item >> 1; h = item & 1; qrow0 = MP + sb * 32; nqb = 1; blo = 0; bhi = 5; }
    else { sample = false; const int it = item - 32; h = it & 1; const int c = (it >> 1) & 127, b = it >> 8; qrow0 = b * SEQ + c * 64; nqb = 2; blo = c >= 2 ? 0 : 2 * (2 - c); bhi = 6; kvrow0 = (long)b * SEQ + (long)(c - 2) * 64; }
    for (int ch = tid; ch < 1536; ch += NTHR) {
        const int j = ch >> 3, dg = ch & 7, blk = j >> 5;
        if (blk >= blo && blk < bhi) {
            u32x4 kx, vx;
            if (sample && j < 128) {
                const size_t o = ((size_t)(sb * 128 + j)) * 128 + h * 64 + dg * 8;
                const f32x4 k0 = *(const f32x4*)(ck + o), k1 = *(const f32x4*)(ck + o + 4), v0 = *(const f32x4*)(cv + o), v1 = *(const f32x4*)(cv + o + 4);
                kx.x = cvtpk(k0[0], k0[1]); kx.y = cvtpk(k0[2], k0[3]); kx.z = cvtpk(k1[0], k1[1]); kx.w = cvtpk(k1[2], k1[3]);
                vx.x = cvtpk(v0[0], v0[1]); vx.y = cvtpk(v0[2], v0[3]); vx.z = cvtpk(v1[0], v1[1]); vx.w = cvtpk(v1[2], v1[3]);
            } else {
                const long row = sample ? (long)(MP + sb * 32 + (j - 128)) : kvrow0 + j;
                const bf16* p = KV + (size_t)row * 256 + h * 64 + dg * 8;
                kx = *(const u32x4*)p; vx = *(const u32x4*)(p + 128);
            }
            *(LAS u32x4*)(lds + LDS_KS + j * KS_STRIDE + dg * 16) = kx;
            LAS unsigned short* vt = (LAS unsigned short*)(lds + LDS_VT + (dg * 8) * VT_STRIDE + j * 2);
            vt[0 * (VT_STRIDE / 2)] = (unsigned short)(vx.x & 0xffffu); vt[1 * (VT_STRIDE / 2)] = (unsigned short)(vx.x >> 16);
            vt[2 * (VT_STRIDE / 2)] = (unsigned short)(vx.y & 0xffffu); vt[3 * (VT_STRIDE / 2)] = (unsigned short)(vx.y >> 16);
            vt[4 * (VT_STRIDE / 2)] = (unsigned short)(vx.z & 0xffffu); vt[5 * (VT_STRIDE / 2)] = (unsigned short)(vx.z >> 16);
            vt[6 * (VT_STRIDE / 2)] = (unsigned short)(vx.w & 0xffffu); vt[7 * (VT_STRIDE / 2)] = (unsigned short)(vx.w >> 16);
        }
    }
    __syncthreads();
    const int r32 = lane & 31, hi = lane >> 5, head = h * 8 + wave;
    const float sink2 = sinks[head] * LOG2E;
    LAS float* wsf = (LAS float*)(lds + LDS_WSF) + wave * 32;
    for (int qb = 0; qb < nqb; ++qb) {
        const bf16* qp = QI + (size_t)(qrow0 + qb * 32 + r32) * DM + head * 64 + hi * 8;
        bf16x8 qf[4];
#pragma unroll
        for (int d0 = 0; d0 < 4; ++d0) qf[d0] = *(const bf16x8*)(qp + d0 * 16);
        f32x16 s[6];
#pragma unroll
        for (int kvb = 0; kvb < 6; ++kvb) {
            if (kvb >= blo && kvb < bhi) {
                f32x16 acc;
#pragma unroll
                for (int i = 0; i < 16; ++i) acc[i] = 0.f;
#pragma unroll
                for (int d0 = 0; d0 < 4; ++d0) { const bf16x8 kf = *(const LAS bf16x8*)(lds + LDS_KS + (kvb * 32 + r32) * KS_STRIDE + d0 * 32 + hi * 16);
                    acc = __builtin_amdgcn_mfma_f32_32x32x16_bf16(kf, qf[d0], acc, 0, 0, 0); }
                s[kvb] = acc;
            } else {
#pragma unroll
                for (int i = 0; i < 16; ++i) s[kvb][i] = -1e30f;
            }
        }
        float mx = sink2;
#pragma unroll
        for (int kvb = 0; kvb < 6; ++kvb)
#pragma unroll
            for (int i = 0; i < 16; ++i) mx = fmaxf(mx, s[kvb][i]);
        mx = fmaxf(mx, __shfl_xor(mx, 32));
        float sum = 0.f;
#pragma unroll
        for (int kvb = 0; kvb < 6; ++kvb)
#pragma unroll
            for (int i = 0; i < 16; ++i) { const float e = __builtin_amdgcn_exp2f(s[kvb][i] - mx); s[kvb][i] = e; sum += e; }
        sum += __shfl_xor(sum, 32);
        const float l = sum + __builtin_amdgcn_exp2f(sink2 - mx);
        f32x16 o[2];
#pragma unroll
        for (int i = 0; i < 16; ++i) { o[0][i] = 0.f; o[1][i] = 0.f; }
#pragma unroll
        for (int kvb = 0; kvb < 6; ++kvb) {
            if (kvb >= blo && kvb < bhi) {
#pragma unroll
                for (int st = 0; st < 2; ++st) {
                    u32x4 pw; pw.x = cvtpk(s[kvb][8 * st + 0], s[kvb][8 * st + 1]); pw.y = cvtpk(s[kvb][8 * st + 2], s[kvb][8 * st + 3]);
                    pw.z = cvtpk(s[kvb][8 * st + 4], s[kvb][8 * st + 5]); pw.w = cvtpk(s[kvb][8 * st + 6], s[kvb][8 * st + 7]);
                    const bf16x8 pf = __builtin_bit_cast(bf16x8, pw);
#pragma unroll
                    for (int db = 0; db < 2; ++db) {
                        const LAS unsigned char* vp = lds + LDS_VT + (db * 32 + r32) * VT_STRIDE + (kvb * 32 + 16 * st + 4 * hi) * 2;
                        const s16x4 lo = *(const LAS s16x4*)vp, hh = *(const LAS s16x4*)(vp + 16);
                        const bf16x8 vf = __builtin_shufflevector(lo, hh, 0, 1, 2, 3, 4, 5, 6, 7);
                        o[db] = __builtin_amdgcn_mfma_f32_32x32x16_bf16(pf, vf, o[db], 0, 0, 0);
                    }
                }
            }
        }
        if (hi == 0) wsf[r32] = l;
        LDS_WAIT(); __builtin_amdgcn_wave_barrier(); asm volatile("" ::: "memory");
        bf16* op = AO + (size_t)(qrow0 + qb * 32) * DM + head * 64 + r32;
#pragma unroll
        for (int i = 0; i < 16; ++i) {
            const int q = crow(i, hi); const float rl = __builtin_amdgcn_rcpf(wsf[q]);
            const unsigned w0 = cvtpk(o[0][i] * rl, o[1][i] * rl);
            op[(size_t)q * DM] = (unsigned short)(w0 & 0xffffu); op[(size_t)q * DM + 32] = (unsigned short)(w0 >> 16);
        }
        LDS_WAIT(); __builtin_amdgcn_wave_barrier(); asm volatile("" ::: "memory");
    }
    __syncthreads();
}

__device__ __forceinline__ void conv_chunk(bf16* BG, const bf16* U, const float* cw, const float* st  , int chunk, int tid) {
    const int cgp = tid & 127, rsub = tid >> 7, c0 = cgp * 8;
    const int t0 = chunk * 16 + rsub * 4;
    float w[3][8];
#pragma unroll
    for (int j = 0; j < 3; ++j) { const f32x4 a = *(const f32x4*)(cw + j * DM + c0), b = *(const f32x4*)(cw + j * DM + c0 + 4);
#pragma unroll
        for (int e = 0; e < 4; ++e) { w[j][e] = a[e]; w[j][4 + e] = b[e]; } }
    float p2[8], p1[8];
    const int pos = (t0 < MP) ? (t0 & (SEQ - 1)) : ((t0 - MP) & (SSEQ - 1));
    if (pos == 0) {
        if (t0 < MP) {
#pragma unroll
            for (int e = 0; e < 8; ++e) { p2[e] = 0.f; p1[e] = 0.f; }
        } else {
            const float* s0 = st + (size_t)((t0 - MP) / SSEQ) * 2 * DM + c0;
            const f32x4 a = *(const f32x4*)s0, b = *(const f32x4*)(s0 + 4), c = *(const f32x4*)(s0 + DM), d = *(const f32x4*)(s0 + DM + 4);
#pragma unroll
            for (int e = 0; e < 4; ++e) { p2[e] = a[e]; p2[4 + e] = b[e]; p1[e] = c[e]; p1[4 + e] = d[e]; }
        }
    } else {
        const u32x4 a = *(const u32x4*)(U + (size_t)(t0 - 2) * DM + c0), b = *(const u32x4*)(U + (size_t)(t0 - 1) * DM + c0);
        p2[0] = bflo(a.x); p2[1] = bfhi(a.x); p2[2] = bflo(a.y); p2[3] = bfhi(a.y); p2[4] = bflo(a.z); p2[5] = bfhi(a.z); p2[6] = bflo(a.w); p2[7] = bfhi(a.w);
        p1[0] = bflo(b.x); p1[1] = bfhi(b.x); p1[2] = bflo(b.y); p1[3] = bfhi(b.y); p1[4] = bflo(b.z); p1[5] = bfhi(b.z); p1[6] = bflo(b.w); p1[7] = bfhi(b.w);
    }
#pragma unroll
    for (int r = 0; r < 4; ++r) {
        const size_t idx = (size_t)(t0 + r) * DM + c0;
        const u32x4 uu = *(const u32x4*)(U + idx), gg = *(const u32x4*)(BG + idx);
        float cu[8], g[8], o[8];
        cu[0] = bflo(uu.x); cu[1] = bfhi(uu.x); cu[2] = bflo(uu.y); cu[3] = bfhi(uu.y); cu[4] = bflo(uu.z); cu[5] = bfhi(uu.z); cu[6] = bflo(uu.w); cu[7] = bfhi(uu.w);
        g[0] = bflo(gg.x); g[1] = bfhi(gg.x); g[2] = bflo(gg.y); g[3] = bfhi(gg.y); g[4] = bflo(gg.z); g[5] = bfhi(gg.z); g[6] = bflo(gg.w); g[7] = bfhi(gg.w);
#pragma unroll
        for (int e = 0; e < 8; ++e) { o[e] = g[e] * (w[0][e] * p2[e] + w[1][e] * p1[e] + w[2][e] * cu[e]); p2[e] = p1[e]; p1[e] = cu[e]; }
        u32x4 ww; ww.x = cvtpk(o[0], o[1]); ww.y = cvtpk(o[2], o[3]); ww.z = cvtpk(o[4], o[5]); ww.w = cvtpk(o[6], o[7]);
        *(u32x4*)(BG + idx) = ww;
    }
}

__device__ __forceinline__ f32x4 bf4(const bf16* p) { const uint2 w = *(const uint2*)p; return (f32x4){bflo(w.x), bfhi(w.x), bflo(w.y), bfhi(w.y)}; }
__device__ __forceinline__ void state_copies(const Args& a, int l, const bf16* KV, const bf16* U, int gt, int NGT) {
    constexpr int N_KP = 8 * 128 * 128 / 4, N_CP = 8 * 2 * 1024 / 4, N_KS = 16 * 128 * 128 / 4, N_CS = 16 * 2 * 1024 / 4;
    constexpr int TOT = 2 * N_KP + N_CP + 2 * N_KS + N_CS;
    float* out = a.out;
    for (int i = gt; i < TOT; i += NGT) {
        int r = i;
        if (r < 2 * N_KP) { const int v = r >= N_KP; if (v) r -= N_KP; const int e = r * 4, hd = e & 127, j = (e >> 7) & 127, b = e >> 14;
            *(f32x4*)(out + (v ? O_VP : O_KP) + (size_t)l * 8 * 128 * 128 + e) = bf4(KV + (size_t)(b * SEQ + SEQ - 128 + j) * 256 + v * 128 + hd); continue; } r -= 2 * N_KP;
        if (r < N_CP) { const int e = r * 4, c = e & 1023, ii = (e >> 10) & 1, b = e >> 11;
            *(f32x4*)(out + O_CP + (size_t)l * 8 * 2 * 1024 + e) = bf4(U + (size_t)(b * SEQ + SEQ - 2 + ii) * DM + c); continue; } r -= N_CP;
        if (r < 2 * N_KS) { const int v = r >= N_KS; if (v) r -= N_KS; const int e = r * 4, hd = e & 127, j = (e >> 7) & 127, b = e >> 14;
            f32x4 val;
            if (j < 96) val = *(const f32x4*)((v ? a.cache_v : a.cache_k) + ((size_t)(l * 16 + b) * 128 + 32 + j) * 128 + hd);
            else val = bf4(KV + (size_t)(MP + b * SSEQ + j - 96) * 256 + v * 128 + hd);
            *(f32x4*)(out + (v ? O_VS : O_KS) + (size_t)l * 16 * 128 * 128 + e) = val; continue; } r -= 2 * N_KS;
        { const int e = r * 4, c = e & 1023, ii = (e >> 10) & 1, b = e >> 11;
            *(f32x4*)(out + O_CS + (size_t)l * 16 * 2 * 1024 + e) = bf4(U + (size_t)(MP + b * SSEQ + SSEQ - 2 + ii) * DM + c); }
    }
}

__device__ __forceinline__ int opaque_tid() { int t = threadIdx.x; asm volatile("" : "+v"(t)); return t; }

typedef float f32x4s __attribute__((ext_vector_type(4)));
__device__ __forceinline__ uint2 pack4(const f32x4s& v) { uint2 w; w.x = cvtpk(v[0], v[1]); w.y = cvtpk(v[2], v[3]); return w; }
__device__ __forceinline__ f32x4s unpack4(const uint2 w) { return (f32x4s){bflo(w.x), bfhi(w.x), bflo(w.y), bfhi(w.y)}; }

struct SEpiSwiGLU {
    bf16* H; const float* ss;
    __device__ __forceinline__ void brows(int sl, int& b0, int& b1) const { b0 = gu_map(32 * sl, 0); b1 = b0 + 128; }
    __device__ __forceinline__ void operator()(const f32x4s& c0, const f32x4s& c1, int row, int sl, int cw, int rit, int wc2, int fq, LAS float* xch) const {
        const float rs = pg8::row_rs(ss, row); f32x4s h;
#pragma unroll
        for (int e = 0; e < 4; ++e) { const float g = c0[e] * rs, u = c1[e] * rs; h[e] = g * fast_sigmoid(g) * u; }
        *(uint2*)(H + (size_t)row * DFF + 32 * sl + cw) = pack4(h);
    }
};
struct SEpiResid {
    bf16* xb; float* ssn; float scale;
    __device__ __forceinline__ void brows(int sl, int& b0, int& b1) const { b0 = 64 * sl; b1 = b0 + 32; }
    __device__ __forceinline__ void operator()(const f32x4s& c0, const f32x4s& c1, int row, int sl, int cw, int rit, int wc2, int fq, LAS float* xch) const {
        bf16* p = xb + (size_t)row * DM + 64 * sl + cw;
        const f32x4s o0 = unpack4(*(const uint2*)p) + c0 * scale, o1 = unpack4(*(const uint2*)(p + 32)) + c1 * scale;
        *(uint2*)p = pack4(o0); *(uint2*)(p + 32) = pack4(o1);
        float sq = (o0[0] * o0[0] + o0[1] * o0[1]) + (o0[2] * o0[2] + o0[3] * o0[3]) + (o1[0] * o1[0] + o1[1] * o1[1]) + (o1[2] * o1[2] + o1[3] * o1[3]);
        sq += __shfl_xor(sq, 16); sq += __shfl_xor(sq, 32);
        if (fq == 0) xch[wc2 * 64 + rit] = sq;
        __syncthreads();
        if (fq == 0 && wc2 == 0) ssn[(size_t)row * 16 + sl] = xch[rit] + xch[64 + rit];
    }
};
struct SEpiMixIn {
    const float* ss; const float* bias; bf16 *Q, *KV, *BG, *U, *SA, *SC;
    __device__ __forceinline__ void brows(int sl, int& b0, int& b1) const {
        if (sl < 36) { b0 = 64 * sl; b1 = b0 + 32; }
        else if (sl < 68) { const int f0 = 32 * (sl - 36); b0 = 2304 + 256 * (f0 >> 7) + (f0 & 127); b1 = b0 + 128; }
        else { b0 = 4352 + 64 * (sl - 68); b1 = b0 + 32; }
    }
    __device__ __forceinline__ void operator()(const f32x4s& c0, const f32x4s& c1, int row, int sl, int cw, int rit, int wc2, int fq, LAS float* xch) const {
        int b0, b1; brows(sl, b0, b1);
        bf16* dst; int ld, cb, mode; float sc = 1.f;
        if (sl < 16) { dst = Q; ld = DM; cb = 64 * sl; mode = 0; sc = QSCALE; }
        else if (sl < 20) { dst = KV; ld = 256; cb = 64 * (sl - 16); mode = 0; }
        else if (sl < 36) { dst = BG; ld = DM; cb = 64 * (sl - 20); mode = 0; }
        else if (sl < 68) { dst = U; ld = DM; cb = 32 * (sl - 36); mode = 2; }
        else if (sl < 84) { dst = SA; ld = DM; cb = 64 * (sl - 68); mode = 1; }
        else { dst = SC; ld = DM; cb = 64 * (sl - 84); mode = 1; }
        const float rs = pg8::row_rs(ss, row);
        f32x4s z0 = c0 * rs + *(const f32x4s*)(bias + b0 + cw), z1 = c1 * rs + *(const f32x4s*)(bias + b1 + cw);
        bf16* p = dst + (size_t)row * ld + cb + cw;
        if (mode == 2) { *(uint2*)p = pack4(z0 * z1); }
        else {
            if (mode == 1) {
#pragma unroll
                for (int e = 0; e < 4; ++e) { z0[e] = fast_sigmoid(z0[e]); z1[e] = fast_sigmoid(z1[e]); }
            } else { z0 = z0 * sc; z1 = z1 * sc; }
            *(uint2*)p = pack4(z0); *(uint2*)(p + 32) = pack4(z1);
        }
    }
};
struct SEpiGate {
    bf16* Gt; const bf16* ADD;
    __device__ __forceinline__ void brows(int sl, int& b0, int& b1) const { b0 = 64 * sl; b1 = b0 + 32; }
    __device__ __forceinline__ void operator()(const f32x4s& c0, const f32x4s& c1, int row, int sl, int cw, int rit, int wc2, int fq, LAS float* xch) const {
        const size_t idx = (size_t)row * DM + 64 * sl + cw;
        f32x4s a0 = (f32x4s){0.f, 0.f, 0.f, 0.f}, a1 = a0;
        if (ADD) { a0 = unpack4(*(const uint2*)(ADD + idx)); a1 = unpack4(*(const uint2*)(ADD + idx + 32)); }
        const f32x4s g0 = unpack4(*(const uint2*)(Gt + idx)), g1 = unpack4(*(const uint2*)(Gt + idx + 32));
        *(uint2*)(Gt + idx) = pack4(a0 + g0 * c0); *(uint2*)(Gt + idx + 32) = pack4(a1 + g1 * c1);
    }
};

template <class Epi>
__device__ __forceinline__ void sample_gemm(LAS unsigned char* lds, const bf16* A, const bf16* Bt, int K, int nslices, const Epi& E, int bx, int G) {
    const int tid = opaque_tid(), lane = tid & 63, wave = __builtin_amdgcn_readfirstlane(tid >> 6), fr = lane & 15, fq = lane >> 4, wr4 = wave >> 1, wc2 = wave & 1;
    constexpr int RS = 272;
    LAS unsigned char* As = lds; LAS unsigned char* Bs = lds + 64 * RS; LAS float* xch = (LAS float*)(lds + 2 * 64 * RS);
    const int srow = tid >> 3, sch = tid & 7, nst = K >> 7, ntasks = nslices * 8;
    const int pbx = (G % 8 == 0) ? (bx & 7) * (G >> 3) + (bx >> 3) : bx;
    for (int t = pbx; t < ntasks; t += G) {
        const int sl = t >> 3, tm = t & 7;
        int br0, br1; E.brows(sl, br0, br1);
        const bf16* ag = A + (size_t)(MP + tm * 64 + srow) * K + sch * 8;
        const bf16* bg = Bt + (size_t)((srow < 32) ? br0 + srow : br1 + (srow - 32)) * K + sch * 8;
        u32x4 ra0 = *(const u32x4*)ag, ra1 = *(const u32x4*)(ag + 64), rb0 = *(const u32x4*)bg, rb1 = *(const u32x4*)(bg + 64);
        f32x4s c0 = (f32x4s){0.f, 0.f, 0.f, 0.f}, c1 = c0;
        for (int s = 0; s < nst; ++s) {
            __syncthreads();
            *(LAS u32x4*)(As + srow * RS + sch * 16) = ra0; *(LAS u32x4*)(As + srow * RS + (sch + 8) * 16) = ra1;
            *(LAS u32x4*)(Bs + srow * RS + sch * 16) = rb0; *(LAS u32x4*)(Bs + srow * RS + (sch + 8) * 16) = rb1;
            __syncthreads();
            if (s + 1 < nst) { const int o = (s + 1) * 128; ra0 = *(const u32x4*)(ag + o); ra1 = *(const u32x4*)(ag + o + 64); rb0 = *(const u32x4*)(bg + o); rb1 = *(const u32x4*)(bg + o + 64); }
#pragma unroll
            for (int ks = 0; ks < 4; ++ks) {
                const bf16x8 af = *(const LAS bf16x8*)(As + (wr4 * 16 + fr) * RS + ks * 64 + fq * 16);
                const bf16x8 bf0 = *(const LAS bf16x8*)(Bs + (wc2 * 16 + fr) * RS + ks * 64 + fq * 16), bf1 = *(const LAS bf16x8*)(Bs + (32 + wc2 * 16 + fr) * RS + ks * 64 + fq * 16);
                c0 = __builtin_amdgcn_mfma_f32_16x16x32_bf16(bf0, af, c0, 0, 0, 0); c1 = __builtin_amdgcn_mfma_f32_16x16x32_bf16(bf1, af, c1, 0, 0, 0);
            }
        }
        E(c0, c1, MP + tm * 64 + wr4 * 16 + fr, sl, wc2 * 16 + 4 * fq, wr4 * 16 + fr, wc2, fq, xch);
    }
    __syncthreads();
}

#define RLX_AGENT __ATOMIC_RELAXED, __HIP_MEMORY_SCOPE_AGENT
#define XB_TMO      128
#define XB_XCNT(j)  (256  + 64 * (j))
#define XB_XSUB(j)  (1280 + 64 * (j))
#define XB_XGEN(j)  (2304 + 64 * (j))
#define XB_TOP      3328
#define XB_TOPGEN   3392
#define XCD_BAR_WORDS 3456
#define XB_SPIN_CAP (1u << 18)

__device__ __forceinline__ unsigned xb_ld(unsigned* p)              { return __hip_atomic_load(p, __ATOMIC_RELAXED, __HIP_MEMORY_SCOPE_AGENT); }
__device__ __forceinline__ unsigned xb_add(unsigned* p, unsigned v) { return __hip_atomic_fetch_add(p, v, __ATOMIC_RELAXED, __HIP_MEMORY_SCOPE_AGENT); }
__device__ __forceinline__ unsigned xb_xcc_id() { return (unsigned)__builtin_amdgcn_s_getreg((3 << 11) | 20) & 0xFu; }
#define XB_SPIN(cond, bar) do { unsigned _sp = 0; while (cond) { __builtin_amdgcn_s_sleep(1); \
    if ((++_sp & 255u) == 0u) { if (xb_ld(&(bar)[XB_TMO])) break; if (_sp > XB_SPIN_CAP) { atomicAdd(&(bar)[XB_TMO], 1u); break; } } } } while (0)

struct XcdBarrier {
    unsigned* bar; unsigned x;
    volatile LAS unsigned* st;
};

__device__ __forceinline__ XcdBarrier xcd_barrier_post(unsigned* bar, volatile LAS unsigned* st) {
    XcdBarrier b; b.bar = bar; b.x = xb_xcc_id(); b.st = st;
    if (threadIdx.x == 0) (void)xb_add(&bar[XB_XCNT(b.x)], 1u);
    return b;
}
__device__ __forceinline__ void xcd_barrier_complete(unsigned* bar, unsigned x, unsigned& nloc, unsigned& nx) {
    const unsigned G = gridDim.x * gridDim.y * gridDim.z;
    unsigned sum, cnt, mine, sp = 0u;
    for (;;) {
        sum = 0u; cnt = 0u; mine = 0u;
#pragma unroll
        for (unsigned j = 0; j < 16; ++j) { const unsigned c = xb_ld(&bar[XB_XCNT(j)]); sum += c; cnt += (c > 0u) ? 1u : 0u; mine = (j == x) ? c : mine; }
        if (sum == G) break;
        __builtin_amdgcn_s_sleep(1);
        if ((++sp & 255u) == 0u) { if (xb_ld(&bar[XB_TMO])) break; if (sp > XB_SPIN_CAP) { atomicAdd(&bar[XB_TMO], 1u); break; } }
    }
    nloc = mine > 0u ? mine : 1u; nx = cnt > 0u ? cnt : 1u;
}

__device__ __forceinline__ void xcd_barrier(const XcdBarrier& b) {
    asm volatile("s_waitcnt vmcnt(0)" ::: "memory");
    __syncthreads();
    if (threadIdx.x == 0) {
        unsigned* bar = b.bar;
        __builtin_amdgcn_s_waitcnt(0);
        unsigned nloc = b.st[0], nx = b.st[1];
        if (nloc == 0u) { xcd_barrier_complete(bar, b.x, nloc, nx); b.st[0] = nloc; b.st[1] = nx; }
        const unsigned old = xb_add(&bar[XB_XSUB(b.x)], 1u);
        const unsigned gen = old / nloc;
        if (old + 1u == (gen + 1u) * nloc) {
            __builtin_amdgcn_fence(__ATOMIC_RELEASE, "agent");
            asm volatile("s_waitcnt vmcnt(0)" ::: "memory");
            const unsigned og = xb_add(&bar[XB_TOP], 1u);
            const unsigned tg = og / nx;
            if (og + 1u == (tg + 1u) * nx) xb_add(&bar[XB_TOPGEN], 1u);
            else XB_SPIN(xb_ld(&bar[XB_TOPGEN]) == tg, bar);
            __builtin_amdgcn_fence(__ATOMIC_ACQUIRE, "agent");
            xb_add(&bar[XB_XGEN(b.x)], 1u);
            asm volatile("s_waitcnt vmcnt(0)" ::: "memory");
        } else {
            XB_SPIN(xb_ld(&bar[XB_XGEN(b.x)]) == gen, bar);
            __builtin_amdgcn_fence(__ATOMIC_ACQUIRE, "agent");
            asm volatile("s_waitcnt vmcnt(0)" ::: "memory");
        }
    }
    __syncthreads();
}

__global__ void __launch_bounds__(NTHR, 2) fwd_megakernel(Args a) {
    extern __shared__ __attribute__((aligned(16))) unsigned char lds_raw[];
    LAS unsigned char* lds = (LAS unsigned char*)lds_raw;
    cg::grid_group grid = cg::this_grid();
    volatile LAS unsigned* bar_st = (volatile LAS unsigned*)(lds + 131072 + 64);
    if (threadIdx.x < 2) bar_st[threadIdx.x] = 0u;
    __syncthreads();
    const int G = gridDim.x, bx = blockIdx.x;
    unsigned char* ws = a.ws;
    float* ss = (float*)(ws + WS_SS);
    bf16* XB = (bf16*)(ws + WS_XB); bf16* H = (bf16*)(ws + WS_H);
    bf16 *Q = (bf16*)(ws + WS_Q), *BG = (bf16*)(ws + WS_BG), *U = (bf16*)(ws + WS_U), *SA = (bf16*)(ws + WS_SA), *SC = (bf16*)(ws + WS_SC), *KV = (bf16*)(ws + WS_KV);
    float* xout = a.out;

#if !(MK_SKIP & 1)
    { const int tid = opaque_tid(), lane = tid & 63, wave = __builtin_amdgcn_readfirstlane(tid >> 6); prologue(a, lds, tid, lane, wave);
      if (MK_DUP & 1) { __syncthreads(); prologue(a, lds, tid, lane, wave); } }
#endif
    grid.sync();
    const XcdBarrier bar = xcd_barrier_post((unsigned*)(a.ws + WS_BAR), bar_st);

#pragma nounroll
    for (int l = 0; l < 2; ++l) {
        const bf16* Wl = (const bf16*)(ws + WS_W) + (size_t)l * E_LAYER;
#if !(MK_SKIP & 2)
        { SEpiSwiGLU SE{H, ss + (size_t)(3 * l) * MT * 16}; sample_gemm(lds, XB, Wl + E_W1GU, DM, DFF / 32, SE, bx, G);
          pg8::Gemm g{XB, Wl + E_W1GU, MP, 2 * DFF, DM}; pg8::StaticOrder S; S.init(MP, 2 * DFF, G, bx); pg8::EpiSwiGLU E{H, ss + (size_t)(3 * l) * MT * 16};
          pg8::gemm_phase<pg8::EpiSwiGLU, pg8::StaticOrder, true, true>(lds, g, S, E);
          if (MK_DUP & 2) pg8::gemm_phase<pg8::EpiSwiGLU, pg8::StaticOrder, true, true>(lds, g, S, E); }
#endif
        xcd_barrier(bar);
        if (MK_DUP & 8) xcd_barrier(bar);
#if !(MK_SKIP & 4)
        { SEpiResid SE{XB, ss + (size_t)(3 * l + 1) * MT * 16, 0.5f}; sample_gemm(lds, H, Wl + E_W1D, DFF, DM / 64, SE, bx, G);
          pg8::Gemm g{H, Wl + E_W1D, MP, DM, DFF}; pg8::StaticOrder S; S.init(MP, DM, G, bx);
          pg8::EpiResid E{XB, ss + (size_t)(3 * l + 1) * MT * 16, 0.5f};
          pg8::gemm_phase<pg8::EpiResid, pg8::StaticOrder, true, true>(lds, g, S, E); }
#endif
        xcd_barrier(bar);
        if (MK_DUP & 8) xcd_barrier(bar);
#if !(MK_SKIP & 8)
        { SEpiMixIn SE{ss + (size_t)(3 * l + 1) * MT * 16, (const float*)(ws + WS_BIAS) + l * NIN, Q, KV, BG, U, SA, SC}; sample_gemm(lds, XB, Wl + E_WIN, DM, 100, SE, bx, G);
          pg8::Gemm g{XB, Wl + E_WIN, MP, NIN, DM}; pg8::StaticOrder S; S.init(MP, NIN, G, bx);
          pg8::EpiMixIn E{ss + (size_t)(3 * l + 1) * MT * 16, (const float*)(ws + WS_BIAS) + l * NIN, Q, KV, BG, U, SA, SC};
          pg8::gemm_phase<pg8::EpiMixIn, pg8::StaticOrder, true, true>(lds, g, S, E); }
#endif
        xcd_barrier(bar);
        if (MK_DUP & 8) xcd_barrier(bar);
#if !(MK_SKIP & 16)
        { const int tid = opaque_tid(), lane = tid & 63, wave = __builtin_amdgcn_readfirstlane(tid >> 6);
          const float* ck = a.cache_k + (size_t)l * 16 * 128 * 128; const float* cv = a.cache_v + (size_t)l * 16 * 128 * 128;
          for (int it = bx; it < N_ATT_ITEMS; it += G) attn_item(lds, Q, Q, KV, ck, cv, a.sinks + l * 16, it, tid, lane, wave);
          for (int ch = bx; ch < MT / 16; ch += G) conv_chunk(BG, U, a.conv_w + (size_t)l * 3 * DM, a.state_conv + (size_t)l * 16 * 2 * DM, ch, tid);
          state_copies(a, l, KV, U, bx * NTHR + tid, G * NTHR); }
#endif
        xcd_barrier(bar);
        if (MK_DUP & 8) xcd_barrier(bar);
#if !(MK_SKIP & 32)
        { SEpiGate SE{SA, nullptr}; sample_gemm(lds, Q, Wl + E_WOA, DM, DM / 64, SE, bx, G);
          pg8::Gemm g{Q, Wl + E_WOA, MP, DM, DM}; pg8::StaticOrder S; S.init(MP, DM, G, bx); pg8::EpiGate E{SA, nullptr};
          pg8::gemm_phase<pg8::EpiGate, pg8::StaticOrder, true, true>(lds, g, S, E); }
        { SEpiGate SE{SC, SA}; sample_gemm(lds, BG, Wl + E_WOC, DM, DM / 64, SE, bx, G);
          pg8::Gemm g{BG, Wl + E_WOC, MP, DM, DM}; pg8::StaticOrder S; S.init(MP, DM, G, bx); pg8::EpiGate E{SC, SA};
          pg8::gemm_phase<pg8::EpiGate, pg8::StaticOrder, true, true>(lds, g, S, E); }
#endif
        xcd_barrier(bar);
        if (MK_DUP & 8) xcd_barrier(bar);
#if !(MK_SKIP & 64)
        { SEpiResid SE{XB, ss + (size_t)(3 * l + 2) * MT * 16, 1.0f}; sample_gemm(lds, SC, Wl + E_WO, DM, DM / 64, SE, bx, G);
          pg8::Gemm g{SC, Wl + E_WO, MP, DM, DM}; pg8::StaticOrder S; S.init(MP, DM, G, bx);
          pg8::EpiResid E{XB, ss + (size_t)(3 * l + 2) * MT * 16, 1.0f};
          pg8::gemm_phase<pg8::EpiResid, pg8::StaticOrder, true, true>(lds, g, S, E); }
#endif
        xcd_barrier(bar);
        if (MK_DUP & 8) xcd_barrier(bar);
#if !(MK_SKIP & 128)
        { SEpiSwiGLU SE{H, ss + (size_t)(3 * l + 2) * MT * 16}; sample_gemm(lds, XB, Wl + E_W2GU, DM, DFF / 32, SE, bx, G);
          pg8::Gemm g{XB, Wl + E_W2GU, MP, 2 * DFF, DM}; pg8::StaticOrder S; S.init(MP, 2 * DFF, G, bx); pg8::EpiSwiGLU E{H, ss + (size_t)(3 * l + 2) * MT * 16};
          pg8::gemm_phase<pg8::EpiSwiGLU, pg8::StaticOrder, true, true>(lds, g, S, E); }
#endif
        xcd_barrier(bar);
        if (MK_DUP & 8) xcd_barrier(bar);
#if !(MK_SKIP & 256)
        { SEpiResid SE{XB, ss + (size_t)(3 * l + 3) * MT * 16, 0.5f}; sample_gemm(lds, H, Wl + E_W2D, DFF, DM / 64, SE, bx, G);
          pg8::Gemm g{H, Wl + E_W2D, MP, DM, DFF}; pg8::StaticOrder S; S.init(MP, DM, G, bx);
          pg8::EpiResid E{XB, ss + (size_t)(3 * l + 3) * MT * 16, 0.5f};
          pg8::gemm_phase<pg8::EpiResid, pg8::StaticOrder, true, true>(lds, g, S, E); }
#endif
        xcd_barrier(bar);
        if (MK_DUP & 8) xcd_barrier(bar);
    }
    { const int tid = opaque_tid(), lane = tid & 63, wave = __builtin_amdgcn_readfirstlane(tid >> 6);
      const int gw = bx * NWAVES + wave, NGW = G * NWAVES; const float* ssf = ss + (size_t)6 * MT * 16;
      f32x4 gv[4];
#pragma unroll
      for (int j = 0; j < 4; ++j) gv[j] = ((const f32x4*)a.norm_final)[lane + 64 * j];
      for (int m = gw; m < MT; m += NGW) { const float rs = pg8::row_rs(ssf, m); f32x4* yr = (f32x4*)(xout + (size_t)m * DM); const uint2* xr = (const uint2*)(XB + (size_t)m * DM);
#pragma unroll
          for (int j = 0; j < 4; ++j) { const uint2 w = xr[lane + 64 * j]; const f32x4 v = (f32x4){bflo(w.x), bfhi(w.x), bflo(w.y), bfhi(w.y)}; yr[lane + 64 * j] = v * rs * gv[j]; } } }
}

extern "C" void kernel_launch(void* const* d_in, const int* in_sizes, int n_in, void* d_out, int out_size, void* d_ws, size_t ws_size, hipStream_t stream) {
    static int grid = 0;
    if (grid == 0) {
        if (n_in != 22 || in_sizes[0] != MP * DM || (size_t)out_size != O_END || ws_size < WS_SS + (size_t)7 * MT * 64) { fprintf(stderr, "kernel_launch: unexpected shapes (n_in %d, in0 %d, out %d, ws %zu)\n", n_in, n_in > 0 ? in_sizes[0] : -1, out_size, ws_size); grid = -1; return; }
        int dev = 0, cus = 0, per_cu = 0;
        hipGetDevice(&dev); hipDeviceGetAttribute(&cus, hipDeviceAttributeMultiprocessorCount, dev);
        if (hipFuncSetAttribute((const void*)fwd_megakernel, hipFuncAttributeMaxDynamicSharedMemorySize, LDS_BYTES) != hipSuccess) { fprintf(stderr, "kernel_launch: hipFuncSetAttribute failed\n"); grid = -1; return; }
        if (hipOccupancyMaxActiveBlocksPerMultiprocessor(&per_cu, (const void*)fwd_megakernel, NTHR, LDS_BYTES) != hipSuccess || per_cu < 1) { fprintf(stderr, "kernel_launch: occupancy query says %d\n", per_cu); per_cu = 1; }
        (void)hipGetLastError();
        grid = cus;
    }
    if (grid < 0) return;
    Args a{};
    a.x_prompt = (const float*)d_in[0]; a.x_sample = (const float*)d_in[1]; a.cache_k = (const float*)d_in[2]; a.cache_v = (const float*)d_in[3]; a.state_conv = (const float*)d_in[4];
    a.norm_ffn1 = (const float*)d_in[5]; a.w1_gate = (const float*)d_in[6]; a.w1_up = (const float*)d_in[7]; a.w1_down = (const float*)d_in[8];
    a.norm_mix = (const float*)d_in[9]; a.w_in = (const float*)d_in[10]; a.b_in = (const float*)d_in[11]; a.sinks = (const float*)d_in[12]; a.conv_w = (const float*)d_in[13];
    a.w_o_attn = (const float*)d_in[14]; a.w_o_conv = (const float*)d_in[15]; a.w_o = (const float*)d_in[16];
    a.norm_ffn2 = (const float*)d_in[17]; a.w2_gate = (const float*)d_in[18]; a.w2_up = (const float*)d_in[19]; a.w2_down = (const float*)d_in[20]; a.norm_final = (const float*)d_in[21];
    a.out = (float*)d_out; a.ws = (unsigned char*)d_ws;
    void* args[] = {&a};
    hipError_t e = hipLaunchCooperativeKernel((const void*)fwd_megakernel, dim3(grid), dim3(NTHR), args, LDS_BYTES, stream);
    if (e != hipSuccess) fprintf(stderr, "kernel_launch: cooperative launch failed: %s (grid %d)\n", hipGetErrorString(e), grid);
}
```

```cpp
#include <hip/hip_runtime.h>
#include <hip/hip_cooperative_groups.h>
#include <cstdio>
#include <cstdint>
namespace cg = cooperative_groups;

constexpr int DM = 1024, DFF = 2816, NIN = 6400;
constexpr int NB = 8, SEQ = 8192, SBAT = 16, SSEQ = 32;
constexpr int MP = NB * SEQ, MS = SBAT * SSEQ, MT = MP + MS;
constexpr float EPS = 1e-6f, LOG2E = 1.4426950408889634f;
constexpr float QSCALE = 0.125f * LOG2E;

typedef float f32x2_t __attribute__((ext_vector_type(2)));
typedef __bf16 bf16x2_t __attribute__((ext_vector_type(2)));
__device__ __forceinline__ unsigned cvtpk(float lo, float hi) { f32x2_t v = {lo, hi}; bf16x2_t b = __builtin_convertvector(v, bf16x2_t); return __builtin_bit_cast(unsigned, b); }
__device__ __forceinline__ float bflo(unsigned w) { return __uint_as_float(w << 16); }
__device__ __forceinline__ float bfhi(unsigned w) { return __uint_as_float(w & 0xffff0000u); }
__device__ __forceinline__ float fast_sigmoid(float z) { return __builtin_amdgcn_rcpf(1.0f + __builtin_amdgcn_exp2f(-z * LOG2E)); }

namespace pg8 {
#define PG8_LAS __attribute__((address_space(3)))
typedef unsigned short bf16_t;
typedef short bf16x8 __attribute__((ext_vector_type(8)));
typedef float f32x4 __attribute__((ext_vector_type(4)));
typedef unsigned u32x4 __attribute__((ext_vector_type(4)));
constexpr int BM = 256, BK = 64, HALF = 128, HTB = HALF * BK * 2  , STAGE_BYTES = 8 * HTB, NXCD = 8, WGM = 8;

__host__ __device__ __forceinline__ int lds_byte(int r, int c) { const int st = (r >> 4) * 2 + (c >> 5), rr = r & 15, cc = c & 31, ob = rr * 64 + cc * 2; return st * 1024 + (ob ^ (((ob >> 9) & 1) << 5)); }
__host__ __device__ __forceinline__ void stage_rc(int b, int& R, int& C) { const int st = b / 1024, sb = b % 1024, swz = sb ^ (((sb >> 9) & 1) << 5); R = (st >> 1) * 16 + swz / 64; C = (st & 1) * 32 + (swz % 64) / 2; }
__host__ __device__ __forceinline__ int perm32(int rho) { const int n = rho >> 4, i = rho & 15; return 8 * (i >> 2) + 4 * n + (i & 3); }

struct Unit { int pm, pn; };
struct Gemm { const bf16_t* A; const bf16_t* Bt; int M, N, K; };

struct StaticOrder {
    int nM, nN, nwg, G, c;
    __host__ __device__ void init(int M, int N, int G_, int c_) { nM = M / BM; nN = N / BM; nwg = nM * nN; G = G_; c = c_; }
    __host__ __device__ bool next(int i, Unit& u) const {
        const long L = (long)i * G + c; if (L >= nwg) return false;
        int wgid = (int)L; { const int q = nwg / NXCD, r = nwg % NXCD, xcd = wgid % NXCD, off = wgid / NXCD; wgid = (xcd < r ? xcd * (q + 1) : r * (q + 1) + (xcd - r) * q) + off; }
        const int nig = WGM * nN, gid = wgid / nig, fm = gid * WGM, gsz = (nM - fm) < WGM ? (nM - fm) : WGM;
        u.pm = fm + ((wgid % nig) % gsz); u.pn = (wgid % nig) / gsz; return true;
    }
    __device__ __forceinline__ void a_ready(const Unit&) const {}
    __device__ __forceinline__ void done(const Unit&) const {}
};

__device__ __forceinline__ float row_rs(const float* ss, int row) { const f32x4* p = (const f32x4*)(ss + (size_t)row * 16); const f32x4 a = p[0], b = p[1], c = p[2], d = p[3];
    const float s = ((a[0] + a[1]) + (a[2] + a[3])) + ((b[0] + b[1]) + (b[2] + b[3])) + ((c[0] + c[1]) + (c[2] + c[3])) + ((d[0] + d[1]) + (d[2] + d[3]));
    return __builtin_amdgcn_rsqf(s * (1.0f / 1024.0f) + EPS); }

__device__ __forceinline__ void wave_rs_table(PG8_LAS float* tab, const float* ss, int row_base, int lane) {
#pragma unroll
    for (int h = 0; h < 2; ++h) { const int j = lane + 64 * h; tab[j] = row_rs(ss, row_base + (j >> 6) * HALF + (j & 63)); }
    asm volatile("s_waitcnt lgkmcnt(0)" ::: "memory"); __builtin_amdgcn_wave_barrier(); asm volatile("" ::: "memory");
}

struct EpiSwiGLU {
    static constexpr bool PERM = true, AFTER_DRAIN = false;
    bf16_t* H; const float* ss; PG8_LAS float* tabs;
    __device__ __forceinline__ void operator()(const f32x4 (&acc)[2][2][4][2], const Unit& u, int wr, int wc, int fr, int fq) const {
        const int row0 = u.pm * BM + wr * 64 + fr, col0 = u.pn * 128 + wc * 32 + 8 * fq;
        PG8_LAS float* tab = tabs + (wr * 4 + wc) * 128; wave_rs_table(tab, ss, u.pm * BM + wr * 64, fq * 16 + fr);
#pragma unroll
        for (int ai = 0; ai < 2; ++ai)
#pragma unroll
            for (int m = 0; m < 4; ++m) {
                const int row = row0 + ai * HALF + m * 16; const float rs = tab[ai * 64 + m * 16 + fr];
                float h[8];
#pragma unroll
                for (int n = 0; n < 2; ++n)
#pragma unroll
                    for (int e = 0; e < 4; ++e) { const float g = acc[ai][0][m][n][e] * rs, up = acc[ai][1][m][n][e] * rs; h[n * 4 + e] = g * fast_sigmoid(g) * up; }
                u32x4 w; w.x = cvtpk(h[0], h[1]); w.y = cvtpk(h[2], h[3]); w.z = cvtpk(h[4], h[5]); w.w = cvtpk(h[6], h[7]);
                *(u32x4*)(H + (size_t)row * DFF + col0) = w;
            }
    }
};

struct EpiResid {
    static constexpr bool PERM = true, AFTER_DRAIN = false;
    bf16_t* xb; float* ssn; float scale;
    __device__ __forceinline__ void operator()(const f32x4 (&acc)[2][2][4][2], const Unit& u, int wr, int wc, int fr, int fq) const {
        const int row0 = u.pm * BM + wr * 64 + fr, col0 = u.pn * BM + wc * 32 + 8 * fq;
#pragma unroll
        for (int ai = 0; ai < 2; ++ai)
#pragma unroll
            for (int m = 0; m < 4; ++m) {
                const int row = row0 + ai * HALF + m * 16;
                bf16_t* xr = xb + (size_t)row * DM + col0;
                const u32x4 g0 = *(const u32x4*)xr, g1 = *(const u32x4*)(xr + HALF);
                float sq = 0.f;
#pragma unroll
                for (int bj = 0; bj < 2; ++bj) {
                    const u32x4 g = bj ? g1 : g0; const f32x4 p0 = acc[ai][bj][m][0], p1 = acc[ai][bj][m][1];
                    const float o0 = bflo(g.x) + scale * p0[0], o1 = bfhi(g.x) + scale * p0[1], o2 = bflo(g.y) + scale * p0[2], o3 = bfhi(g.y) + scale * p0[3];
                    const float o4 = bflo(g.z) + scale * p1[0], o5 = bfhi(g.z) + scale * p1[1], o6 = bflo(g.w) + scale * p1[2], o7 = bfhi(g.w) + scale * p1[3];
                    u32x4 w; w.x = cvtpk(o0, o1); w.y = cvtpk(o2, o3); w.z = cvtpk(o4, o5); w.w = cvtpk(o6, o7);
                    *(u32x4*)(xr + bj * HALF) = w;
                    sq += (o0 * o0 + o1 * o1) + (o2 * o2 + o3 * o3) + (o4 * o4 + o5 * o5) + (o6 * o6 + o7 * o7);
                }
                sq += __shfl_xor(sq, 16); sq += __shfl_xor(sq, 32);
                if (fq == 0) ssn[(size_t)row * 16 + u.pn * 4 + wc] = sq;
            }
    }
};

struct EpiMixIn {
    static constexpr bool PERM = true, AFTER_DRAIN = false;
    const float* ss; const float* bias; bf16_t *Q, *KV, *BG, *U, *SA, *SC; PG8_LAS float* tabs;
    __device__ __forceinline__ void operator()(const f32x4 (&acc)[2][2][4][2], const Unit& u, int wr, int wc, int fr, int fq) const {
        PG8_LAS float* tab = tabs + (wr * 4 + wc) * 128; wave_rs_table(tab, ss, u.pm * BM + wr * 64, fq * 16 + fr);
        const int pn = u.pn; bf16_t* dst; int ld, cbase, mode; float sc = 1.f;
        if (pn < 4) { dst = Q; ld = DM; cbase = pn * 256; mode = 0; sc = QSCALE; }
        else if (pn == 4) { dst = KV; ld = 256; cbase = 0; mode = 0; }
        else if (pn < 9) { dst = BG; ld = DM; cbase = (pn - 5) * 256; mode = 0; }
        else if (pn < 17) { dst = U; ld = DM; cbase = (pn - 9) * 128; mode = 2; }
        else if (pn < 21) { dst = SA; ld = DM; cbase = (pn - 17) * 256; mode = 1; }
        else { dst = SC; ld = DM; cbase = (pn - 21) * 256; mode = 1; }
        const int row0 = u.pm * BM + wr * 64 + fr, cw = wc * 32 + 8 * fq;
        f32x4 bv[2][2];
#pragma unroll
        for (int bj = 0; bj < 2; ++bj)
#pragma unroll
            for (int n = 0; n < 2; ++n) bv[bj][n] = *(const f32x4*)(bias + pn * 256 + bj * HALF + cw + 4 * n);
#pragma unroll
        for (int ai = 0; ai < 2; ++ai)
#pragma unroll
            for (int m = 0; m < 4; ++m) {
                const int row = row0 + ai * HALF + m * 16; const float rs = tab[ai * 64 + m * 16 + fr];
                bf16_t* rowp = dst + (size_t)row * ld + cbase + cw;
                if (mode == 2) {
                    const f32x4 z0 = (acc[ai][0][m][0] * rs + bv[0][0]) * (acc[ai][1][m][0] * rs + bv[1][0]);
                    const f32x4 z1 = (acc[ai][0][m][1] * rs + bv[0][1]) * (acc[ai][1][m][1] * rs + bv[1][1]);
                    u32x4 w; w.x = cvtpk(z0[0], z0[1]); w.y = cvtpk(z0[2], z0[3]); w.z = cvtpk(z1[0], z1[1]); w.w = cvtpk(z1[2], z1[3]);
                    *(u32x4*)rowp = w;
                } else {
#pragma unroll
                    for (int bj = 0; bj < 2; ++bj) {
                        f32x4 z0 = acc[ai][bj][m][0] * rs + bv[bj][0], z1 = acc[ai][bj][m][1] * rs + bv[bj][1];
                        if (mode == 1) {
#pragma unroll
                            for (int e = 0; e < 4; ++e) { z0[e] = fast_sigmoid(z0[e]); z1[e] = fast_sigmoid(z1[e]); }
                        } else { z0 = z0 * sc; z1 = z1 * sc; }
                        u32x4 w; w.x = cvtpk(z0[0], z0[1]); w.y = cvtpk(z0[2], z0[3]); w.z = cvtpk(z1[0], z1[1]); w.w = cvtpk(z1[2], z1[3]);
                        *(u32x4*)(rowp + bj * HALF) = w;
                    }
                }
            }
    }
};

struct EpiGate {
    static constexpr bool PERM = true, AFTER_DRAIN = false;
    bf16_t* G; const bf16_t* ADD;
    __device__ __forceinline__ void operator()(const f32x4 (&acc)[2][2][4][2], const Unit& u, int wr, int wc, int fr, int fq) const {
        const int row0 = u.pm * BM + wr * 64 + fr, col0 = u.pn * BM + wc * 32 + 8 * fq;
#pragma unroll
        for (int ai = 0; ai < 2; ++ai)
#pragma unroll
            for (int m = 0; m < 4; ++m) {
                const int row = row0 + ai * HALF + m * 16;
#pragma unroll
                for (int bj = 0; bj < 2; ++bj) {
                    const size_t idx = (size_t)row * DM + col0 + bj * HALF;
                    const u32x4 g = *(const u32x4*)(G + idx);
                    u32x4 a = (u32x4){0u, 0u, 0u, 0u}; if (ADD) a = *(const u32x4*)(ADD + idx);
                    const f32x4 p0 = acc[ai][bj][m][0], p1 = acc[ai][bj][m][1];
                    u32x4 w;
                    w.x = cvtpk(bflo(a.x) + bflo(g.x) * p0[0], bfhi(a.x) + bfhi(g.x) * p0[1]);
                    w.y = cvtpk(bflo(a.y) + bflo(g.y) * p0[2], bfhi(a.y) + bfhi(g.y) * p0[3]);
                    w.z = cvtpk(bflo(a.z) + bflo(g.z) * p1[0], bfhi(a.z) + bfhi(g.z) * p1[1]);
                    w.w = cvtpk(bflo(a.w) + bflo(g.w) * p1[2], bfhi(a.w) + bfhi(g.w) * p1[3]);
                    *(u32x4*)(G + idx) = w;
                }
            }
    }
};

template <class Epi, class Sched, bool ALIGN_EPI = false, bool SP2 = false>
__device__ __forceinline__ void gemm_phase(PG8_LAS unsigned char* lds, const Gemm g, const Sched& S, const Epi& E) {
    int tid_ = threadIdx.x; asm volatile("" : "+v"(tid_));
    const int tid = tid_, wid = __builtin_amdgcn_readfirstlane(tid >> 6), lane = tid & 63, wr = wid >> 2, wc = wid & 3, fr = lane & 15, fq = lane >> 4;
    const int K = g.K, nt = K / BK;
    unsigned voffA[2], voffB[2];
#pragma unroll
    for (int i = 0; i < 2; ++i) { int R, C; stage_rc(tid * 16 + i * 8192, R, C); const int Rb = Epi::PERM ? ((R & ~31) + perm32(R & 31)) : R;
        voffA[i] = (unsigned)(R * K + C) * 2u; voffB[i] = (unsigned)(Rb * K + C) * 2u; }
    const size_t kstep = (size_t)(BK * 2);
    const size_t hstep = (size_t)HALF * K * 2;
    const size_t tstep = 2 * hstep;
    const unsigned ldsw = (unsigned)wid * 1024u;
    const int aoff = lds_byte(wr * 64 + fr, fq * 8), boff = lds_byte(wc * 32 + fr, fq * 8);
#define PG8_SA(b, h) (((b) * 2 + (h)) * HTB)
#define PG8_SB(b, h) ((4 + (b) * 2 + (h)) * HTB)
#define PG8_STAGE(bufoff, gbase, voff) do { _Pragma("unroll") for (int _i = 0; _i < 2; ++_i) \
        __builtin_amdgcn_global_load_lds((const unsigned*)((const char*)(gbase) + (voff)[_i]), (PG8_LAS unsigned*)(lds + (bufoff) + ldsw + _i * 8192), 16, 0, 0); } while (0)
#define PG8_LDA(dst, b, h) do { _Pragma("unroll") for (int m = 0; m < 4; ++m) _Pragma("unroll") for (int k = 0; k < 2; ++k) dst[m][k] = *(const PG8_LAS bf16x8*)(lds + PG8_SA(b, h) + aoff + m * 2048 + k * 1024); } while (0)
#define PG8_LDB(dst, b, h) do { _Pragma("unroll") for (int n = 0; n < 2; ++n) _Pragma("unroll") for (int k = 0; k < 2; ++k) dst[n][k] = *(const PG8_LAS bf16x8*)(lds + PG8_SB(b, h) + boff + n * 2048 + k * 1024); } while (0)
#define PG8_MMA(ai, bj, At, Bt) do { __builtin_amdgcn_s_setprio(1); _Pragma("unroll") for (int m = 0; m < 4; ++m) _Pragma("unroll") for (int n = 0; n < 2; ++n) _Pragma("unroll") for (int k = 0; k < 2; ++k) \
        acc[ai][bj][m][n] = __builtin_amdgcn_mfma_f32_16x16x32_bf16(Bt[n][k], At[m][k], acc[ai][bj][m][n], 0, 0, 0); __builtin_amdgcn_s_setprio(0); } while (0)
#define PG8_WAIT_V(n) asm volatile("s_waitcnt vmcnt(" #n ")" ::: "memory")
#define PG8_WAIT_L(n) asm volatile("s_waitcnt lgkmcnt(" #n ")" ::: "memory")
#define PG8_BAR __builtin_amdgcn_s_barrier()
#define PG8_SCHED __builtin_amdgcn_sched_barrier(0)
    Unit cur, nxt; int ui = 0;
    if (!S.next(0, cur)) return;
    f32x4 acc[2][2][4][2];
#pragma unroll
    for (int a = 0; a < 2; ++a)
#pragma unroll
        for (int b = 0; b < 2; ++b)
#pragma unroll
            for (int m = 0; m < 4; ++m)
#pragma unroll
                for (int n = 0; n < 2; ++n) acc[a][b][m][n] = (f32x4){0.f, 0.f, 0.f, 0.f};
    bf16x8 At[4][2], B0[2][2], B1[2][2];
    const char* cA = (const char*)g.A + (size_t)cur.pm * tstep; const char* cB = (const char*)g.Bt + (size_t)cur.pn * tstep;
    S.a_ready(cur);
    if constexpr (SP2) {
        PG8_STAGE(PG8_SB(0, 0), cB, voffB); PG8_STAGE(PG8_SB(0, 1), cB + hstep, voffB); PG8_STAGE(PG8_SA(0, 0), cA, voffA); PG8_STAGE(PG8_SA(0, 1), cA + hstep, voffA);
        if (wr == 1) PG8_BAR;
        PG8_WAIT_V(2); PG8_BAR;
        PG8_STAGE(PG8_SB(1, 0), cB + kstep, voffB); PG8_STAGE(PG8_SA(1, 0), cA + kstep, voffA); PG8_STAGE(PG8_SB(1, 1), cB + hstep + kstep, voffB);
        PG8_WAIT_V(6); PG8_BAR;
    } else {
        PG8_STAGE(PG8_SB(0, 0), cB, voffB); PG8_STAGE(PG8_SA(0, 0), cA, voffA); PG8_STAGE(PG8_SB(0, 1), cB + hstep, voffB); PG8_STAGE(PG8_SA(0, 1), cA + hstep, voffA);
        if (wr == 1) PG8_BAR;
        PG8_WAIT_V(4); PG8_BAR;
        PG8_STAGE(PG8_SB(1, 0), cB + kstep, voffB); PG8_STAGE(PG8_SA(1, 0), cA + kstep, voffA); PG8_STAGE(PG8_SB(1, 1), cB + hstep + kstep, voffB);
        PG8_WAIT_V(6); PG8_BAR;
    }
    for (;;) {
        const bool has_next = S.next(ui + 1, nxt);
        const char* nA = has_next ? (const char*)g.A + (size_t)nxt.pm * tstep : cA; const char* nB = has_next ? (const char*)g.Bt + (size_t)nxt.pn * tstep : cB;
        for (int t = 0; t < nt; t += 2) {
            const bool last = (t == nt - 2);
            const char* a1 = cA + (size_t)(t + 1) * kstep;
            const char* a2 = last ? nA : cA + (size_t)(t + 2) * kstep; const char* b2 = last ? nB : cB + (size_t)(t + 2) * kstep;
            const char* a3 = a2 + kstep; const char* b3 = b2 + kstep;
            if (last && has_next) S.a_ready(nxt);
            if constexpr (SP2) {
            PG8_LDB(B0, 0, 0); PG8_LDB(B1, 0, 1); PG8_SCHED; PG8_LDA(At, 0, 0); PG8_STAGE(PG8_SA(1, 1), a1 + hstep, voffA);
            PG8_WAIT_V(8); PG8_WAIT_L(0); PG8_BAR; PG8_MMA(0, 0, At, B0); PG8_MMA(0, 1, At, B1); PG8_BAR; PG8_SCHED;
            PG8_LDA(At, 0, 1); PG8_STAGE(PG8_SB(0, 0), b2, voffB); PG8_STAGE(PG8_SB(0, 1), b2 + hstep, voffB); PG8_STAGE(PG8_SA(0, 0), a2, voffA);
            PG8_WAIT_V(8); PG8_WAIT_L(0); PG8_BAR; PG8_MMA(1, 0, At, B0); PG8_MMA(1, 1, At, B1); PG8_BAR; PG8_SCHED;
            PG8_LDB(B0, 1, 0); PG8_LDB(B1, 1, 1); PG8_SCHED; PG8_LDA(At, 1, 0); PG8_STAGE(PG8_SA(0, 1), a2 + hstep, voffA);
            PG8_WAIT_V(8); PG8_WAIT_L(0); PG8_BAR; PG8_MMA(0, 0, At, B0); PG8_MMA(0, 1, At, B1); PG8_BAR; PG8_SCHED;
            PG8_LDA(At, 1, 1); PG8_STAGE(PG8_SB(1, 0), b3, voffB); PG8_STAGE(PG8_SB(1, 1), b3 + hstep, voffB); PG8_STAGE(PG8_SA(1, 0), a3, voffA);
            PG8_WAIT_V(8); PG8_WAIT_L(0); PG8_BAR; PG8_MMA(1, 0, At, B0); PG8_MMA(1, 1, At, B1); PG8_BAR; PG8_SCHED;
            } else {
            PG8_LDB(B0, 0, 0); PG8_SCHED; PG8_LDA(At, 0, 0); PG8_STAGE(PG8_SA(1, 1), a1 + hstep, voffA);
            PG8_WAIT_L(8); PG8_BAR; PG8_WAIT_L(0); PG8_MMA(0, 0, At, B0); PG8_BAR; PG8_SCHED;
            PG8_LDB(B1, 0, 1); PG8_STAGE(PG8_SB(0, 0), b2, voffB);
            PG8_BAR; PG8_WAIT_L(0); PG8_MMA(0, 1, At, B1); PG8_BAR;
            PG8_LDA(At, 0, 1); PG8_STAGE(PG8_SA(0, 0), a2, voffA);
            PG8_BAR; PG8_WAIT_L(0); PG8_MMA(1, 0, At, B0); PG8_BAR; PG8_SCHED;
            PG8_STAGE(PG8_SB(0, 1), b2 + hstep, voffB);
            PG8_WAIT_V(6); PG8_BAR; PG8_MMA(1, 1, At, B1); PG8_BAR;
            PG8_LDB(B0, 1, 0); PG8_SCHED; PG8_LDA(At, 1, 0); PG8_STAGE(PG8_SA(0, 1), a2 + hstep, voffA);
            PG8_WAIT_L(8); PG8_BAR; PG8_WAIT_L(0); PG8_MMA(0, 0, At, B0); PG8_BAR; PG8_SCHED;
            PG8_LDB(B1, 1, 1); PG8_STAGE(PG8_SB(1, 0), b3, voffB);
            PG8_BAR; PG8_WAIT_L(0); PG8_MMA(0, 1, At, B1); PG8_BAR;
            PG8_LDA(At, 1, 1); PG8_STAGE(PG8_SA(1, 0), a3, voffA);
            PG8_BAR; PG8_WAIT_L(0); PG8_MMA(1, 0, At, B0); PG8_BAR; PG8_SCHED;
            PG8_STAGE(PG8_SB(1, 1), b3 + hstep, voffB);
            PG8_WAIT_V(6); PG8_BAR; PG8_MMA(1, 1, At, B1); PG8_BAR;
            }
        }
        if constexpr (ALIGN_EPI) { if (wr == 0) PG8_BAR; }
        if constexpr (!Epi::AFTER_DRAIN) { E(acc, cur, wr, wc, fr, fq); S.done(cur); }
        if (!has_next) break;
#pragma unroll
        for (int a = 0; a < 2; ++a)
#pragma unroll
            for (int b = 0; b < 2; ++b)
#pragma unroll
                for (int m = 0; m < 4; ++m)
#pragma unroll
                    for (int n = 0; n < 2; ++n) acc[a][b][m][n] = (f32x4){0.f, 0.f, 0.f, 0.f};
        cur = nxt; cA = nA; cB = nB; ++ui;
        if constexpr (ALIGN_EPI) { if (wr == 1) PG8_BAR; }
    }
    PG8_WAIT_V(0);
    if constexpr (!ALIGN_EPI) { if (wr == 0) PG8_BAR; }
    PG8_BAR;
    if constexpr (Epi::AFTER_DRAIN) { E.fused(acc, cur, wr, wc, fr, fq, lds, wid, lane); S.done(cur); }
#undef PG8_SA
#undef PG8_SB
#undef PG8_STAGE
#undef PG8_LDA
#undef PG8_LDB
#undef PG8_MMA
#undef PG8_WAIT_V
#undef PG8_WAIT_L
#undef PG8_BAR
#undef PG8_SCHED
}
}

#define GAS __attribute__((address_space(1)))
#define LAS __attribute__((address_space(3)))
typedef unsigned short bf16;
typedef float f32x4 __attribute__((ext_vector_type(4)));
typedef float f32x16 __attribute__((ext_vector_type(16)));
typedef unsigned u32x4 __attribute__((ext_vector_type(4)));
typedef short bf16x8 __attribute__((ext_vector_type(8)));
typedef short s16x4 __attribute__((ext_vector_type(4)));
constexpr size_t MiB = 1u << 20;
constexpr size_t WS_SS = 960 * MiB;
constexpr size_t WS_BAR = 2 * MiB;
constexpr size_t WS_BIAS = 3 * MiB;
constexpr size_t WS_W = 4 * MiB;
constexpr size_t E_W1GU = 0, E_W1D = E_W1GU + (size_t)2 * DFF * DM, E_WIN = E_W1D + (size_t)DM * DFF, E_WOA = E_WIN + (size_t)NIN * DM, E_WOC = E_WOA + (size_t)DM * DM,
                 E_WO = E_WOC + (size_t)DM * DM, E_W2GU = E_WO + (size_t)DM * DM, E_W2D = E_W2GU + (size_t)2 * DFF * DM, E_LAYER = E_W2D + (size_t)DM * DFF;
constexpr size_t WS_XB = 116 * MiB;
constexpr size_t ACT = (size_t)MT * DM * 2;
constexpr size_t WS_Q = 246 * MiB, WS_BG = WS_Q + ACT, WS_U = WS_BG + ACT, WS_SA = WS_U + ACT, WS_SC = WS_SA + ACT, WS_KV = WS_SC + ACT, WS_END = WS_KV + (size_t)MT * 256 * 2;
constexpr size_t WS_H = WS_Q;
static_assert(WS_W + 2 * E_LAYER * 2 <= WS_XB && WS_XB + ACT <= WS_Q && WS_H + (size_t)MT * DFF * 2 <= WS_SA && WS_END <= WS_SS && WS_SS + (size_t)7 * MT * 64 <= (size_t)1024 * MiB, "d_ws map");
constexpr size_t O_YP = 0, O_YS = (size_t)MP * DM, O_KP = O_YS + (size_t)MS * DM, O_VP = O_KP + 2 * 8 * 128 * 128, O_CP = O_VP + 2 * 8 * 128 * 128, O_KS = O_CP + 2 * 8 * 2 * 1024,
                 O_VS = O_KS + 2 * 16 * 128 * 128, O_CS = O_VS + 2 * 16 * 128 * 128, O_END = O_CS + 2 * 16 * 2 * 1024;

#ifndef MK_SKIP
#define MK_SKIP 0
#endif
#ifndef MK_DUP
#define MK_DUP 0
#endif
constexpr int NWAVES = 8, NTHR = 512;
constexpr int LDS_BYTES = 139264;

struct Args {
    const float* x_prompt; const float* x_sample; const float* cache_k; const float* cache_v; const float* state_conv;
    const float* norm_ffn1; const float* w1_gate; const float* w1_up; const float* w1_down;
    const float* norm_mix; const float* w_in; const float* b_in; const float* sinks; const float* conv_w; const float* w_o_attn; const float* w_o_conv; const float* w_o;
    const float* norm_ffn2; const float* w2_gate; const float* w2_up; const float* w2_down; const float* norm_final;
    float* out; unsigned char* ws;
};

__device__ __forceinline__ float wave_sum(float v) {
#pragma unroll
    for (int o = 1; o < 64; o <<= 1) v += __shfl_xor(v, o);
    return v;
}
#define LDS_WAIT() asm volatile("s_waitcnt lgkmcnt(0)" ::: "memory")

__device__ __forceinline__ void transpose_item(const float* W, int K, int N, const float* gain, bf16* WT, int dst_row0, LAS float* scr, int k0, int n0, int lane) {
#pragma unroll 8
    for (int i = 0; i < 32; ++i) { const int kk = 2 * i + (lane >> 5); float v = W[(size_t)(k0 + kk) * N + n0 + (lane & 31)]; if (gain) v *= gain[k0 + kk]; scr[kk * 33 + (lane & 31)] = v; }
    LDS_WAIT(); asm volatile("" ::: "memory");
    const int c = lane & 7;
#pragma unroll
    for (int j = 0; j < 4; ++j) { const int n = (lane >> 3) + 8 * j; const LAS float* s = scr + (8 * c) * 33 + n;
        u32x4 o; o.x = cvtpk(s[0 * 33], s[1 * 33]); o.y = cvtpk(s[2 * 33], s[3 * 33]); o.z = cvtpk(s[4 * 33], s[5 * 33]); o.w = cvtpk(s[6 * 33], s[7 * 33]);
        *(u32x4*)(WT + (size_t)(dst_row0 + n) * K + k0 + 8 * c) = o; }
    LDS_WAIT(); asm volatile("" ::: "memory");
}
__device__ __forceinline__ int win_map(int n) {
    if (n < 2304 || n >= 4352) return n;
    if (n < 3328) { const int f = n - 2304; return 2304 + 256 * (f >> 7) + (f & 127); }
    const int f = n - 3328; return 2304 + 256 * (f >> 7) + 128 + (f & 127);
}
__device__ __forceinline__ int gu_map(int f, int up) { return 256 * (f >> 7) + 128 * up + (f & 127); }

__device__ __forceinline__ void prologue(const Args& a, LAS unsigned char* lds, int tid, int lane, int wave) {
    LAS float* scr = (LAS float*)(lds + wave * 16384);
    const int gw = blockIdx.x * NWAVES + wave, NGW = gridDim.x * NWAVES;
    bf16* Wb = (bf16*)(a.ws + WS_W);
    constexpr int I_G = 16 * 88, I_D = 44 * 32, I_IN = 16 * 200, I_O = 16 * 32, I_LAYER = 6 * I_G + I_IN + 3 * I_O;
    static_assert(I_G == I_D, "item counts");
    for (int it = gw; it < 2 * I_LAYER; it += NGW) {
        const int l = it / I_LAYER; int r = it - l * I_LAYER; bf16* Wl = Wb + (size_t)l * E_LAYER;
        if (r < 2 * I_G) { const int up = r >= I_G; if (up) r -= I_G; const int kb = r / 88, nb = r % 88;
            transpose_item((up ? a.w1_up : a.w1_gate) + (size_t)l * DM * DFF, DM, DFF, a.norm_ffn1 + l * DM, Wl + E_W1GU, gu_map(nb * 32, up), scr, kb * 64, nb * 32, lane); continue; } r -= 2 * I_G;
        if (r < I_D) { const int kb = r / 32, nb = r % 32; transpose_item(a.w1_down + (size_t)l * DFF * DM, DFF, DM, nullptr, Wl + E_W1D, nb * 32, scr, kb * 64, nb * 32, lane); continue; } r -= I_D;
        if (r < I_IN) { const int kb = r / 200, nb = r % 200; transpose_item(a.w_in + (size_t)l * DM * NIN, DM, NIN, a.norm_mix + l * DM, Wl + E_WIN, win_map(nb * 32), scr, kb * 64, nb * 32, lane); continue; } r -= I_IN;
        if (r < 3 * I_O) { const int w = r / I_O; r -= w * I_O; const int kb = r / 32, nb = r % 32; const float* src = (w == 0 ? a.w_o_attn : w == 1 ? a.w_o_conv : a.w_o) + (size_t)l * DM * DM;
            transpose_item(src, DM, DM, nullptr, Wl + (w == 0 ? E_WOA : w == 1 ? E_WOC : E_WO), nb * 32, scr, kb * 64, nb * 32, lane); continue; } r -= 3 * I_O;
        if (r < 2 * I_G) { const int up = r >= I_G; if (up) r -= I_G; const int kb = r / 88, nb = r % 88;
            transpose_item((up ? a.w2_up : a.w2_gate) + (size_t)l * DM * DFF, DM, DFF, a.norm_ffn2 + l * DM, Wl + E_W2GU, gu_map(nb * 32, up), scr, kb * 64, nb * 32, lane); continue; } r -= 2 * I_G;
        { const int kb = r / 32, nb = r % 32; transpose_item(a.w2_down + (size_t)l * DFF * DM, DFF, DM, nullptr, Wl + E_W2D, nb * 32, scr, kb * 64, nb * 32, lane); }
    }
    float* ss = (float*)(a.ws + WS_SS); bf16* XB = (bf16*)(a.ws + WS_XB);
    for (int m = gw; m < MT; m += NGW) {
        const float* xr = (m < MP) ? a.x_prompt + (size_t)m * DM : a.x_sample + (size_t)(m - MP) * DM;
        f32x4 v[4]; float s = 0.f;
#pragma unroll
        for (int j = 0; j < 4; ++j) { v[j] = ((const f32x4*)xr)[lane + 64 * j]; s += (v[j].x * v[j].x + v[j].y * v[j].y) + (v[j].z * v[j].z + v[j].w * v[j].w); }
        s = wave_sum(s); if (lane < 16) ss[(size_t)m * 16 + lane] = (lane == 0) ? s : 0.f;
        unsigned long long* o8 = (unsigned long long*)(XB + (size_t)m * DM) + lane;
#pragma unroll
        for (int j = 0; j < 4; ++j) o8[64 * j] = (unsigned long long)cvtpk(v[j].x, v[j].y) | ((unsigned long long)cvtpk(v[j].z, v[j].w) << 32);
    }
    const int gt = blockIdx.x * NTHR + tid, NGT = gridDim.x * NTHR;
    { unsigned* bw = (unsigned*)(a.ws + WS_BAR); for (int i = gt; i < 3456  ; i += NGT) bw[i] = 0u; }
    float* bp = (float*)(a.ws + WS_BIAS);
    for (int i = gt; i < 2 * NIN; i += NGT) { const int l = i / NIN, n = i - l * NIN; bp[l * NIN + win_map(n)] = a.b_in[i]; }
}

constexpr int KS_STRIDE = 144, VT_STRIDE = 408;
constexpr int LDS_KS = 0, LDS_VT = 192 * KS_STRIDE, LDS_WSF = LDS_VT + 64 * VT_STRIDE, ATT_LDS = LDS_WSF + NWAVES * 32 * 4;
constexpr int N_ATT_ITEMS = 32 + NB * 128 * 2;
__device__ __forceinline__ int crow(int r, int hi) { return (r & 3) + 8 * (r >> 2) + 4 * hi; }

__device__ __forceinline__ void attn_item(LAS unsigned char* lds, const bf16* QI, bf16* AO, const bf16* KV, const float* ck, const float* cv, const float* sinks, int item, int tid, int lane, int wave) {
    int qrow0, nqb, blo, bhi, h, sb = 0; long kvrow0 = 0; bool sample;
    if (item < 32) { sample = true; sb = item >> 1; h = item & 1; qrow0 = MP + sb * 32; nqb = 1; blo = 0; bhi = 5; }
    else { sample = false; const int it = item - 32; h = it & 1; const int c = (it >> 1) & 127, b = it >> 8; qrow0 = b * SEQ + c * 64; nqb = 2; blo = c >= 2 ? 0 : 2 * (2 - c); bhi = 6; kvrow0 = (long)b * SEQ + (long)(c - 2) * 64; }
    for (int ch = tid; ch < 1536; ch += NTHR) {
        const int j = ch >> 3, dg = ch & 7, blk = j >> 5;
        if (blk >= blo && blk < bhi) {
            u32x4 kx, vx;
            if (sample && j < 128) {
                const size_t o = ((size_t)(sb * 128 + j)) * 128 + h * 64 + dg * 8;
                const f32x4 k0 = *(const f32x4*)(ck + o), k1 = *(const f32x4*)(ck + o + 4), v0 = *(const f32x4*)(cv + o), v1 = *(const f32x4*)(cv + o + 4);
                kx.x = cvtpk(k0[0], k0[1]); kx.y = cvtpk(k0[2], k0[3]); kx.z = cvtpk(k1[0], k1[1]); kx.w = cvtpk(k1[2], k1[3]);
                vx.x = cvtpk(v0[0], v0[1]); vx.y = cvtpk(v0[2], v0[3]); vx.z = cvtpk(v1[0], v1[1]); vx.w = cvtpk(v1[2], v1[3]);
            } else {
                const long row = sample ? (long)(MP + sb * 32 + (j - 128)) : kvrow0 + j;
                const bf16* p = KV + (size_t)row * 256 + h * 64 + dg * 8;
                kx = *(const u32x4*)p; vx = *(const u32x4*)(p + 128);
            }
            *(LAS u32x4*)(lds + LDS_KS + j * KS_STRIDE + dg * 16) = kx;
            LAS unsigned short* vt = (LAS unsigned short*)(lds + LDS_VT + (dg * 8) * VT_STRIDE + j * 2);
            vt[0 * (VT_STRIDE / 2)] = (unsigned short)(vx.x & 0xffffu); vt[1 * (VT_STRIDE / 2)] = (unsigned short)(vx.x >> 16);
            vt[2 * (VT_STRIDE / 2)] = (unsigned short)(vx.y & 0xffffu); vt[3 * (VT_STRIDE / 2)] = (unsigned short)(vx.y >> 16);
            vt[4 * (VT_STRIDE / 2)] = (unsigned short)(vx.z & 0xffffu); vt[5 * (VT_STRIDE / 2)] = (unsigned short)(vx.z >> 16);
            vt[6 * (VT_STRIDE / 2)] = (unsigned short)(vx.w & 0xffffu); vt[7 * (VT_STRIDE / 2)] = (unsigned short)(vx.w >> 16);
        }
    }
    __syncthreads();
    const int r32 = lane & 31, hi = lane >> 5, head = h * 8 + wave;
    const float sink2 = sinks[head] * LOG2E;
    LAS float* wsf = (LAS float*)(lds + LDS_WSF) + wave * 32;
    for (int qb = 0; qb < nqb; ++qb) {
        const bf16* qp = QI + (size_t)(qrow0 + qb * 32 + r32) * DM + head * 64 + hi * 8;
        bf16x8 qf[4];
#pragma unroll
        for (int d0 = 0; d0 < 4; ++d0) qf[d0] = *(const bf16x8*)(qp + d0 * 16);
        f32x16 s[6];
#pragma unroll
        for (int kvb = 0; kvb < 6; ++kvb) {
            if (kvb >= blo && kvb < bhi) {
                f32x16 acc;
#pragma unroll
                for (int i = 0; i < 16; ++i) acc[i] = 0.f;
#pragma unroll
                for (int d0 = 0; d0 < 4; ++d0) { const bf16x8 kf = *(const LAS bf16x8*)(lds + LDS_KS + (kvb * 32 + r32) * KS_STRIDE + d0 * 32 + hi * 16);
                    acc = __builtin_amdgcn_mfma_f32_32x32x16_bf16(kf, qf[d0], acc, 0, 0, 0); }
                s[kvb] = acc;
            } else {
#pragma unroll
                for (int i = 0; i < 16; ++i) s[kvb][i] = -1e30f;
            }
        }
        float mx = sink2;
#pragma unroll
        for (int kvb = 0; kvb < 6; ++kvb)
#pragma unroll
            for (int i = 0; i < 16; ++i) mx = fmaxf(mx, s[kvb][i]);
        mx = fmaxf(mx, __shfl_xor(mx, 32));
        float sum = 0.f;
#pragma unroll
        for (int kvb = 0; kvb < 6; ++kvb)
#pragma unroll
            for (int i = 0; i < 16; ++i) { const float e = __builtin_amdgcn_exp2f(s[kvb][i] - mx); s[kvb][i] = e; sum += e; }
        sum += __shfl_xor(sum, 32);
        const float l = sum + __builtin_amdgcn_exp2f(sink2 - mx);
        f32x16 o[2];
#pragma unroll
        for (int i = 0; i < 16; ++i) { o[0][i] = 0.f; o[1][i] = 0.f; }
#pragma unroll
        for (int kvb = 0; kvb < 6; ++kvb) {
            if (kvb >= blo && kvb < bhi) {
#pragma unroll
                for (int st = 0; st < 2; ++st) {
                    u32x4 pw; pw.x = cvtpk(s[kvb][8 * st + 0], s[kvb][8 * st + 1]); pw.y = cvtpk(s[kvb][8 * st + 2], s[kvb][8 * st + 3]);
                    pw.z = cvtpk(s[kvb][8 * st + 4], s[kvb][8 * st + 5]); pw.w = cvtpk(s[kvb][8 * st + 6], s[kvb][8 * st + 7]);
                    const bf16x8 pf = __builtin_bit_cast(bf16x8, pw);
#pragma unroll
                    for (int db = 0; db < 2; ++db) {
                        const LAS unsigned char* vp = lds + LDS_VT + (db * 32 + r32) * VT_STRIDE + (kvb * 32 + 16 * st + 4 * hi) * 2;
                        const s16x4 lo = *(const LAS s16x4*)vp, hh = *(const LAS s16x4*)(vp + 16);
                        const bf16x8 vf = __builtin_shufflevector(lo, hh, 0, 1, 2, 3, 4, 5, 6, 7);
                        o[db] = __builtin_amdgcn_mfma_f32_32x32x16_bf16(pf, vf, o[db], 0, 0, 0);
                    }
                }
            }
        }
        if (hi == 0) wsf[r32] = l;
        LDS_WAIT(); __builtin_amdgcn_wave_barrier(); asm volatile("" ::: "memory");
        bf16* op = AO + (size_t)(qrow0 + qb * 32) * DM + head * 64 + r32;
#pragma unroll
        for (int i = 0; i < 16; ++i) {
            const int q = crow(i, hi); const float rl = __builtin_amdgcn_rcpf(wsf[q]);
            const unsigned w0 = cvtpk(o[0][i] * rl, o[1][i] * rl);
            op[(size_t)q * DM] = (unsigned short)(w0 & 0xffffu); op[(size_t)q * DM + 32] = (unsigned short)(w0 >> 16);
        }
        LDS_WAIT(); __builtin_amdgcn_wave_barrier(); asm volatile("" ::: "memory");
    }
    __syncthreads();
}

__device__ __forceinline__ void conv_chunk(bf16* BG, const bf16* U, const float* cw, const float* st  , int chunk, int tid) {
    const int cgp = tid & 127, rsub = tid >> 7, c0 = cgp * 8;
    const int t0 = chunk * 16 + rsub * 4;
    float w[3][8];
#pragma unroll
    for (int j = 0; j < 3; ++j) { const f32x4 a = *(const f32x4*)(cw + j * DM + c0), b = *(const f32x4*)(cw + j * DM + c0 + 4);
#pragma unroll
        for (int e = 0; e < 4; ++e) { w[j][e] = a[e]; w[j][4 + e] = b[e]; } }
    float p2[8], p1[8];
    const int pos = (t0 < MP) ? (t0 & (SEQ - 1)) : ((t0 - MP) & (SSEQ - 1));
    if (pos == 0) {
        if (t0 < MP) {
#pragma unroll
            for (int e = 0; e < 8; ++e) { p2[e] = 0.f; p1[e] = 0.f; }
        } else {
            const float* s0 = st + (size_t)((t0 - MP) / SSEQ) * 2 * DM + c0;
            const f32x4 a = *(const f32x4*)s0, b = *(const f32x4*)(s0 + 4), c = *(const f32x4*)(s0 + DM), d = *(const f32x4*)(s0 + DM + 4);
#pragma unroll
            for (int e = 0; e < 4; ++e) { p2[e] = a[e]; p2[4 + e] = b[e]; p1[e] = c[e]; p1[4 + e] = d[e]; }
        }
    } else {
        const u32x4 a = *(const u32x4*)(U + (size_t)(t0 - 2) * DM + c0), b = *(const u32x4*)(U + (size_t)(t0 - 1) * DM + c0);
        p2[0] = bflo(a.x); p2[1] = bfhi(a.x); p2[2] = bflo(a.y); p2[3] = bfhi(a.y); p2[4] = bflo(a.z); p2[5] = bfhi(a.z); p2[6] = bflo(a.w); p2[7] = bfhi(a.w);
        p1[0] = bflo(b.x); p1[1] = bfhi(b.x); p1[2] = bflo(b.y); p1[3] = bfhi(b.y); p1[4] = bflo(b.z); p1[5] = bfhi(b.z); p1[6] = bflo(b.w); p1[7] = bfhi(b.w);
    }
#pragma unroll
    for (int r = 0; r < 4; ++r) {
        const size_t idx = (size_t)(t0 + r) * DM + c0;
        const u32x4 uu = *(const u32x4*)(U + idx), gg = *(const u32x4*)(BG + idx);
        float cu[8], g[8], o[8];
        cu[0] = bflo(uu.x); cu[1] = bfhi(uu.x); cu[2] = bflo(uu.y); cu[3] = bfhi(uu.y); cu[4] = bflo(uu.z); cu[5] = bfhi(uu.z); cu[6] = bflo(uu.w); cu[7] = bfhi(uu.w);
        g[0] = bflo(gg.x); g[1] = bfhi(gg.x); g[2] = bflo(gg.y); g[3] = bfhi(gg.y); g[4] = bflo(gg.z); g[5] = bfhi(gg.z); g[6] = bflo(gg.w); g[7] = bfhi(gg.w);
#pragma unroll
        for (int e = 0; e < 8; ++e) { o[e] = g[e] * (w[0][e] * p2[e] + w[1][e] * p1[e] + w[2][e] * cu[e]); p2[e] = p1[e]; p1[e] = cu[e]; }
        u32x4 ww; ww.x = cvtpk(o[0], o[1]); ww.y = cvtpk(o[2], o[3]); ww.z = cvtpk(o[4], o[5]); ww.w = cvtpk(o[6], o[7]);
        *(u32x4*)(BG + idx) = ww;
    }
}

__device__ __forceinline__ f32x4 bf4(const bf16* p) { const uint2 w = *(const uint2*)p; return (f32x4){bflo(w.x), bfhi(w.x), bflo(w.y), bfhi(w.y)}; }
__device__ __forceinline__ void state_copies(const Args& a, int l, const bf16* KV, const bf16* U, int gt, int NGT) {
    constexpr int N_KP = 8 * 128 * 128 / 4, N_CP = 8 * 2 * 1024 / 4, N_KS = 16 * 128 * 128 / 4, N_CS = 16 * 2 * 1024 / 4;
    constexpr int TOT = 2 * N_KP + N_CP + 2 * N_KS + N_CS;
    float* out = a.out;
    for (int i = gt; i < TOT; i += NGT) {
        int r = i;
        if (r < 2 * N_KP) { const int v = r >= N_KP; if (v) r -= N_KP; const int e = r * 4, hd = e & 127, j = (e >> 7) & 127, b = e >> 14;
            *(f32x4*)(out + (v ? O_VP : O_KP) + (size_t)l * 8 * 128 * 128 + e) = bf4(KV + (size_t)(b * SEQ + SEQ - 128 + j) * 256 + v * 128 + hd); continue; } r -= 2 * N_KP;
        if (r < N_CP) { const int e = r * 4, c = e & 1023, ii = (e >> 10) & 1, b = e >> 11;
            *(f32x4*)(out + O_CP + (size_t)l * 8 * 2 * 1024 + e) = bf4(U + (size_t)(b * SEQ + SEQ - 2 + ii) * DM + c); continue; } r -= N_CP;
        if (r < 2 * N_KS) { const int v = r >= N_KS; if (v) r -= N_KS; const int e = r * 4, hd = e & 127, j = (e >> 7) & 127, b = e >> 14;
            f32x4 val;
            if (j < 96) val = *(const f32x4*)((v ? a.cache_v : a.cache_k) + ((size_t)(l * 16 + b) * 128 + 32 + j) * 128 + hd);
            else val = bf4(KV + (size_t)(MP + b * SSEQ + j - 96) * 256 + v * 128 + hd);
            *(f32x4*)(out + (v ? O_VS : O_KS) + (size_t)l * 16 * 128 * 128 + e) = val; continue; } r -= 2 * N_KS;
        { const int e = r * 4, c = e & 1023, ii = (e >> 10) & 1, b = e >> 11;
            *(f32x4*)(out + O_CS + (size_t)l * 16 * 2 * 1024 + e) = bf4(U + (size_t)(MP + b * SSEQ + SSEQ - 2 + ii) * DM + c); }
    }
}

__device__ __forceinline__ int opaque_tid() { int t = threadIdx.x; asm volatile("" : "+v"(t)); return t; }

typedef float f32x4s __attribute__((ext_vector_type(4)));
__device__ __forceinline__ uint2 pack4(const f32x4s& v) { uint2 w; w.x = cvtpk(v[0], v[1]); w.y = cvtpk(v[2], v[3]); return w; }
__device__ __forceinline__ f32x4s unpack4(const uint2 w) { return (f32x4s){bflo(w.x), bfhi(w.x), bflo(w.y), bfhi(w.y)}; }

struct SEpiSwiGLU {
    bf16* H; const float* ss;
    __device__ __forceinline__ void brows(int sl, int& b0, int& b1) const { b0 = gu_map(32 * sl, 0); b1 = b0 + 128; }
    __device__ __forceinline__ void operator()(const f32x4s& c0, const f32x4s& c1, int row, int sl, int cw, int rit, int wc2, int fq, LAS float* xch) const {
        const float rs = pg8::row_rs(ss, row); f32x4s h;
#pragma unroll
        for (int e = 0; e < 4; ++e) { const float g = c0[e] * rs, u = c1[e] * rs; h[e] = g * fast_sigmoid(g) * u; }
        *(uint2*)(H + (size_t)row * DFF + 32 * sl + cw) = pack4(h);
    }
};
struct SEpiResid {
    bf16* xb; float* ssn; float scale;
    __device__ __forceinline__ void brows(int sl, int& b0, int& b1) const { b0 = 64 * sl; b1 = b0 + 32; }
    __device__ __forceinline__ void operator()(const f32x4s& c0, const f32x4s& c1, int row, int sl, int cw, int rit, int wc2, int fq, LAS float* xch) const {
        bf16* p = xb + (size_t)row * DM + 64 * sl + cw;
        const f32x4s o0 = unpack4(*(const uint2*)p) + c0 * scale, o1 = unpack4(*(const uint2*)(p + 32)) + c1 * scale;
        *(uint2*)p = pack4(o0); *(uint2*)(p + 32) = pack4(o1);
        float sq = (o0[0] * o0[0] + o0[1] * o0[1]) + (o0[2] * o0[2] + o0[3] * o0[3]) + (o1[0] * o1[0] + o1[1] * o1[1]) + (o1[2] * o1[2] + o1[3] * o1[3]);
        sq += __shfl_xor(sq, 16); sq += __shfl_xor(sq, 32);
        if (fq == 0) xch[wc2 * 64 + rit] = sq;
        __syncthreads();
        if (fq == 0 && wc2 == 0) ssn[(size_t)row * 16 + sl] = xch[rit] + xch[64 + rit];
    }
};
struct SEpiMixIn {
    const float* ss; const float* bias; bf16 *Q, *KV, *BG, *U, *SA, *SC;
    __device__ __forceinline__ void brows(int sl, int& b0, int& b1) const {
        if (sl < 36) { b0 = 64 * sl; b1 = b0 + 32; }
        else if (sl < 68) { const int f0 = 32 * (sl - 36); b0 = 2304 + 256 * (f0 >> 7) + (f0 & 127); b1 = b0 + 128; }
        else { b0 = 4352 + 64 * (sl - 68); b1 = b0 + 32; }
    }
    __device__ __forceinline__ void operator()(const f32x4s& c0, const f32x4s& c1, int row, int sl, int cw, int rit, int wc2, int fq, LAS float* xch) const {
        int b0, b1; brows(sl, b0, b1);
        bf16* dst; int ld, cb, mode; float sc = 1.f;
        if (sl < 16) { dst = Q; ld = DM; cb = 64 * sl; mode = 0; sc = QSCALE; }
        else if (sl < 20) { dst = KV; ld = 256; cb = 64 * (sl - 16); mode = 0; }
        else if (sl < 36) { dst = BG; ld = DM; cb = 64 * (sl - 20); mode = 0; }
        else if (sl < 68) { dst = U; ld = DM; cb = 32 * (sl - 36); mode = 2; }
        else if (sl < 84) { dst = SA; ld = DM; cb = 64 * (sl - 68); mode = 1; }
        else { dst = SC; ld = DM; cb = 64 * (sl - 84); mode = 1; }
        const float rs = pg8::row_rs(ss, row);
        f32x4s z0 = c0 * rs + *(const f32x4s*)(bias + b0 + cw), z1 = c1 * rs + *(const f32x4s*)(bias + b1 + cw);
        bf16* p = dst + (size_t)row * ld + cb + cw;
        if (mode == 2) { *(uint2*)p = pack4(z0 * z1); }
        else {
            if (mode == 1) {
#pragma unroll
                for (int e = 0; e < 4; ++e) { z0[e] = fast_sigmoid(z0[e]); z1[e] = fast_sigmoid(z1[e]); }
            } else { z0 = z0 * sc; z1 = z1 * sc; }
            *(uint2*)p = pack4(z0); *(uint2*)(p + 32) = pack4(z1);
        }
    }
};
struct SEpiGate {
    bf16* Gt; const bf16* ADD;
    __device__ __forceinline__ void brows(int sl, int& b0, int& b1) const { b0 = 64 * sl; b1 = b0 + 32; }
    __device__ __forceinline__ void operator()(const f32x4s& c0, const f32x4s& c1, int row, int sl, int cw, int rit, int wc2, int fq, LAS float* xch) const {
        const size_t idx = (size_t)row * DM + 64 * sl + cw;
        f32x4s a0 = (f32x4s){0.f, 0.f, 0.f, 0.f}, a1 = a0;
        if (ADD) { a0 = unpack4(*(const uint2*)(ADD + idx)); a1 = unpack4(*(const uint2*)(ADD + idx + 32)); }
        const f32x4s g0 = unpack4(*(const uint2*)(Gt + idx)), g1 = unpack4(*(const uint2*)(Gt + idx + 32));
        *(uint2*)(Gt + idx) = pack4(a0 + g0 * c0); *(uint2*)(Gt + idx + 32) = pack4(a1 + g1 * c1);
    }
};

template <class Epi>
__device__ __forceinline__ void sample_gemm(LAS unsigned char* lds, const bf16* A, const bf16* Bt, int K, int nslices, const Epi& E, int bx, int G) {
    const int tid = opaque_tid(), lane = tid & 63, wave = __builtin_amdgcn_readfirstlane(tid >> 6), fr = lane & 15, fq = lane >> 4, wr4 = wave >> 1, wc2 = wave & 1;
    constexpr int RS = 272;
    LAS unsigned char* As = lds; LAS unsigned char* Bs = lds + 64 * RS; LAS float* xch = (LAS float*)(lds + 2 * 64 * RS);
    const int srow = tid >> 3, sch = tid & 7, nst = K >> 7, ntasks = nslices * 8;
    const int pbx = (G % 8 == 0) ? (bx & 7) * (G >> 3) + (bx >> 3) : bx;
    for (int t = pbx; t < ntasks; t += G) {
        const int sl = t >> 3, tm = t & 7;
        int br0, br1; E.brows(sl, br0, br1);
        const bf16* ag = A + (size_t)(MP + tm * 64 + srow) * K + sch * 8;
        const bf16* bg = Bt + (size_t)((srow < 32) ? br0 + srow : br1 + (srow - 32)) * K + sch * 8;
        u32x4 ra0 = *(const u32x4*)ag, ra1 = *(const u32x4*)(ag + 64), rb0 = *(const u32x4*)bg, rb1 = *(const u32x4*)(bg + 64);
        f32x4s c0 = (f32x4s){0.f, 0.f, 0.f, 0.f}, c1 = c0;
        for (int s = 0; s < nst; ++s) {
            __syncthreads();
            *(LAS u32x4*)(As + srow * RS + sch * 16) = ra0; *(LAS u32x4*)(As + srow * RS + (sch + 8) * 16) = ra1;
            *(LAS u32x4*)(Bs + srow * RS + sch * 16) = rb0; *(LAS u32x4*)(Bs + srow * RS + (sch + 8) * 16) = rb1;
            __syncthreads();
            if (s + 1 < nst) { const int o = (s + 1) * 128; ra0 = *(const u32x4*)(ag + o); ra1 = *(const u32x4*)(ag + o + 64); rb0 = *(const u32x4*)(bg + o); rb1 = *(const u32x4*)(bg + o + 64); }
#pragma unroll
            for (int ks = 0; ks < 4; ++ks) {
                const bf16x8 af = *(const LAS bf16x8*)(As + (wr4 * 16 + fr) * RS + ks * 64 + fq * 16);
                const bf16x8 bf0 = *(const LAS bf16x8*)(Bs + (wc2 * 16 + fr) * RS + ks * 64 + fq * 16), bf1 = *(const LAS bf16x8*)(Bs + (32 + wc2 * 16 + fr) * RS + ks * 64 + fq * 16);
                c0 = __builtin_amdgcn_mfma_f32_16x16x32_bf16(bf0, af, c0, 0, 0, 0); c1 = __builtin_amdgcn_mfma_f32_16x16x32_bf16(bf1, af, c1, 0, 0, 0);
            }
        }
        E(c0, c1, MP + tm * 64 + wr4 * 16 + fr, sl, wc2 * 16 + 4 * fq, wr4 * 16 + fr, wc2, fq, xch);
    }
    __syncthreads();
}

#define RLX_AGENT __ATOMIC_RELAXED, __HIP_MEMORY_SCOPE_AGENT
#define XB_TMO      128
#define XB_XCNT(j)  (256  + 64 * (j))
#define XB_XSUB(j)  (1280 + 64 * (j))
#define XB_XGEN(j)  (2304 + 64 * (j))
#define XB_TOP      3328
#define XB_TOPGEN   3392
#define XCD_BAR_WORDS 3456
#define XB_SPIN_CAP (1u << 18)

__device__ __forceinline__ unsigned xb_ld(unsigned* p)              { return __hip_atomic_load(p, __ATOMIC_RELAXED, __HIP_MEMORY_SCOPE_AGENT); }
__device__ __forceinline__ unsigned xb_add(unsigned* p, unsigned v) { return __hip_atomic_fetch_add(p, v, __ATOMIC_RELAXED, __HIP_MEMORY_SCOPE_AGENT); }
__device__ __forceinline__ unsigned xb_xcc_id() { return (unsigned)__builtin_amdgcn_s_getreg((3 << 11) | 20) & 0xFu; }
#define XB_SPIN(cond, bar) do { unsigned _sp = 0; while (cond) { __builtin_amdgcn_s_sleep(1); \
    if ((++_sp & 255u) == 0u) { if (xb_ld(&(bar)[XB_TMO])) break; if (_sp > XB_SPIN_CAP) { atomicAdd(&(bar)[XB_TMO], 1u); break; } } } } while (0)

struct XcdBarrier {
    unsigned* bar; unsigned x;
    volatile LAS unsigned* st;
};

__device__ __forceinline__ XcdBarrier xcd_barrier_post(unsigned* bar, volatile LAS unsigned* st) {
    XcdBarrier b; b.bar = bar; b.x = xb_xcc_id(); b.st = st;
    if (threadIdx.x == 0) (void)xb_add(&bar[XB_XCNT(b.x)], 1u);
    return b;
}
__device__ __forceinline__ void xcd_barrier_complete(unsigned* bar, unsigned x, unsigned& nloc, unsigned& nx) {
    const unsigned G = gridDim.x * gridDim.y * gridDim.z;
    unsigned sum, cnt, mine, sp = 0u;
    for (;;) {
        sum = 0u; cnt = 0u; mine = 0u;
#pragma unroll
        for (unsigned j = 0; j < 16; ++j) { const unsigned c = xb_ld(&bar[XB_XCNT(j)]); sum += c; cnt += (c > 0u) ? 1u : 0u; mine = (j == x) ? c : mine; }
        if (sum == G) break;
        __builtin_amdgcn_s_sleep(1);
        if ((++sp & 255u) == 0u) { if (xb_ld(&bar[XB_TMO])) break; if (sp > XB_SPIN_CAP) { atomicAdd(&bar[XB_TMO], 1u); break; } }
    }
    nloc = mine > 0u ? mine : 1u; nx = cnt > 0u ? cnt : 1u;
}

__device__ __forceinline__ void xcd_barrier(const XcdBarrier& b) {
    asm volatile("s_waitcnt vmcnt(0)" ::: "memory");
    __syncthreads();
    if (threadIdx.x == 0) {
        unsigned* bar = b.bar;
        __builtin_amdgcn_s_waitcnt(0);
        unsigned nloc = b.st[0], nx = b.st[1];
        if (nloc == 0u) { xcd_barrier_complete(bar, b.x, nloc, nx); b.st[0] = nloc; b.st[1] = nx; }
        const unsigned old = xb_add(&bar[XB_XSUB(b.x)], 1u);
        const unsigned gen = old / nloc;
        if (old + 1u == (gen + 1u) * nloc) {
            __builtin_amdgcn_fence(__ATOMIC_RELEASE, "agent");
            asm volatile("s_waitcnt vmcnt(0)" ::: "memory");
            const unsigned og = xb_add(&bar[XB_TOP], 1u);
            const unsigned tg = og / nx;
            if (og + 1u == (tg + 1u) * nx) xb_add(&bar[XB_TOPGEN], 1u);
            else XB_SPIN(xb_ld(&bar[XB_TOPGEN]) == tg, bar);
            __builtin_amdgcn_fence(__ATOMIC_ACQUIRE, "agent");
            xb_add(&bar[XB_XGEN(b.x)], 1u);
            asm volatile("s_waitcnt vmcnt(0)" ::: "memory");
        } else {
            XB_SPIN(xb_ld(&bar[XB_XGEN(b.x)]) == gen, bar);
            __builtin_amdgcn_fence(__ATOMIC_ACQUIRE, "agent");
            asm volatile("s_waitcnt vmcnt(0)" ::: "memory");
        }
    }
    __syncthreads();
}

__global__ void __launch_bounds__(NTHR, 2) fwd_megakernel(Args a) {
    extern __shared__ __attribute__((aligned(16))) unsigned char lds_raw[];
    LAS unsigned char* lds = (LAS unsigned char*)lds_raw;
    cg::grid_group grid = cg::this_grid();
    volatile LAS unsigned* bar_st = (volatile LAS unsigned*)(lds + 131072 + 64);
    if (threadIdx.x < 2) bar_st[threadIdx.x] = 0u;
    __syncthreads();
    const int G = gridDim.x, bx = blockIdx.x;
    unsigned char* ws = a.ws;
    float* ss = (float*)(ws + WS_SS);
    bf16* XB = (bf16*)(ws + WS_XB); bf16* H = (bf16*)(ws + WS_H);
    bf16 *Q = (bf16*)(ws + WS_Q), *BG = (bf16*)(ws + WS_BG), *U = (bf16*)(ws + WS_U), *SA = (bf16*)(ws + WS_SA), *SC = (bf16*)(ws + WS_SC), *KV = (bf16*)(ws + WS_KV);
    float* xout = a.out;

#if !(MK_SKIP & 1)
    { const int tid = opaque_tid(), lane = tid & 63, wave = __builtin_amdgcn_readfirstlane(tid >> 6); prologue(a, lds, tid, lane, wave);
      if (MK_DUP & 1) { __syncthreads(); prologue(a, lds, tid, lane, wave); } }
#endif
    grid.sync();
    const XcdBarrier bar = xcd_barrier_post((unsigned*)(a.ws + WS_BAR), bar_st);

#pragma nounroll
    for (int l = 0; l < 2; ++l) {
        const bf16* Wl = (const bf16*)(ws + WS_W) + (size_t)l * E_LAYER;
#if !(MK_SKIP & 2)
        { SEpiSwiGLU SE{H, ss + (size_t)(3 * l) * MT * 16}; sample_gemm(lds, XB, Wl + E_W1GU, DM, DFF / 32, SE, bx, G);
          pg8::Gemm g{XB, Wl + E_W1GU, MP, 2 * DFF, DM}; pg8::StaticOrder S; S.init(MP, 2 * DFF, G, bx); pg8::EpiSwiGLU E{H, ss + (size_t)(3 * l) * MT * 16, (LAS float*)(lds + 131072 + 1024)};
          pg8::gemm_phase<pg8::EpiSwiGLU, pg8::StaticOrder, true, true>(lds, g, S, E);
          if (MK_DUP & 2) pg8::gemm_phase<pg8::EpiSwiGLU, pg8::StaticOrder, true, true>(lds, g, S, E); }
#endif
        xcd_barrier(bar);
        if (MK_DUP & 8) xcd_barrier(bar);
#if !(MK_SKIP & 4)
        { SEpiResid SE{XB, ss + (size_t)(3 * l + 1) * MT * 16, 0.5f}; sample_gemm(lds, H, Wl + E_W1D, DFF, DM / 64, SE, bx, G);
          pg8::Gemm g{H, Wl + E_W1D, MP, DM, DFF}; pg8::StaticOrder S; S.init(MP, DM, G, bx);
          pg8::EpiResid E{XB, ss + (size_t)(3 * l + 1) * MT * 16, 0.5f};
          pg8::gemm_phase<pg8::EpiResid, pg8::StaticOrder, true, true>(lds, g, S, E); }
#endif
        xcd_barrier(bar);
        if (MK_DUP & 8) xcd_barrier(bar);
#if !(MK_SKIP & 8)
        { SEpiMixIn SE{ss + (size_t)(3 * l + 1) * MT * 16, (const float*)(ws + WS_BIAS) + l * NIN, Q, KV, BG, U, SA, SC}; sample_gemm(lds, XB, Wl + E_WIN, DM, 100, SE, bx, G);
          pg8::Gemm g{XB, Wl + E_WIN, MP, NIN, DM}; pg8::StaticOrder S; S.init(MP, NIN, G, bx);
          pg8::EpiMixIn E{ss + (size_t)(3 * l + 1) * MT * 16, (const float*)(ws + WS_BIAS) + l * NIN, Q, KV, BG, U, SA, SC, (LAS float*)(lds + 131072 + 1024)};
          pg8::gemm_phase<pg8::EpiMixIn, pg8::StaticOrder, true, true>(lds, g, S, E);
          if (MK_DUP & 16) pg8::gemm_phase<pg8::EpiMixIn, pg8::StaticOrder, true, true>(lds, g, S, E); }
#endif
        xcd_barrier(bar);
        if (MK_DUP & 8) xcd_barrier(bar);
#if !(MK_SKIP & 16)
        { const int tid = opaque_tid(), lane = tid & 63, wave = __builtin_amdgcn_readfirstlane(tid >> 6);
          const float* ck = a.cache_k + (size_t)l * 16 * 128 * 128; const float* cv = a.cache_v + (size_t)l * 16 * 128 * 128;
          const bool conv_first = ((bx >> 3) & 1) != 0;
          if (conv_first) for (int ch = bx; ch < MT / 16; ch += G) conv_chunk(BG, U, a.conv_w + (size_t)l * 3 * DM, a.state_conv + (size_t)l * 16 * 2 * DM, ch, tid);
          for (int it = bx; it < N_ATT_ITEMS; it += G) attn_item(lds, Q, Q, KV, ck, cv, a.sinks + l * 16, it, tid, lane, wave);
          if (!conv_first) for (int ch = bx; ch < MT / 16; ch += G) conv_chunk(BG, U, a.conv_w + (size_t)l * 3 * DM, a.state_conv + (size_t)l * 16 * 2 * DM, ch, tid);
          state_copies(a, l, KV, U, bx * NTHR + tid, G * NTHR); }
#endif
        xcd_barrier(bar);
        if (MK_DUP & 8) xcd_barrier(bar);
#if !(MK_SKIP & 32)
        { SEpiGate SE{SA, nullptr}; sample_gemm(lds, Q, Wl + E_WOA, DM, DM / 64, SE, bx, G);
          pg8::Gemm g{Q, Wl + E_WOA, MP, DM, DM}; pg8::StaticOrder S; S.init(MP, DM, G, bx); pg8::EpiGate E{SA, nullptr};
          pg8::gemm_phase<pg8::EpiGate, pg8::StaticOrder, true, true>(lds, g, S, E); }
        { SEpiGate SE{SC, SA}; sample_gemm(lds, BG, Wl + E_WOC, DM, DM / 64, SE, bx, G);
          pg8::Gemm g{BG, Wl + E_WOC, MP, DM, DM}; pg8::StaticOrder S; S.init(MP, DM, G, bx); pg8::EpiGate E{SC, SA};
          pg8::gemm_phase<pg8::EpiGate, pg8::StaticOrder, true, true>(lds, g, S, E); }
#endif
        xcd_barrier(bar);
        if (MK_DUP & 8) xcd_barrier(bar);
#if !(MK_SKIP & 64)
        { SEpiResid SE{XB, ss + (size_t)(3 * l + 2) * MT * 16, 1.0f}; sample_gemm(lds, SC, Wl + E_WO, DM, DM / 64, SE, bx, G);
          pg8::Gemm g{SC, Wl + E_WO, MP, DM, DM}; pg8::StaticOrder S; S.init(MP, DM, G, bx);
          pg8::EpiResid E{XB, ss + (size_t)(3 * l + 2) * MT * 16, 1.0f};
          pg8::gemm_phase<pg8::EpiResid, pg8::StaticOrder, true, true>(lds, g, S, E); }
#endif
        xcd_barrier(bar);
        if (MK_DUP & 8) xcd_barrier(bar);
#if !(MK_SKIP & 128)
        { SEpiSwiGLU SE{H, ss + (size_t)(3 * l + 2) * MT * 16}; sample_gemm(lds, XB, Wl + E_W2GU, DM, DFF / 32, SE, bx, G);
          pg8::Gemm g{XB, Wl + E_W2GU, MP, 2 * DFF, DM}; pg8::StaticOrder S; S.init(MP, 2 * DFF, G, bx); pg8::EpiSwiGLU E{H, ss + (size_t)(3 * l + 2) * MT * 16, (LAS float*)(lds + 131072 + 1024)};
          pg8::gemm_phase<pg8::EpiSwiGLU, pg8::StaticOrder, true, true>(lds, g, S, E); }
#endif
        xcd_barrier(bar);
        if (MK_DUP & 8) xcd_barrier(bar);
#if !(MK_SKIP & 256)
        { SEpiResid SE{XB, ss + (size_t)(3 * l + 3) * MT * 16, 0.5f}; sample_gemm(lds, H, Wl + E_W2D, DFF, DM / 64, SE, bx, G);
          pg8::Gemm g{H, Wl + E_W2D, MP, DM, DFF}; pg8::StaticOrder S; S.init(MP, DM, G, bx);
          pg8::EpiResid E{XB, ss + (size_t)(3 * l + 3) * MT * 16, 0.5f};
          pg8::gemm_phase<pg8::EpiResid, pg8::StaticOrder, true, true>(lds, g, S, E); }
#endif
        xcd_barrier(bar);
        if (MK_DUP & 8) xcd_barrier(bar);
    }
    { const int tid = opaque_tid(), lane = tid & 63, wave = __builtin_amdgcn_readfirstlane(tid >> 6);
      const int gw = bx * NWAVES + wave, NGW = G * NWAVES; const float* ssf = ss + (size_t)6 * MT * 16;
      f32x4 gv[4];
#pragma unroll
      for (int j = 0; j < 4; ++j) gv[j] = ((const f32x4*)a.norm_final)[lane + 64 * j];
      for (int m = gw; m < MT; m += NGW) { const float rs = pg8::row_rs(ssf, m); f32x4* yr = (f32x4*)(xout + (size_t)m * DM); const uint2* xr = (const uint2*)(XB + (size_t)m * DM);
#pragma unroll
          for (int j = 0; j < 4; ++j) { const uint2 w = xr[lane + 64 * j]; const f32x4 v = (f32x4){bflo(w.x), bfhi(w.x), bflo(w.y), bfhi(w.y)}; yr[lane + 64 * j] = v * rs * gv[j]; } } }
}

extern "C" void kernel_launch(void* const* d_in, const int* in_sizes, int n_in, void* d_out, int out_size, void* d_ws, size_t ws_size, hipStream_t stream) {
    static int grid = 0;
    if (grid == 0) {
        if (n_in != 22 || in_sizes[0] != MP * DM || (size_t)out_size != O_END || ws_size < WS_SS + (size_t)7 * MT * 64) { fprintf(stderr, "kernel_launch: unexpected shapes (n_in %d, in0 %d, out %d, ws %zu)\n", n_in, n_in > 0 ? in_sizes[0] : -1, out_size, ws_size); grid = -1; return; }
        int dev = 0, cus = 0, per_cu = 0;
        hipGetDevice(&dev); hipDeviceGetAttribute(&cus, hipDeviceAttributeMultiprocessorCount, dev);
        if (hipFuncSetAttribute((const void*)fwd_megakernel, hipFuncAttributeMaxDynamicSharedMemorySize, LDS_BYTES) != hipSuccess) { fprintf(stderr, "kernel_launch: hipFuncSetAttribute failed\n"); grid = -1; return; }
        if (hipOccupancyMaxActiveBlocksPerMultiprocessor(&per_cu, (const void*)fwd_megakernel, NTHR, LDS_BYTES) != hipSuccess || per_cu < 1) { fprintf(stderr, "kernel_launch: occupancy query says %d\n", per_cu); per_cu = 1; }
        (void)hipGetLastError();
        grid = cus;
    }
    if (grid < 0) return;
    Args a{};
    a.x_prompt = (const float*)d_in[0]; a.x_sample = (const float*)d_in[1]; a.cache_k = (const float*)d_in[2]; a.cache_v = (const float*)d_in[3]; a.state_conv = (const float*)d_in[4];
    a.norm_ffn1 = (const float*)d_in[5]; a.w1_gate = (const float*)d_in[6]; a.w1_up = (const float*)d_in[7]; a.w1_down = (const float*)d_in[8];
    a.norm_mix = (const float*)d_in[9]; a.w_in = (const float*)d_in[10]; a.b_in = (const float*)d_in[11]; a.sinks = (const float*)d_in[12]; a.conv_w = (const float*)d_in[13];
    a.w_o_attn = (const float*)d_in[14]; a.w_o_conv = (const float*)d_in[15]; a.w_o = (const float*)d_in[16];
    a.norm_ffn2 = (const float*)d_in[17]; a.w2_gate = (const float*)d_in[18]; a.w2_up = (const float*)d_in[19]; a.w2_down = (const float*)d_in[20]; a.norm_final = (const float*)d_in[21];
    a.out = (float*)d_out; a.ws = (unsigned char*)d_ws;
    void* args[] = {&a};
    hipError_t e = hipLaunchCooperativeKernel((const void*)fwd_megakernel, dim3(grid), dim3(NTHR), args, LDS_BYTES, stream);
    if (e != hipSuccess) fprintf(stderr, "kernel_launch: cooperative launch failed: %s (grid %d)\n", hipGetErrorString(e), grid);
}
```

```cpp
#include <hip/hip_runtime.h>
#include <hip/hip_cooperative_groups.h>
#include <cstdio>
#include <cstdint>
namespace cg = cooperative_groups;

constexpr int DM = 1024, DFF = 2816, NIN = 6400;
constexpr int NB = 8, SEQ = 8192, SBAT = 16, SSEQ = 32;
constexpr int MP = NB * SEQ, MS = SBAT * SSEQ, MT = MP + MS;
constexpr float EPS = 1e-6f, LOG2E = 1.4426950408889634f;
constexpr float QSCALE = 0.125f * LOG2E;

typedef float f32x2_t __attribute__((ext_vector_type(2)));
typedef __bf16 bf16x2_t __attribute__((ext_vector_type(2)));
__device__ __forceinline__ unsigned cvtpk(float lo, float hi) { f32x2_t v = {lo, hi}; bf16x2_t b = __builtin_convertvector(v, bf16x2_t); return __builtin_bit_cast(unsigned, b); }
__device__ __forceinline__ float bflo(unsigned w) { return __uint_as_float(w << 16); }
__device__ __forceinline__ float bfhi(unsigned w) { return __uint_as_float(w & 0xffff0000u); }
__device__ __forceinline__ float fast_sigmoid(float z) { return __builtin_amdgcn_rcpf(1.0f + __builtin_amdgcn_exp2f(-z * LOG2E)); }

namespace pg8 {
#define PG8_LAS __attribute__((address_space(3)))
typedef unsigned short bf16_t;
typedef short bf16x8 __attribute__((ext_vector_type(8)));
typedef float f32x4 __attribute__((ext_vector_type(4)));
typedef unsigned u32x4 __attribute__((ext_vector_type(4)));
constexpr int BM = 256, BK = 64, HALF = 128, HTB = HALF * BK * 2  , STAGE_BYTES = 8 * HTB, NXCD = 8, WGM = 8;

__host__ __device__ __forceinline__ int lds_byte(int r, int c) { const int st = (r >> 4) * 2 + (c >> 5), rr = r & 15, cc = c & 31, ob = rr * 64 + cc * 2; return st * 1024 + (ob ^ (((ob >> 9) & 1) << 5)); }
__host__ __device__ __forceinline__ void stage_rc(int b, int& R, int& C) { const int st = b / 1024, sb = b % 1024, swz = sb ^ (((sb >> 9) & 1) << 5); R = (st >> 1) * 16 + swz / 64; C = (st & 1) * 32 + (swz % 64) / 2; }
__host__ __device__ __forceinline__ int perm32(int rho) { const int n = rho >> 4, i = rho & 15; return 8 * (i >> 2) + 4 * n + (i & 3); }

struct Unit { int pm, pn; };
struct Gemm { const bf16_t* A; const bf16_t* Bt; int M, N, K; };

struct StaticOrder {
    int nM, nN, nwg, G, c, rev;
    __host__ __device__ void init(int M, int N, int G_, int c_, int rev_ = 0) { nM = M / BM; nN = N / BM; nwg = nM * nN; G = G_; c = c_; rev = rev_; }
    __host__ __device__ bool next(int i, Unit& u) const {
        const long L = (long)i * G + c; if (L >= nwg) return false;
        int wgid = (int)L; { const int q = nwg / NXCD, r = nwg % NXCD, xcd = wgid % NXCD, off = wgid / NXCD; wgid = (xcd < r ? xcd * (q + 1) : r * (q + 1) + (xcd - r) * q) + off; }
        const int nig = WGM * nN, gid = wgid / nig, fm = gid * WGM, gsz = (nM - fm) < WGM ? (nM - fm) : WGM;
        u.pm = fm + ((wgid % nig) % gsz); u.pn = (wgid % nig) / gsz; if (rev) u.pm = nM - 1 - u.pm; return true;
    }
    __device__ __forceinline__ void a_ready(const Unit&) const {}
    __device__ __forceinline__ void done(const Unit&) const {}
};

__device__ __forceinline__ float row_rs(const float* ss, int row) { const f32x4* p = (const f32x4*)(ss + (size_t)row * 16); const f32x4 a = p[0], b = p[1], c = p[2], d = p[3];
    const float s = ((a[0] + a[1]) + (a[2] + a[3])) + ((b[0] + b[1]) + (b[2] + b[3])) + ((c[0] + c[1]) + (c[2] + c[3])) + ((d[0] + d[1]) + (d[2] + d[3]));
    return __builtin_amdgcn_rsqf(s * (1.0f / 1024.0f) + EPS); }

__device__ __forceinline__ void wave_rs_table(PG8_LAS float* tab, const float* ss, int row_base, int lane) {
    f32x4 pv[2][4];
#pragma unroll
    for (int h = 0; h < 2; ++h) { const int j = lane + 64 * h; const f32x4* p = (const f32x4*)(ss + (size_t)(row_base + (j >> 6) * HALF + (j & 63)) * 16);
#pragma unroll
        for (int q = 0; q < 4; ++q) pv[h][q] = p[q]; }
#pragma unroll
    for (int h = 0; h < 2; ++h) { const f32x4 a = pv[h][0], b = pv[h][1], c = pv[h][2], d = pv[h][3];
        const float s = ((a[0] + a[1]) + (a[2] + a[3])) + ((b[0] + b[1]) + (b[2] + b[3])) + ((c[0] + c[1]) + (c[2] + c[3])) + ((d[0] + d[1]) + (d[2] + d[3]));
        tab[lane + 64 * h] = __builtin_amdgcn_rsqf(s * (1.0f / 1024.0f) + EPS); }
    asm volatile("s_waitcnt lgkmcnt(0)" ::: "memory"); __builtin_amdgcn_wave_barrier(); asm volatile("" ::: "memory");
}

struct EpiSwiGLU {
    static constexpr bool PERM = true, AFTER_DRAIN = false;
    static __device__ __forceinline__ int store_class(const Unit&) { return 0; }
    static constexpr int RELAX = 6;
    bf16_t* H; const float* ss; PG8_LAS float* tabs;
    __device__ __forceinline__ void operator()(const f32x4 (&acc)[2][2][4][2], const Unit& u, int wr, int wc, int fr, int fq) const {
        const int row0 = u.pm * BM + wr * 64 + fr, col0 = u.pn * 128 + wc * 32 + 8 * fq;
        PG8_LAS float* tab = tabs + (wr * 4 + wc) * 128; wave_rs_table(tab, ss, u.pm * BM + wr * 64, fq * 16 + fr);
#pragma unroll
        for (int ai = 0; ai < 2; ++ai)
#pragma unroll
            for (int m = 0; m < 4; ++m) {
                const int row = row0 + ai * HALF + m * 16; const float rs = tab[ai * 64 + m * 16 + fr];
                float h[8];
#pragma unroll
                for (int n = 0; n < 2; ++n)
#pragma unroll
                    for (int e = 0; e < 4; ++e) { const float g = acc[ai][0][m][n][e] * rs, up = acc[ai][1][m][n][e] * rs; h[n * 4 + e] = g * fast_sigmoid(g) * up; }
                u32x4 w; w.x = cvtpk(h[0], h[1]); w.y = cvtpk(h[2], h[3]); w.z = cvtpk(h[4], h[5]); w.w = cvtpk(h[6], h[7]);
                *(u32x4*)(H + (size_t)row * DFF + col0) = w;
            }
    }
};

struct EpiResid {
    static constexpr bool PERM = true, AFTER_DRAIN = false;
    static __device__ __forceinline__ int store_class(const Unit&) { return 0; }
    static constexpr int RELAX = 22;
    bf16_t* xb; float* ssn; float scale;
    __device__ __forceinline__ void operator()(const f32x4 (&acc)[2][2][4][2], const Unit& u, int wr, int wc, int fr, int fq) const {
        const int row0 = u.pm * BM + wr * 64 + fr, col0 = u.pn * BM + wc * 32 + 8 * fq;
#pragma unroll
        for (int ai = 0; ai < 2; ++ai) {
            u32x4 gl[4][2];
#pragma unroll
            for (int m = 0; m < 4; ++m) { const bf16_t* xr = xb + (size_t)(row0 + ai * HALF + m * 16) * DM + col0; gl[m][0] = *(const u32x4*)xr; gl[m][1] = *(const u32x4*)(xr + HALF); }
#pragma unroll
            for (int m = 0; m < 4; ++m) {
                const int row = row0 + ai * HALF + m * 16;
                bf16_t* xr = xb + (size_t)row * DM + col0;
                const u32x4 g0 = gl[m][0], g1 = gl[m][1];
                float sq = 0.f;
#pragma unroll
                for (int bj = 0; bj < 2; ++bj) {
                    const u32x4 g = bj ? g1 : g0; const f32x4 p0 = acc[ai][bj][m][0], p1 = acc[ai][bj][m][1];
                    const float o0 = bflo(g.x) + scale * p0[0], o1 = bfhi(g.x) + scale * p0[1], o2 = bflo(g.y) + scale * p0[2], o3 = bfhi(g.y) + scale * p0[3];
                    const float o4 = bflo(g.z) + scale * p1[0], o5 = bfhi(g.z) + scale * p1[1], o6 = bflo(g.w) + scale * p1[2], o7 = bfhi(g.w) + scale * p1[3];
                    u32x4 w; w.x = cvtpk(o0, o1); w.y = cvtpk(o2, o3); w.z = cvtpk(o4, o5); w.w = cvtpk(o6, o7);
                    *(u32x4*)(xr + bj * HALF) = w;
                    sq += (o0 * o0 + o1 * o1) + (o2 * o2 + o3 * o3) + (o4 * o4 + o5 * o5) + (o6 * o6 + o7 * o7);
                }
                sq += __shfl_xor(sq, 16); sq += __shfl_xor(sq, 32);
                if (fq == 0) ssn[(size_t)row * 16 + u.pn * 4 + wc] = sq;
            }
        }
    }
};

struct EpiMixIn {
    static constexpr bool PERM = true, AFTER_DRAIN = false;
    static __device__ __forceinline__ int store_class(const Unit&) { return 0; }
    static constexpr int RELAX = 6;
    const float* ss; const bf16_t* bias16; bf16_t *Q, *KV, *BG, *U, *SA, *SC; PG8_LAS float* tabs;
    __device__ __forceinline__ void operator()(const f32x4 (&acc)[2][2][4][2], const Unit& u, int wr, int wc, int fr, int fq) const {
        PG8_LAS float* tab = tabs + (wr * 4 + wc) * 128; wave_rs_table(tab, ss, u.pm * BM + wr * 64, fq * 16 + fr);
        const int pn = u.pn; bf16_t* dst; int ld, cbase, mode; float sc = 1.f;
        if (pn < 4) { dst = Q; ld = DM; cbase = pn * 256; mode = 0; sc = QSCALE; }
        else if (pn == 4) { dst = KV; ld = 256; cbase = 0; mode = 0; }
        else if (pn < 9) { dst = BG; ld = DM; cbase = (pn - 5) * 256; mode = 0; }
        else if (pn < 17) { dst = U; ld = DM; cbase = (pn - 9) * 128; mode = 2; }
        else if (pn < 21) { dst = SA; ld = DM; cbase = (pn - 17) * 256; mode = 1; }
        else { dst = SC; ld = DM; cbase = (pn - 21) * 256; mode = 1; }
        const int row0 = u.pm * BM + wr * 64 + fr, cw = wc * 32 + 8 * fq;
        u32x4 bw[2];
#pragma unroll
        for (int bj = 0; bj < 2; ++bj) bw[bj] = *(const u32x4*)(bias16 + pn * 256 + bj * HALF + cw);
#define BV(bj, n) ((n) == 0 ? (f32x4){bflo(bw[bj].x), bfhi(bw[bj].x), bflo(bw[bj].y), bfhi(bw[bj].y)} : (f32x4){bflo(bw[bj].z), bfhi(bw[bj].z), bflo(bw[bj].w), bfhi(bw[bj].w)})
#pragma unroll
        for (int ai = 0; ai < 2; ++ai)
#pragma unroll
            for (int m = 0; m < 4; ++m) {
                const int row = row0 + ai * HALF + m * 16; const float rs = tab[ai * 64 + m * 16 + fr];
                bf16_t* rowp = dst + (size_t)row * ld + cbase + cw;
                if (mode == 2) {
                    const f32x4 z0 = (acc[ai][0][m][0] * rs + BV(0, 0)) * (acc[ai][1][m][0] * rs + BV(1, 0));
                    const f32x4 z1 = (acc[ai][0][m][1] * rs + BV(0, 1)) * (acc[ai][1][m][1] * rs + BV(1, 1));
                    u32x4 w; w.x = cvtpk(z0[0], z0[1]); w.y = cvtpk(z0[2], z0[3]); w.z = cvtpk(z1[0], z1[1]); w.w = cvtpk(z1[2], z1[3]);
                    *(u32x4*)rowp = w;
                } else {
#pragma unroll
                    for (int bj = 0; bj < 2; ++bj) {
                        f32x4 z0 = acc[ai][bj][m][0] * rs + BV(bj, 0), z1 = acc[ai][bj][m][1] * rs + BV(bj, 1);
                        if (mode == 1) {
#pragma unroll
                            for (int e = 0; e < 4; ++e) { z0[e] = fast_sigmoid(z0[e]); z1[e] = fast_sigmoid(z1[e]); }
                        } else { z0 = z0 * sc; z1 = z1 * sc; }
                        u32x4 w; w.x = cvtpk(z0[0], z0[1]); w.y = cvtpk(z0[2], z0[3]); w.z = cvtpk(z1[0], z1[1]); w.w = cvtpk(z1[2], z1[3]);
                        *(u32x4*)(rowp + bj * HALF) = w;
                    }
                }
            }
    }
};

#undef BV
struct EpiGate {
    static constexpr bool PERM = true, AFTER_DRAIN = false;
    static __device__ __forceinline__ int store_class(const Unit&) { return 0; }
    static constexpr int RELAX = 14;
    bf16_t* G; const bf16_t* ADD;
    __device__ __forceinline__ void operator()(const f32x4 (&acc)[2][2][4][2], const Unit& u, int wr, int wc, int fr, int fq) const {
        const int row0 = u.pm * BM + wr * 64 + fr, col0 = u.pn * BM + wc * 32 + 8 * fq;
#pragma unroll
        for (int ai = 0; ai < 2; ++ai)
#pragma unroll
          for (int mp = 0; mp < 2; ++mp) {
            u32x4 gl[2][2], al[2][2];
#pragma unroll
            for (int mm = 0; mm < 2; ++mm)
#pragma unroll
                for (int bj = 0; bj < 2; ++bj) { const size_t idx = (size_t)(row0 + ai * HALF + (2 * mp + mm) * 16) * DM + col0 + bj * HALF;
                    gl[mm][bj] = *(const u32x4*)(G + idx); al[mm][bj] = (u32x4){0u, 0u, 0u, 0u}; if (ADD) al[mm][bj] = *(const u32x4*)(ADD + idx); }
#pragma unroll
            for (int mm = 0; mm < 2; ++mm) {
                const int m = 2 * mp + mm;
                const int row = row0 + ai * HALF + m * 16;
#pragma unroll
                for (int bj = 0; bj < 2; ++bj) {
                    const size_t idx = (size_t)row * DM + col0 + bj * HALF;
                    const u32x4 g = gl[mm][bj];
                    const u32x4 a = al[mm][bj];
                    const f32x4 p0 = acc[ai][bj][m][0], p1 = acc[ai][bj][m][1];
                    u32x4 w;
                    w.x = cvtpk(bflo(a.x) + bflo(g.x) * p0[0], bfhi(a.x) + bfhi(g.x) * p0[1]);
                    w.y = cvtpk(bflo(a.y) + bflo(g.y) * p0[2], bfhi(a.y) + bfhi(g.y) * p0[3]);
                    w.z = cvtpk(bflo(a.z) + bflo(g.z) * p1[0], bfhi(a.z) + bfhi(g.z) * p1[1]);
                    w.w = cvtpk(bflo(a.w) + bflo(g.w) * p1[2], bfhi(a.w) + bfhi(g.w) * p1[3]);
                    *(u32x4*)(G + idx) = w;
                }
            }
          }
    }
};

template <class Epi, class Sched, bool ALIGN_EPI = false, bool SP2 = false>
__device__ __forceinline__ void gemm_phase(PG8_LAS unsigned char* lds, const Gemm g, const Sched& S, const Epi& E) {
    int tid_ = threadIdx.x; asm volatile("" : "+v"(tid_));
    const int tid = tid_, wid = __builtin_amdgcn_readfirstlane(tid >> 6), lane = tid & 63, wr = wid >> 2, wc = wid & 3, fr = lane & 15, fq = lane >> 4;
    const int K = g.K, nt = K / BK;
    unsigned voffA[2], voffB[2];
#pragma unroll
    for (int i = 0; i < 2; ++i) { int R, C; stage_rc(tid * 16 + i * 8192, R, C); const int Rb = Epi::PERM ? ((R & ~31) + perm32(R & 31)) : R;
        voffA[i] = (unsigned)(R * K + C) * 2u; voffB[i] = (unsigned)(Rb * K + C) * 2u; }
    const size_t kstep = (size_t)(BK * 2);
    const size_t hstep = (size_t)HALF * K * 2;
    const size_t tstep = 2 * hstep;
    const unsigned ldsw = (unsigned)wid * 1024u;
    const int aoff = lds_byte(wr * 64 + fr, fq * 8), boff = lds_byte(wc * 32 + fr, fq * 8);
#define PG8_SA(b, h) (((b) * 2 + (h)) * HTB)
#define PG8_SB(b, h) ((4 + (b) * 2 + (h)) * HTB)
    const unsigned ldsb = (unsigned)__builtin_amdgcn_readfirstlane((int)((unsigned)(unsigned long long)(__attribute__((address_space(3))) unsigned char*)lds + ldsw));
#define PG8_GLDS(vo, sbase, off) asm volatile("s_add_u32 m0, %2, %3\n\ts_nop 0\n\tglobal_load_lds_dwordx4 %0, %1" :: "v"(vo), "s"(sbase), "s"(ldsb), "i"(off) : "memory", "m0", "scc")
#define PG8_STAGE(bufoff, gbase, voff) do { PG8_GLDS((voff)[0], (const char*)(gbase), (bufoff)); PG8_GLDS((voff)[1], (const char*)(gbase), (bufoff) + 8192); } while (0)
#define PG8_LDA(dst, b, h) do { _Pragma("unroll") for (int m = 0; m < 4; ++m) _Pragma("unroll") for (int k = 0; k < 2; ++k) dst[m][k] = *(const PG8_LAS bf16x8*)(lds + PG8_SA(b, h) + aoff + m * 2048 + k * 1024); } while (0)
#define PG8_LDB(dst, b, h) do { _Pragma("unroll") for (int n = 0; n < 2; ++n) _Pragma("unroll") for (int k = 0; k < 2; ++k) dst[n][k] = *(const PG8_LAS bf16x8*)(lds + PG8_SB(b, h) + boff + n * 2048 + k * 1024); } while (0)
#define PG8_MMA(ai, bj, At, Bt) do { __builtin_amdgcn_s_setprio(1); _Pragma("unroll") for (int m = 0; m < 4; ++m) _Pragma("unroll") for (int n = 0; n < 2; ++n) _Pragma("unroll") for (int k = 0; k < 2; ++k) \
        acc[ai][bj][m][n] = __builtin_amdgcn_mfma_f32_16x16x32_bf16(Bt[n][k], At[m][k], acc[ai][bj][m][n], 0, 0, 0); __builtin_amdgcn_s_setprio(0); } while (0)
#define PG8_WAIT_V(n) asm volatile("s_waitcnt vmcnt(" #n ")" ::: "memory")
#define PG8_WAIT_VX(rx) PG8_WAIT_V(8)
#define PG8_WAIT_L(n) asm volatile("s_waitcnt lgkmcnt(" #n ")" ::: "memory")
#define PG8_BAR __builtin_amdgcn_s_barrier()
#define PG8_SCHED __builtin_amdgcn_sched_barrier(0)
    Unit cur, nxt; int ui = 0; int rcls = 0;
    if (!S.next(0, cur)) return;
    f32x4 acc[2][2][4][2];
#pragma unroll
    for (int a = 0; a < 2; ++a)
#pragma unroll
        for (int b = 0; b < 2; ++b)
#pragma unroll
            for (int m = 0; m < 4; ++m)
#pragma unroll
                for (int n = 0; n < 2; ++n) acc[a][b][m][n] = (f32x4){0.f, 0.f, 0.f, 0.f};
    bf16x8 At[4][2], B0[2][2], B1[2][2];
    const char* cA = (const char*)g.A + (size_t)cur.pm * tstep; const char* cB = (const char*)g.Bt + (size_t)cur.pn * tstep;
    S.a_ready(cur);
    if constexpr (SP2) {
        PG8_STAGE(PG8_SB(0, 0), cB, voffB); PG8_STAGE(PG8_SB(0, 1), cB + hstep, voffB); PG8_STAGE(PG8_SA(0, 0), cA, voffA); PG8_STAGE(PG8_SA(0, 1), cA + hstep, voffA);
        if (wr == 1) PG8_BAR;
        PG8_WAIT_V(2); PG8_BAR;
        PG8_STAGE(PG8_SB(1, 0), cB + kstep, voffB); PG8_STAGE(PG8_SA(1, 0), cA + kstep, voffA); PG8_STAGE(PG8_SB(1, 1), cB + hstep + kstep, voffB);
        PG8_WAIT_V(6); PG8_BAR;
    } else {
        PG8_STAGE(PG8_SB(0, 0), cB, voffB); PG8_STAGE(PG8_SA(0, 0), cA, voffA); PG8_STAGE(PG8_SB(0, 1), cB + hstep, voffB); PG8_STAGE(PG8_SA(0, 1), cA + hstep, voffA);
        if (wr == 1) PG8_BAR;
        PG8_WAIT_V(4); PG8_BAR;
        PG8_STAGE(PG8_SB(1, 0), cB + kstep, voffB); PG8_STAGE(PG8_SA(1, 0), cA + kstep, voffA); PG8_STAGE(PG8_SB(1, 1), cB + hstep + kstep, voffB);
        PG8_WAIT_V(6); PG8_BAR;
    }
    for (;;) {
        const bool has_next = S.next(ui + 1, nxt);
        const char* nA = has_next ? (const char*)g.A + (size_t)nxt.pm * tstep : cA; const char* nB = has_next ? (const char*)g.Bt + (size_t)nxt.pn * tstep : cB;
        for (int t = 0; t < nt; t += 2) {
            const bool last = (t == nt - 2);
            const char* a1 = cA + (size_t)(t + 1) * kstep;
            const char* a2 = last ? nA : cA + (size_t)(t + 2) * kstep; const char* b2 = last ? nB : cB + (size_t)(t + 2) * kstep;
            const char* a3 = a2 + kstep; const char* b3 = b2 + kstep;
            if (last && has_next) S.a_ready(nxt);
            if constexpr (SP2) {
            const int rx = (t == 0) ? rcls : 0;
            PG8_LDB(B0, 0, 0); PG8_LDB(B1, 0, 1); PG8_SCHED; PG8_LDA(At, 0, 0); PG8_STAGE(PG8_SA(1, 1), a1 + hstep, voffA);
            PG8_WAIT_VX(rx); PG8_WAIT_L(0); PG8_BAR; PG8_MMA(0, 0, At, B0); PG8_MMA(0, 1, At, B1); PG8_BAR; PG8_SCHED;
            PG8_LDA(At, 0, 1); PG8_STAGE(PG8_SB(0, 0), b2, voffB); PG8_STAGE(PG8_SB(0, 1), b2 + hstep, voffB); PG8_STAGE(PG8_SA(0, 0), a2, voffA);
            PG8_WAIT_VX(rx); PG8_WAIT_L(0); PG8_BAR; PG8_MMA(1, 0, At, B0); PG8_MMA(1, 1, At, B1); PG8_BAR; PG8_SCHED;
            PG8_LDB(B0, 1, 0); PG8_LDB(B1, 1, 1); PG8_SCHED; PG8_LDA(At, 1, 0); PG8_STAGE(PG8_SA(0, 1), a2 + hstep, voffA);
            PG8_WAIT_V(8); PG8_WAIT_L(0); PG8_BAR; PG8_MMA(0, 0, At, B0); PG8_MMA(0, 1, At, B1); PG8_BAR; PG8_SCHED;
            PG8_LDA(At, 1, 1); PG8_STAGE(PG8_SB(1, 0), b3, voffB); PG8_STAGE(PG8_SB(1, 1), b3 + hstep, voffB); PG8_STAGE(PG8_SA(1, 0), a3, voffA);
            PG8_WAIT_V(8); PG8_WAIT_L(0); PG8_BAR; PG8_MMA(1, 0, At, B0); PG8_MMA(1, 1, At, B1); PG8_BAR; PG8_SCHED;
            } else {
            PG8_LDB(B0, 0, 0); PG8_SCHED; PG8_LDA(At, 0, 0); PG8_STAGE(PG8_SA(1, 1), a1 + hstep, voffA);
            PG8_WAIT_L(8); PG8_BAR; PG8_WAIT_L(0); PG8_MMA(0, 0, At, B0); PG8_BAR; PG8_SCHED;
            PG8_LDB(B1, 0, 1); PG8_STAGE(PG8_SB(0, 0), b2, voffB);
            PG8_BAR; PG8_WAIT_L(0); PG8_MMA(0, 1, At, B1); PG8_BAR;
            PG8_LDA(At, 0, 1); PG8_STAGE(PG8_SA(0, 0), a2, voffA);
            PG8_BAR; PG8_WAIT_L(0); PG8_MMA(1, 0, At, B0); PG8_BAR; PG8_SCHED;
            PG8_STAGE(PG8_SB(0, 1), b2 + hstep, voffB);
            PG8_WAIT_V(6); PG8_BAR; PG8_MMA(1, 1, At, B1); PG8_BAR;
            PG8_LDB(B0, 1, 0); PG8_SCHED; PG8_LDA(At, 1, 0); PG8_STAGE(PG8_SA(0, 1), a2 + hstep, voffA);
            PG8_WAIT_L(8); PG8_BAR; PG8_WAIT_L(0); PG8_MMA(0, 0, At, B0); PG8_BAR; PG8_SCHED;
            PG8_LDB(B1, 1, 1); PG8_STAGE(PG8_SB(1, 0), b3, voffB);
            PG8_BAR; PG8_WAIT_L(0); PG8_MMA(0, 1, At, B1); PG8_BAR;
            PG8_LDA(At, 1, 1); PG8_STAGE(PG8_SA(1, 0), a3, voffA);
            PG8_BAR; PG8_WAIT_L(0); PG8_MMA(1, 0, At, B0); PG8_BAR; PG8_SCHED;
            PG8_STAGE(PG8_SB(1, 1), b3 + hstep, voffB);
            PG8_WAIT_V(6); PG8_BAR; PG8_MMA(1, 1, At, B1); PG8_BAR;
            }
        }
        if constexpr (ALIGN_EPI) { if (wr == 0) PG8_BAR; }
        if constexpr (!Epi::AFTER_DRAIN) { E(acc, cur, wr, wc, fr, fq); S.done(cur); rcls = 1 + Epi::store_class(cur); }
        if (!has_next) break;
#pragma unroll
        for (int a = 0; a < 2; ++a)
#pragma unroll
            for (int b = 0; b < 2; ++b)
#pragma unroll
                for (int m = 0; m < 4; ++m)
#pragma unroll
                    for (int n = 0; n < 2; ++n) acc[a][b][m][n] = (f32x4){0.f, 0.f, 0.f, 0.f};
        cur = nxt; cA = nA; cB = nB; ++ui;
        if constexpr (ALIGN_EPI) { if (wr == 1) PG8_BAR; }
    }
    PG8_WAIT_V(0);
    if constexpr (!ALIGN_EPI) { if (wr == 0) PG8_BAR; }
    PG8_BAR;
    if constexpr (Epi::AFTER_DRAIN) { E.fused(acc, cur, wr, wc, fr, fq, lds, wid, lane); S.done(cur); }
#undef PG8_SA
#undef PG8_SB
#undef PG8_STAGE
#undef PG8_LDA
#undef PG8_LDB
#undef PG8_MMA
#undef PG8_WAIT_V
#undef PG8_WAIT_VX
#undef PG8_GLDS
#undef PG8_WAIT_L
#undef PG8_BAR
#undef PG8_SCHED
}
}

#define GAS __attribute__((address_space(1)))
#define LAS __attribute__((address_space(3)))
typedef unsigned short bf16;
typedef float f32x4 __attribute__((ext_vector_type(4)));
typedef float f32x16 __attribute__((ext_vector_type(16)));
typedef unsigned u32x4 __attribute__((ext_vector_type(4)));
typedef short bf16x8 __attribute__((ext_vector_type(8)));
typedef short s16x4 __attribute__((ext_vector_type(4)));
constexpr size_t MiB = 1u << 20;
constexpr size_t WS_SS = 960 * MiB;
constexpr size_t WS_BAR = 2 * MiB;
constexpr size_t WS_BIAS = 3 * MiB;
constexpr size_t WS_W = 4 * MiB;
constexpr size_t E_W1GU = 0, E_W1D = E_W1GU + (size_t)2 * DFF * DM, E_WIN = E_W1D + (size_t)DM * DFF, E_WOA = E_WIN + (size_t)NIN * DM, E_WOC = E_WOA + (size_t)DM * DM,
                 E_WO = E_WOC + (size_t)DM * DM, E_W2GU = E_WO + (size_t)DM * DM, E_W2D = E_W2GU + (size_t)2 * DFF * DM, E_LAYER = E_W2D + (size_t)DM * DFF;
constexpr size_t WS_XB = 116 * MiB;
constexpr size_t ACT = (size_t)MT * DM * 2;
constexpr size_t WS_Q = 246 * MiB, WS_BG = WS_Q + ACT, WS_U = WS_BG + ACT, WS_SA = WS_U + ACT, WS_SC = WS_SA + ACT, WS_KV = WS_SC + ACT, WS_END = WS_KV + (size_t)MT * 256 * 2;
constexpr size_t WS_H = WS_Q;
static_assert(WS_W + 2 * E_LAYER * 2 <= WS_XB && WS_XB + ACT <= WS_Q && WS_H + (size_t)MT * DFF * 2 <= WS_SA && WS_END <= WS_SS && WS_SS + (size_t)7 * MT * 64 <= (size_t)1024 * MiB, "d_ws map");
constexpr size_t O_YP = 0, O_YS = (size_t)MP * DM, O_KP = O_YS + (size_t)MS * DM, O_VP = O_KP + 2 * 8 * 128 * 128, O_CP = O_VP + 2 * 8 * 128 * 128, O_KS = O_CP + 2 * 8 * 2 * 1024,
                 O_VS = O_KS + 2 * 16 * 128 * 128, O_CS = O_VS + 2 * 16 * 128 * 128, O_END = O_CS + 2 * 16 * 2 * 1024;

#ifndef MK_SKIP
#define MK_SKIP 0
#endif
#ifndef MK_DUP
#define MK_DUP 0
#endif
constexpr int NWAVES = 8, NTHR = 512;
constexpr int LDS_BYTES = 139264;

struct Args {
    const float* x_prompt; const float* x_sample; const float* cache_k; const float* cache_v; const float* state_conv;
    const float* norm_ffn1; const float* w1_gate; const float* w1_up; const float* w1_down;
    const float* norm_mix; const float* w_in; const float* b_in; const float* sinks; const float* conv_w; const float* w_o_attn; const float* w_o_conv; const float* w_o;
    const float* norm_ffn2; const float* w2_gate; const float* w2_up; const float* w2_down; const float* norm_final;
    float* out; unsigned char* ws;
};

__device__ __forceinline__ const float* inp(int k) { int z = 0; asm volatile("" : "+v"(z)); z = __builtin_amdgcn_readfirstlane(z);
    return ((const float* const __attribute__((address_space(4)))*)__builtin_amdgcn_kernarg_segment_ptr())[k + z]; }
__device__ __forceinline__ float wave_sum(float v) {
#pragma unroll
    for (int o = 1; o < 64; o <<= 1) v += __shfl_xor(v, o);
    return v;
}
#define LDS_WAIT() asm volatile("s_waitcnt lgkmcnt(0)" ::: "memory")

__device__ __forceinline__ void transpose_item(const float* W, int K, int N, const float* gain, bf16* WT, int dst_row0, LAS float* scr, int k0, int n0, int lane) {
    float v[32];
#pragma unroll
    for (int i = 0; i < 32; ++i) v[i] = W[(size_t)(k0 + 2 * i + (lane >> 5)) * N + n0 + (lane & 31)];
    const int c = lane & 7;
    f32x4 g0 = (f32x4){1.f, 1.f, 1.f, 1.f}, g1 = g0;
    if (gain) { g0 = *(const f32x4*)(gain + k0 + 8 * c); g1 = *(const f32x4*)(gain + k0 + 8 * c + 4); }
#pragma unroll
    for (int i = 0; i < 32; ++i) scr[(2 * i + (lane >> 5)) * 33 + (lane & 31)] = v[i];
    LDS_WAIT(); asm volatile("" ::: "memory");
#pragma unroll
    for (int j = 0; j < 4; ++j) { const int n = (lane >> 3) + 8 * j; const LAS float* s = scr + (8 * c) * 33 + n;
        u32x4 o; o.x = cvtpk(s[0 * 33] * g0[0], s[1 * 33] * g0[1]); o.y = cvtpk(s[2 * 33] * g0[2], s[3 * 33] * g0[3]); o.z = cvtpk(s[4 * 33] * g1[0], s[5 * 33] * g1[1]); o.w = cvtpk(s[6 * 33] * g1[2], s[7 * 33] * g1[3]);
        *(u32x4*)(WT + (size_t)(dst_row0 + n) * K + k0 + 8 * c) = o; }
    LDS_WAIT(); asm volatile("" ::: "memory");
}
__device__ __forceinline__ int win_map(int n) {
    if (n < 2304 || n >= 4352) return n;
    if (n < 3328) { const int f = n - 2304; return 2304 + 256 * (f >> 7) + (f & 127); }
    const int f = n - 3328; return 2304 + 256 * (f >> 7) + 128 + (f & 127);
}
__device__ __forceinline__ int gu_map(int f, int up) { return 256 * (f >> 7) + 128 * up + (f & 127); }

__device__ __forceinline__ void prologue(const Args& a, LAS unsigned char* lds, int tid, int lane, int wave) {
    LAS float* scr = (LAS float*)(lds + wave * 16384);
    const int gw = blockIdx.x * NWAVES + wave, NGW = gridDim.x * NWAVES;
    bf16* Wb = (bf16*)(a.ws + WS_W);
    constexpr int I_G = 16 * 88, I_D = 44 * 32, I_IN = 16 * 200, I_O = 16 * 32, I_LAYER = 6 * I_G + I_IN + 3 * I_O;
    static_assert(I_G == I_D, "item counts");
    for (int it = gw; it < 2 * I_LAYER; it += NGW) {
        const int l = it / I_LAYER; int r = it - l * I_LAYER; bf16* Wl = Wb + (size_t)l * E_LAYER;
        if (r < 2 * I_G) { const int up = r >= I_G; if (up) r -= I_G; const int kb = r / 88, nb = r % 88;
            transpose_item((up ? inp(7) : inp(6)) + (size_t)l * DM * DFF, DM, DFF, inp(5) + l * DM, Wl + E_W1GU, gu_map(nb * 32, up), scr, kb * 64, nb * 32, lane); continue; } r -= 2 * I_G;
        if (r < I_D) { const int kb = r / 32, nb = r % 32; transpose_item(inp(8) + (size_t)l * DFF * DM, DFF, DM, nullptr, Wl + E_W1D, nb * 32, scr, kb * 64, nb * 32, lane); continue; } r -= I_D;
        if (r < I_IN) { const int kb = r / 200, nb = r % 200; transpose_item(inp(10) + (size_t)l * DM * NIN, DM, NIN, inp(9) + l * DM, Wl + E_WIN, win_map(nb * 32), scr, kb * 64, nb * 32, lane); continue; } r -= I_IN;
        if (r < 3 * I_O) { const int w = r / I_O; r -= w * I_O; const int kb = r / 32, nb = r % 32; const float* src = (w == 0 ? inp(14) : w == 1 ? inp(15) : inp(16)) + (size_t)l * DM * DM;
            transpose_item(src, DM, DM, nullptr, Wl + (w == 0 ? E_WOA : w == 1 ? E_WOC : E_WO), nb * 32, scr, kb * 64, nb * 32, lane); continue; } r -= 3 * I_O;
        if (r < 2 * I_G) { const int up = r >= I_G; if (up) r -= I_G; const int kb = r / 88, nb = r % 88;
            transpose_item((up ? inp(19) : inp(18)) + (size_t)l * DM * DFF, DM, DFF, inp(17) + l * DM, Wl + E_W2GU, gu_map(nb * 32, up), scr, kb * 64, nb * 32, lane); continue; } r -= 2 * I_G;
        { const int kb = r / 32, nb = r % 32; transpose_item(inp(20) + (size_t)l * DFF * DM, DFF, DM, nullptr, Wl + E_W2D, nb * 32, scr, kb * 64, nb * 32, lane); }
    }
    float* ss = (float*)(a.ws + WS_SS); bf16* XB = (bf16*)(a.ws + WS_XB);
    static_assert(MT % 2 == 0 && MP % 2 == 0, "row pairs");
    for (int m2 = gw; m2 < MT / 2; m2 += NGW) {
        f32x4 v[2][4];
#pragma unroll
        for (int r = 0; r < 2; ++r) { const int m = 2 * m2 + r; const float* xr = (m < MP) ? inp(0) + (size_t)m * DM : inp(1) + (size_t)(m - MP) * DM;
#pragma unroll
            for (int j = 0; j < 4; ++j) v[r][j] = ((const f32x4*)xr)[lane + 64 * j]; }
#pragma unroll
        for (int r = 0; r < 2; ++r) { const int m = 2 * m2 + r; float s = 0.f;
#pragma unroll
            for (int j = 0; j < 4; ++j) s += (v[r][j].x * v[r][j].x + v[r][j].y * v[r][j].y) + (v[r][j].z * v[r][j].z + v[r][j].w * v[r][j].w);
            s = wave_sum(s); if (lane < 16) ss[(size_t)m * 16 + lane] = (lane == 0) ? s : 0.f;
            unsigned long long* o8 = (unsigned long long*)(XB + (size_t)m * DM) + lane;
#pragma unroll
            for (int j = 0; j < 4; ++j) o8[64 * j] = (unsigned long long)cvtpk(v[r][j].x, v[r][j].y) | ((unsigned long long)cvtpk(v[r][j].z, v[r][j].w) << 32); }
    }
    const int gt = blockIdx.x * NTHR + tid, NGT = gridDim.x * NTHR;
    { unsigned* bw = (unsigned*)(a.ws + WS_BAR); for (int i = gt; i < 3456  ; i += NGT) bw[i] = 0u; }
    float* bp = (float*)(a.ws + WS_BIAS);
    bf16* bp16 = (bf16*)(a.ws + WS_BIAS + 65536);
    for (int i = gt; i < 2 * NIN; i += NGT) { const int l = i / NIN, n = i - l * NIN; const float bvl = inp(11)[i]; bp[l * NIN + win_map(n)] = bvl; bp16[l * NIN + win_map(n)] = (bf16)(cvtpk(bvl, 0.f) & 0xffffu); }
}

constexpr int KS_STRIDE = 144, VT_STRIDE = 408;
constexpr int LDS_KS = 0, LDS_VT = 192 * KS_STRIDE, LDS_WSF = LDS_VT + 64 * VT_STRIDE, ATT_LDS = LDS_WSF + NWAVES * 32 * 4;
constexpr int N_ATT_ITEMS = 32 + NB * 128 * 2;
__device__ __forceinline__ int crow(int r, int hi) { return (r & 3) + 8 * (r >> 2) + 4 * hi; }

__device__ __forceinline__ void attn_item(LAS unsigned char* lds, const bf16* QI, bf16* AO, const bf16* KV, const float* ck, const float* cv, const float* sinks, int item, int tid, int lane, int wave) {
    int qrow0, nqb, blo, bhi, h, sb = 0; long kvrow0 = 0; bool sample;
    if (item < 32) { sample = true; sb = item >> 1; h = item & 1; qrow0 = MP + sb * 32; nqb = 1; blo = 0; bhi = 5; }
    else { sample = false; const int it = item - 32; h = it & 1; const int c = (it >> 1) & 127, b = it >> 8; qrow0 = b * SEQ + c * 64; nqb = 2; blo = c >= 2 ? 0 : 2 * (2 - c); bhi = 6; kvrow0 = (long)b * SEQ + (long)(c - 2) * 64; }
    const int r32 = lane & 31, hi = lane >> 5, head = h * 8 + wave;
    const bf16* qbase = QI + (size_t)(qrow0 + r32) * DM + head * 64 + hi * 8;
    bf16x8 qf[4];
#pragma unroll
    for (int d0 = 0; d0 < 4; ++d0) qf[d0] = *(const bf16x8*)(qbase + d0 * 16);
    { const int jb = tid >> 3, dg = tid & 7, tb = tid >> 8;
      u32x4 kx[3], vx[3];
#pragma unroll
      for (int i = 0; i < 3; ++i) { const int j = jb + 64 * i;
          if (tb + 2 * i >= blo && tb + 2 * i < bhi) {
              if (sample && j < 128) {
                  const size_t o = ((size_t)(sb * 128 + j)) * 128 + h * 64 + dg * 8;
                  const f32x4 k0 = *(const f32x4*)(ck + o), k1 = *(const f32x4*)(ck + o + 4), v0 = *(const f32x4*)(cv + o), v1 = *(const f32x4*)(cv + o + 4);
                  kx[i].x = cvtpk(k0[0], k0[1]); kx[i].y = cvtpk(k0[2], k0[3]); kx[i].z = cvtpk(k1[0], k1[1]); kx[i].w = cvtpk(k1[2], k1[3]);
                  vx[i].x = cvtpk(v0[0], v0[1]); vx[i].y = cvtpk(v0[2], v0[3]); vx[i].z = cvtpk(v1[0], v1[1]); vx[i].w = cvtpk(v1[2], v1[3]);
              } else {
                  const long row = sample ? (long)(MP + sb * 32 + (j - 128)) : kvrow0 + j;
                  const bf16* p = KV + (size_t)row * 256 + h * 64 + dg * 8;
                  kx[i] = *(const u32x4*)p; vx[i] = *(const u32x4*)(p + 128);
              }
          }
      }
#pragma unroll
      for (int i = 0; i < 3; ++i) { const int j = jb + 64 * i;
          if (tb + 2 * i >= blo && tb + 2 * i < bhi) {
              *(LAS u32x4*)(lds + LDS_KS + j * KS_STRIDE + dg * 16) = kx[i];
              LAS unsigned short* vt = (LAS unsigned short*)(lds + LDS_VT + (dg * 8) * VT_STRIDE + j * 2); const u32x4 v4 = vx[i];
              vt[0 * (VT_STRIDE / 2)] = (unsigned short)(v4.x & 0xffffu); vt[1 * (VT_STRIDE / 2)] = (unsigned short)(v4.x >> 16);
              vt[2 * (VT_STRIDE / 2)] = (unsigned short)(v4.y & 0xffffu); vt[3 * (VT_STRIDE / 2)] = (unsigned short)(v4.y >> 16);
              vt[4 * (VT_STRIDE / 2)] = (unsigned short)(v4.z & 0xffffu); vt[5 * (VT_STRIDE / 2)] = (unsigned short)(v4.z >> 16);
              vt[6 * (VT_STRIDE / 2)] = (unsigned short)(v4.w & 0xffffu); vt[7 * (VT_STRIDE / 2)] = (unsigned short)(v4.w >> 16);
          }
      } }
    __syncthreads();
    const float sink2 = sinks[head] * LOG2E;
    LAS float* wsf = (LAS float*)(lds + LDS_WSF) + wave * 32;
    for (int qb = 0; qb < nqb; ++qb) {
        f32x16 s[6];
#pragma unroll
        for (int kvb = 0; kvb < 6; ++kvb) {
            if (kvb >= blo && kvb < bhi) {
                f32x16 acc;
#pragma unroll
                for (int i = 0; i < 16; ++i) acc[i] = 0.f;
#pragma unroll
                for (int d0 = 0; d0 < 4; ++d0) { const bf16x8 kf = *(const LAS bf16x8*)(lds + LDS_KS + (kvb * 32 + r32) * KS_STRIDE + d0 * 32 + hi * 16);
                    acc = __builtin_amdgcn_mfma_f32_32x32x16_bf16(kf, qf[d0], acc, 0, 0, 0); }
                s[kvb] = acc;
            } else {
#pragma unroll
                for (int i = 0; i < 16; ++i) s[kvb][i] = -1e30f;
            }
        }
        if (qb + 1 < nqb) {
#pragma unroll
            for (int d0 = 0; d0 < 4; ++d0) qf[d0] = *(const bf16x8*)(qbase + (size_t)32 * DM + d0 * 16);
        }
        float mx = sink2;
#pragma unroll
        for (int kvb = 0; kvb < 6; ++kvb)
#pragma unroll
            for (int i = 0; i < 16; ++i) mx = fmaxf(mx, s[kvb][i]);
        mx = fmaxf(mx, __shfl_xor(mx, 32));
        float sum = 0.f;
#pragma unroll
        for (int kvb = 0; kvb < 6; ++kvb)
#pragma unroll
            for (int i = 0; i < 16; ++i) { const float e = __builtin_amdgcn_exp2f(s[kvb][i] - mx); s[kvb][i] = e; sum += e; }
        sum += __shfl_xor(sum, 32);
        const float l = sum + __builtin_amdgcn_exp2f(sink2 - mx);
        f32x16 o[2];
#pragma unroll
        for (int i = 0; i < 16; ++i) { o[0][i] = 0.f; o[1][i] = 0.f; }
#pragma unroll
        for (int kvb = 0; kvb < 6; ++kvb) {
            if (kvb >= blo && kvb < bhi) {
#pragma unroll
                for (int st = 0; st < 2; ++st) {
                    u32x4 pw; pw.x = cvtpk(s[kvb][8 * st + 0], s[kvb][8 * st + 1]); pw.y = cvtpk(s[kvb][8 * st + 2], s[kvb][8 * st + 3]);
                    pw.z = cvtpk(s[kvb][8 * st + 4], s[kvb][8 * st + 5]); pw.w = cvtpk(s[kvb][8 * st + 6], s[kvb][8 * st + 7]);
                    const bf16x8 pf = __builtin_bit_cast(bf16x8, pw);
#pragma unroll
                    for (int db = 0; db < 2; ++db) {
                        const LAS unsigned char* vp = lds + LDS_VT + (db * 32 + r32) * VT_STRIDE + (kvb * 32 + 16 * st + 4 * hi) * 2;
                        const s16x4 lo = *(const LAS s16x4*)vp, hh = *(const LAS s16x4*)(vp + 16);
                        const bf16x8 vf = __builtin_shufflevector(lo, hh, 0, 1, 2, 3, 4, 5, 6, 7);
                        o[db] = __builtin_amdgcn_mfma_f32_32x32x16_bf16(pf, vf, o[db], 0, 0, 0);
                    }
                }
            }
        }
        if (hi == 0) wsf[r32] = l;
        LDS_WAIT(); __builtin_amdgcn_wave_barrier(); asm volatile("" ::: "memory");
        bf16* op = AO + (size_t)(qrow0 + qb * 32) * DM + head * 64 + r32;
#pragma unroll
        for (int i = 0; i < 16; ++i) {
            const int q = crow(i, hi); const float rl = __builtin_amdgcn_rcpf(wsf[q]);
            const unsigned w0 = cvtpk(o[0][i] * rl, o[1][i] * rl);
            op[(size_t)q * DM] = (unsigned short)(w0 & 0xffffu); op[(size_t)q * DM + 32] = (unsigned short)(w0 >> 16);
        }
        LDS_WAIT(); __builtin_amdgcn_wave_barrier(); asm volatile("" ::: "memory");
    }
    __syncthreads();
}

__device__ __forceinline__ void conv_chunk(bf16* BG, const bf16* U, const float* cw, const float* st  , int chunk, int tid) {
    const int cgp = tid & 127, rsub = tid >> 7, c0 = cgp * 8;
    const int t0 = chunk * 32 + rsub * 8;
    float w[3][8];
#pragma unroll
    for (int j = 0; j < 3; ++j) { const f32x4 a = *(const f32x4*)(cw + j * DM + c0), b = *(const f32x4*)(cw + j * DM + c0 + 4);
#pragma unroll
        for (int e = 0; e < 4; ++e) { w[j][e] = a[e]; w[j][4 + e] = b[e]; } }
    float p2[8], p1[8];
    const int pos = (t0 < MP) ? (t0 & (SEQ - 1)) : ((t0 - MP) & (SSEQ - 1));
    if (pos == 0) {
        if (t0 < MP) {
#pragma unroll
            for (int e = 0; e < 8; ++e) { p2[e] = 0.f; p1[e] = 0.f; }
        } else {
            const float* s0 = st + (size_t)((t0 - MP) / SSEQ) * 2 * DM + c0;
            const f32x4 a = *(const f32x4*)s0, b = *(const f32x4*)(s0 + 4), c = *(const f32x4*)(s0 + DM), d = *(const f32x4*)(s0 + DM + 4);
#pragma unroll
            for (int e = 0; e < 4; ++e) { p2[e] = a[e]; p2[4 + e] = b[e]; p1[e] = c[e]; p1[4 + e] = d[e]; }
        }
    } else {
        const u32x4 a = *(const u32x4*)(U + (size_t)(t0 - 2) * DM + c0), b = *(const u32x4*)(U + (size_t)(t0 - 1) * DM + c0);
        p2[0] = bflo(a.x); p2[1] = bfhi(a.x); p2[2] = bflo(a.y); p2[3] = bfhi(a.y); p2[4] = bflo(a.z); p2[5] = bfhi(a.z); p2[6] = bflo(a.w); p2[7] = bfhi(a.w);
        p1[0] = bflo(b.x); p1[1] = bfhi(b.x); p1[2] = bflo(b.y); p1[3] = bfhi(b.y); p1[4] = bflo(b.z); p1[5] = bfhi(b.z); p1[6] = bflo(b.w); p1[7] = bfhi(b.w);
    }
    u32x4 ur[8], gr[8];
#pragma unroll
    for (int r = 0; r < 8; ++r) { const size_t idx = (size_t)(t0 + r) * DM + c0; ur[r] = *(const u32x4*)(U + idx); gr[r] = *(const u32x4*)(BG + idx); }
#pragma unroll
    for (int r = 0; r < 8; ++r) {
        const size_t idx = (size_t)(t0 + r) * DM + c0;
        const u32x4 uu = ur[r], gg = gr[r];
        float cu[8], g[8], o[8];
        cu[0] = bflo(uu.x); cu[1] = bfhi(uu.x); cu[2] = bflo(uu.y); cu[3] = bfhi(uu.y); cu[4] = bflo(uu.z); cu[5] = bfhi(uu.z); cu[6] = bflo(uu.w); cu[7] = bfhi(uu.w);
        g[0] = bflo(gg.x); g[1] = bfhi(gg.x); g[2] = bflo(gg.y); g[3] = bfhi(gg.y); g[4] = bflo(gg.z); g[5] = bfhi(gg.z); g[6] = bflo(gg.w); g[7] = bfhi(gg.w);
#pragma unroll
        for (int e = 0; e < 8; ++e) { o[e] = g[e] * (w[0][e] * p2[e] + w[1][e] * p1[e] + w[2][e] * cu[e]); p2[e] = p1[e]; p1[e] = cu[e]; }
        u32x4 ww; ww.x = cvtpk(o[0], o[1]); ww.y = cvtpk(o[2], o[3]); ww.z = cvtpk(o[4], o[5]); ww.w = cvtpk(o[6], o[7]);
        *(u32x4*)(BG + idx) = ww;
    }
}

__device__ __forceinline__ f32x4 bf4(const bf16* p) { const uint2 w = *(const uint2*)p; return (f32x4){bflo(w.x), bfhi(w.x), bflo(w.y), bfhi(w.y)}; }
__device__ __forceinline__ void state_copies(const Args& a, int l, const bf16* KV, const bf16* U, int gt, int NGT) {
    constexpr int N_KP = 8 * 128 * 128 / 4, N_CP = 8 * 2 * 1024 / 4, N_KS = 16 * 128 * 128 / 4, N_CS = 16 * 2 * 1024 / 4;
    constexpr int TOT = 2 * N_KP + N_CP + 2 * N_KS + N_CS;
    float* out = a.out;
    for (int i = gt; i < TOT; i += NGT) {
        int r = i;
        if (r < 2 * N_KP) { const int v = r >= N_KP; if (v) r -= N_KP; const int e = r * 4, hd = e & 127, j = (e >> 7) & 127, b = e >> 14;
            *(f32x4*)(out + (v ? O_VP : O_KP) + (size_t)l * 8 * 128 * 128 + e) = bf4(KV + (size_t)(b * SEQ + SEQ - 128 + j) * 256 + v * 128 + hd); continue; } r -= 2 * N_KP;
        if (r < N_CP) { const int e = r * 4, c = e & 1023, ii = (e >> 10) & 1, b = e >> 11;
            *(f32x4*)(out + O_CP + (size_t)l * 8 * 2 * 1024 + e) = bf4(U + (size_t)(b * SEQ + SEQ - 2 + ii) * DM + c); continue; } r -= N_CP;
        if (r < 2 * N_KS) { const int v = r >= N_KS; if (v) r -= N_KS; const int e = r * 4, hd = e & 127, j = (e >> 7) & 127, b = e >> 14;
            f32x4 val;
            if (j < 96) val = *(const f32x4*)((v ? inp(3) : inp(2)) + ((size_t)(l * 16 + b) * 128 + 32 + j) * 128 + hd);
            else val = bf4(KV + (size_t)(MP + b * SSEQ + j - 96) * 256 + v * 128 + hd);
            *(f32x4*)(out + (v ? O_VS : O_KS) + (size_t)l * 16 * 128 * 128 + e) = val; continue; } r -= 2 * N_KS;
        { const int e = r * 4, c = e & 1023, ii = (e >> 10) & 1, b = e >> 11;
            *(f32x4*)(out + O_CS + (size_t)l * 16 * 2 * 1024 + e) = bf4(U + (size_t)(MP + b * SSEQ + SSEQ - 2 + ii) * DM + c); }
    }
}

__device__ __forceinline__ int opaque_tid() { int t = threadIdx.x; asm volatile("" : "+v"(t)); return t; }

typedef float f32x4s __attribute__((ext_vector_type(4)));
__device__ __forceinline__ uint2 pack4(const f32x4s& v) { uint2 w; w.x = cvtpk(v[0], v[1]); w.y = cvtpk(v[2], v[3]); return w; }
__device__ __forceinline__ f32x4s unpack4(const uint2 w) { return (f32x4s){bflo(w.x), bfhi(w.x), bflo(w.y), bfhi(w.y)}; }

struct SEpiSwiGLU {
    bf16* H; const float* ss;
    __device__ __forceinline__ void brows(int sl, int& b0, int& b1) const { b0 = gu_map(32 * sl, 0); b1 = b0 + 128; }
    __device__ __forceinline__ void operator()(const f32x4s& c0, const f32x4s& c1, int row, int sl, int cw, int rit, int wc2, int fq, LAS float* xch) const {
        const float rs = pg8::row_rs(ss, row); f32x4s h;
#pragma unroll
        for (int e = 0; e < 4; ++e) { const float g = c0[e] * rs, u = c1[e] * rs; h[e] = g * fast_sigmoid(g) * u; }
        *(uint2*)(H + (size_t)row * DFF + 32 * sl + cw) = pack4(h);
    }
};
struct SEpiResid {
    bf16* xb; float* ssn; float scale;
    __device__ __forceinline__ void brows(int sl, int& b0, int& b1) const { b0 = 64 * sl; b1 = b0 + 32; }
    __device__ __forceinline__ void operator()(const f32x4s& c0, const f32x4s& c1, int row, int sl, int cw, int rit, int wc2, int fq, LAS float* xch) const {
        bf16* p = xb + (size_t)row * DM + 64 * sl + cw;
        const f32x4s o0 = unpack4(*(const uint2*)p) + c0 * scale, o1 = unpack4(*(const uint2*)(p + 32)) + c1 * scale;
        *(uint2*)p = pack4(o0); *(uint2*)(p + 32) = pack4(o1);
        float sq = (o0[0] * o0[0] + o0[1] * o0[1]) + (o0[2] * o0[2] + o0[3] * o0[3]) + (o1[0] * o1[0] + o1[1] * o1[1]) + (o1[2] * o1[2] + o1[3] * o1[3]);
        sq += __shfl_xor(sq, 16); sq += __shfl_xor(sq, 32);
        if (fq == 0) xch[wc2 * 64 + rit] = sq;
        __syncthreads();
        if (fq == 0 && wc2 == 0) ssn[(size_t)row * 16 + sl] = xch[rit] + xch[64 + rit];
    }
};
struct SEpiMixIn {
    const float* ss; const float* bias; bf16 *Q, *KV, *BG, *U, *SA, *SC;
    __device__ __forceinline__ void brows(int sl, int& b0, int& b1) const {
        if (sl < 36) { b0 = 64 * sl; b1 = b0 + 32; }
        else if (sl < 68) { const int f0 = 32 * (sl - 36); b0 = 2304 + 256 * (f0 >> 7) + (f0 & 127); b1 = b0 + 128; }
        else { b0 = 4352 + 64 * (sl - 68); b1 = b0 + 32; }
    }
    __device__ __forceinline__ void operator()(const f32x4s& c0, const f32x4s& c1, int row, int sl, int cw, int rit, int wc2, int fq, LAS float* xch) const {
        int b0, b1; brows(sl, b0, b1);
        bf16* dst; int ld, cb, mode; float sc = 1.f;
        if (sl < 16) { dst = Q; ld = DM; cb = 64 * sl; mode = 0; sc = QSCALE; }
        else if (sl < 20) { dst = KV; ld = 256; cb = 64 * (sl - 16); mode = 0; }
        else if (sl < 36) { dst = BG; ld = DM; cb = 64 * (sl - 20); mode = 0; }
        else if (sl < 68) { dst = U; ld = DM; cb = 32 * (sl - 36); mode = 2; }
        else if (sl < 84) { dst = SA; ld = DM; cb = 64 * (sl - 68); mode = 1; }
        else { dst = SC; ld = DM; cb = 64 * (sl - 84); mode = 1; }
        const float rs = pg8::row_rs(ss, row);
        f32x4s z0 = c0 * rs + *(const f32x4s*)(bias + b0 + cw), z1 = c1 * rs + *(const f32x4s*)(bias + b1 + cw);
        bf16* p = dst + (size_t)row * ld + cb + cw;
        if (mode == 2) { *(uint2*)p = pack4(z0 * z1); }
        else {
            if (mode == 1) {
#pragma unroll
                for (int e = 0; e < 4; ++e) { z0[e] = fast_sigmoid(z0[e]); z1[e] = fast_sigmoid(z1[e]); }
            } else { z0 = z0 * sc; z1 = z1 * sc; }
            *(uint2*)p = pack4(z0); *(uint2*)(p + 32) = pack4(z1);
        }
    }
};
struct SEpiGate {
    bf16* Gt; const bf16* ADD;
    __device__ __forceinline__ void brows(int sl, int& b0, int& b1) const { b0 = 64 * sl; b1 = b0 + 32; }
    __device__ __forceinline__ void operator()(const f32x4s& c0, const f32x4s& c1, int row, int sl, int cw, int rit, int wc2, int fq, LAS float* xch) const {
        const size_t idx = (size_t)row * DM + 64 * sl + cw;
        f32x4s a0 = (f32x4s){0.f, 0.f, 0.f, 0.f}, a1 = a0;
        if (ADD) { a0 = unpack4(*(const uint2*)(ADD + idx)); a1 = unpack4(*(const uint2*)(ADD + idx + 32)); }
        const f32x4s g0 = unpack4(*(const uint2*)(Gt + idx)), g1 = unpack4(*(const uint2*)(Gt + idx + 32));
        *(uint2*)(Gt + idx) = pack4(a0 + g0 * c0); *(uint2*)(Gt + idx + 32) = pack4(a1 + g1 * c1);
    }
};

template <class Epi>
__device__ __forceinline__ void sample_gemm(LAS unsigned char* lds, const bf16* A, const bf16* Bt, int K, int nslices, const Epi& E, int bx, int G) {
    const int tid = opaque_tid(), lane = tid & 63, wave = __builtin_amdgcn_readfirstlane(tid >> 6), fr = lane & 15, fq = lane >> 4, wr4 = wave >> 1, wc2 = wave & 1;
    constexpr int RS = 528;
    LAS unsigned char* As = lds; LAS unsigned char* Bs = lds + 64 * RS; LAS float* xch = (LAS float*)(lds + 2 * 64 * RS);
    const int srow = tid >> 3, sch = tid & 7, nst = K >> 8, ntasks = nslices * 8;
    const int pbx = (G % 8 == 0) ? (bx & 7) * (G >> 3) + (bx >> 3) : bx;
    for (int t = pbx; t < ntasks; t += G) {
        const int sl = t >> 3, tm = t & 7;
        int br0, br1; E.brows(sl, br0, br1);
        const bf16* ag = A + (size_t)(MP + tm * 64 + srow) * K + sch * 8;
        const bf16* bg = Bt + (size_t)((srow < 32) ? br0 + srow : br1 + (srow - 32)) * K + sch * 8;
        u32x4 ra[4], rb[4];
#pragma unroll
        for (int q = 0; q < 4; ++q) { ra[q] = *(const u32x4*)(ag + 64 * q); rb[q] = *(const u32x4*)(bg + 64 * q); }
        f32x4s c0 = (f32x4s){0.f, 0.f, 0.f, 0.f}, c1 = c0;
        for (int s = 0; s < nst; ++s) {
            __syncthreads();
#pragma unroll
            for (int q = 0; q < 4; ++q) { *(LAS u32x4*)(As + srow * RS + (sch + 8 * q) * 16) = ra[q]; *(LAS u32x4*)(Bs + srow * RS + (sch + 8 * q) * 16) = rb[q]; }
            __syncthreads();
            if (s + 1 < nst) { const int o = (s + 1) * 256;
#pragma unroll
                for (int q = 0; q < 4; ++q) { ra[q] = *(const u32x4*)(ag + o + 64 * q); rb[q] = *(const u32x4*)(bg + o + 64 * q); } }
#pragma unroll
            for (int ks = 0; ks < 8; ++ks) {
                const bf16x8 af = *(const LAS bf16x8*)(As + (wr4 * 16 + fr) * RS + ks * 64 + fq * 16);
                const bf16x8 bf0 = *(const LAS bf16x8*)(Bs + (wc2 * 16 + fr) * RS + ks * 64 + fq * 16), bf1 = *(const LAS bf16x8*)(Bs + (32 + wc2 * 16 + fr) * RS + ks * 64 + fq * 16);
                c0 = __builtin_amdgcn_mfma_f32_16x16x32_bf16(bf0, af, c0, 0, 0, 0); c1 = __builtin_amdgcn_mfma_f32_16x16x32_bf16(bf1, af, c1, 0, 0, 0);
            }
        }
        E(c0, c1, MP + tm * 64 + wr4 * 16 + fr, sl, wc2 * 16 + 4 * fq, wr4 * 16 + fr, wc2, fq, xch);
    }
    __syncthreads();
}

#define RLX_AGENT __ATOMIC_RELAXED, __HIP_MEMORY_SCOPE_AGENT
#define XB_TMO      128
#define XB_XCNT(j)  (256  + 64 * (j))
#define XB_XSUB(j)  (1280 + 64 * (j))
#define XB_XGEN(j)  (2304 + 64 * (j))
#define XB_TOP      3328
#define XB_TOPGEN   3392
#define XCD_BAR_WORDS 3456
#define XB_SPIN_CAP (1u << 18)

__device__ __forceinline__ unsigned xb_ld(unsigned* p)              { return __hip_atomic_load(p, __ATOMIC_RELAXED, __HIP_MEMORY_SCOPE_AGENT); }
__device__ __forceinline__ unsigned xb_add(unsigned* p, unsigned v) { return __hip_atomic_fetch_add(p, v, __ATOMIC_RELAXED, __HIP_MEMORY_SCOPE_AGENT); }
__device__ __forceinline__ unsigned xb_xcc_id() { return (unsigned)__builtin_amdgcn_s_getreg((3 << 11) | 20) & 0xFu; }
#define XB_SPIN(cond, bar) do { unsigned _sp = 0; while (cond) { __builtin_amdgcn_s_sleep(1); \
    if ((++_sp & 255u) == 0u) { if (xb_ld(&(bar)[XB_TMO])) break; if (_sp > XB_SPIN_CAP) { atomicAdd(&(bar)[XB_TMO], 1u); break; } } } } while (0)

struct XcdBarrier {
    unsigned* bar; unsigned x;
    volatile LAS unsigned* st;
};

__device__ __forceinline__ XcdBarrier xcd_barrier_post(unsigned* bar, volatile LAS unsigned* st) {
    XcdBarrier b; b.bar = bar; b.x = xb_xcc_id(); b.st = st;
    if (threadIdx.x == 0) (void)xb_add(&bar[XB_XCNT(b.x)], 1u);
    return b;
}
__device__ __forceinline__ void xcd_barrier_complete(unsigned* bar, unsigned x, unsigned& nloc, unsigned& nx) {
    const unsigned G = gridDim.x * gridDim.y * gridDim.z;
    unsigned sum, cnt, mine, sp = 0u;
    for (;;) {
        sum = 0u; cnt = 0u; mine = 0u;
#pragma unroll
        for (unsigned j = 0; j < 16; ++j) { const unsigned c = xb_ld(&bar[XB_XCNT(j)]); sum += c; cnt += (c > 0u) ? 1u : 0u; mine = (j == x) ? c : mine; }
        if (sum == G) break;
        __builtin_amdgcn_s_sleep(1);
        if ((++sp & 255u) == 0u) { if (xb_ld(&bar[XB_TMO])) break; if (sp > XB_SPIN_CAP) { atomicAdd(&bar[XB_TMO], 1u); break; } }
    }
    nloc = mine > 0u ? mine : 1u; nx = cnt > 0u ? cnt : 1u;
}

__device__ __forceinline__ void xcd_barrier(const XcdBarrier& b) {
    asm volatile("s_waitcnt vmcnt(0)" ::: "memory");
    __syncthreads();
    if (threadIdx.x == 0) {
        unsigned* bar = b.bar;
        __builtin_amdgcn_s_waitcnt(0);
        unsigned nloc = b.st[0], nx = b.st[1];
        if (nloc == 0u) { xcd_barrier_complete(bar, b.x, nloc, nx); b.st[0] = nloc; b.st[1] = nx; }
        const unsigned old = xb_add(&bar[XB_XSUB(b.x)], 1u);
        const unsigned gen = old / nloc;
        if (old + 1u == (gen + 1u) * nloc) {
            __builtin_amdgcn_fence(__ATOMIC_RELEASE, "agent");
            asm volatile("s_waitcnt vmcnt(0)" ::: "memory");
            const unsigned og = xb_add(&bar[XB_TOP], 1u);
            const unsigned tg = og / nx;
            if (og + 1u == (tg + 1u) * nx) xb_add(&bar[XB_TOPGEN], 1u);
            else XB_SPIN(xb_ld(&bar[XB_TOPGEN]) == tg, bar);
            __builtin_amdgcn_fence(__ATOMIC_ACQUIRE, "agent");
            xb_add(&bar[XB_XGEN(b.x)], 1u);
            asm volatile("s_waitcnt vmcnt(0)" ::: "memory");
        } else {
            XB_SPIN(xb_ld(&bar[XB_XGEN(b.x)]) == gen, bar);
            __builtin_amdgcn_fence(__ATOMIC_ACQUIRE, "agent");
            asm volatile("s_waitcnt vmcnt(0)" ::: "memory");
        }
    }
    __syncthreads();
}

#ifndef MK_REV
#define MK_REV 1
#endif
#ifndef MK_SP2
#define MK_SP2 true
#endif
#ifndef MK_ALIGN
#define MK_ALIGN true
#endif
#ifndef MK_STAGGER
#define MK_STAGGER 0
#endif
__device__ __forceinline__ void stagger(int bx) { const unsigned lvl = (unsigned)(bx >> 3) & 3u; if (MK_STAGGER > 0 && lvl) { const unsigned long long t0 = __builtin_amdgcn_s_memrealtime(); while (__builtin_amdgcn_s_memrealtime() - t0 < (unsigned long long)(lvl * MK_STAGGER)) __builtin_amdgcn_s_sleep(4); } }
__global__ void __launch_bounds__(NTHR, 2) fwd_megakernel(Args a) {
    extern __shared__ __attribute__((aligned(16))) unsigned char lds_raw[];
    LAS unsigned char* lds = (LAS unsigned char*)lds_raw;
    cg::grid_group grid = cg::this_grid();
    volatile LAS unsigned* bar_st = (volatile LAS unsigned*)(lds + 131072 + 64);
    if (threadIdx.x < 2) bar_st[threadIdx.x] = 0u;
    __syncthreads();
    const int G = gridDim.x, bx = blockIdx.x;
#define ws ((unsigned char*)inp(23))
#define ss ((float*)(ws + WS_SS))
#define XB ((bf16*)(ws + WS_XB))
#define H ((bf16*)(ws + WS_H))
#define Q ((bf16*)(ws + WS_Q))
#define BG ((bf16*)(ws + WS_BG))
#define U ((bf16*)(ws + WS_U))
#define SA ((bf16*)(ws + WS_SA))
#define SC ((bf16*)(ws + WS_SC))
#define KV ((bf16*)(ws + WS_KV))
#define xout ((float*)inp(22))

#if !(MK_SKIP & 1)
    { const int tid = opaque_tid(), lane = tid & 63, wave = __builtin_amdgcn_readfirstlane(tid >> 6); prologue(a, lds, tid, lane, wave);
      if (MK_DUP & 1) { __syncthreads(); prologue(a, lds, tid, lane, wave); } }
#endif
    grid.sync();
    const XcdBarrier bar = xcd_barrier_post((unsigned*)(ws + WS_BAR), bar_st);

#pragma nounroll
    for (int l = 0; l < 2; ++l) {
        const bf16* Wl = (const bf16*)(ws + WS_W) + (size_t)l * E_LAYER;
#if !(MK_SKIP & 2)
        { SEpiSwiGLU SE{H, ss + (size_t)(3 * l) * MT * 16}; sample_gemm(lds, XB, Wl + E_W1GU, DM, DFF / 32, SE, bx, G);
          pg8::Gemm g{XB, Wl + E_W1GU, MP, 2 * DFF, DM}; pg8::StaticOrder S; S.init(MP, 2 * DFF, G, bx); pg8::EpiSwiGLU E{H, ss + (size_t)(3 * l) * MT * 16, (LAS float*)(lds + 131072 + 1024)};
          stagger(bx);
          pg8::gemm_phase<pg8::EpiSwiGLU, pg8::StaticOrder, MK_ALIGN, MK_SP2>(lds, g, S, E);
          if (MK_DUP & 2) pg8::gemm_phase<pg8::EpiSwiGLU, pg8::StaticOrder, MK_ALIGN, MK_SP2>(lds, g, S, E); }
#endif
        xcd_barrier(bar);
        if (MK_DUP & 8) xcd_barrier(bar);
#if !(MK_SKIP & 4)
        { SEpiResid SE{XB, ss + (size_t)(3 * l + 1) * MT * 16, 0.5f}; sample_gemm(lds, H, Wl + E_W1D, DFF, DM / 64, SE, bx, G);
          pg8::Gemm g{H, Wl + E_W1D, MP, DM, DFF}; pg8::StaticOrder S; S.init(MP, DM, G, bx, MK_REV);
          pg8::EpiResid E{XB, ss + (size_t)(3 * l + 1) * MT * 16, (MK_DUP & 32) ? 0.25f : 0.5f};
          stagger(bx);
          pg8::gemm_phase<pg8::EpiResid, pg8::StaticOrder, MK_ALIGN, MK_SP2>(lds, g, S, E);
          if (MK_DUP & 32) pg8::gemm_phase<pg8::EpiResid, pg8::StaticOrder, MK_ALIGN, MK_SP2>(lds, g, S, E); }
#endif
        xcd_barrier(bar);
        if (MK_DUP & 8) xcd_barrier(bar);
#if !(MK_SKIP & 8)
        { SEpiMixIn SE{ss + (size_t)(3 * l + 1) * MT * 16, (const float*)(ws + WS_BIAS) + l * NIN, Q, KV, BG, U, SA, SC}; sample_gemm(lds, XB, Wl + E_WIN, DM, 100, SE, bx, G);
          pg8::Gemm g{XB, Wl + E_WIN, MP, NIN, DM}; pg8::StaticOrder S; S.init(MP, NIN, G, bx);
          pg8::EpiMixIn E{ss + (size_t)(3 * l + 1) * MT * 16, (const bf16*)(ws + WS_BIAS + 65536) + l * NIN, Q, KV, BG, U, SA, SC, (LAS float*)(lds + 131072 + 1024)};
          stagger(bx);
          pg8::gemm_phase<pg8::EpiMixIn, pg8::StaticOrder, MK_ALIGN, MK_SP2>(lds, g, S, E);
          if (MK_DUP & 16) pg8::gemm_phase<pg8::EpiMixIn, pg8::StaticOrder, MK_ALIGN, MK_SP2>(lds, g, S, E); }
#endif
        xcd_barrier(bar);
        if (MK_DUP & 8) xcd_barrier(bar);
#if !(MK_SKIP & 16)
        { const int tid = opaque_tid(), lane = tid & 63, wave = __builtin_amdgcn_readfirstlane(tid >> 6);
          const float* ck = inp(2) + (size_t)l * 16 * 128 * 128; const float* cv = inp(3) + (size_t)l * 16 * 128 * 128;
          const bool conv_first = ((bx >> 3) & 1) != 0;
          if (conv_first) for (int ch = bx; ch < MT / 32; ch += G) conv_chunk(BG, U, inp(13) + (size_t)l * 3 * DM, inp(4) + (size_t)l * 16 * 2 * DM, MT / 32 - 1 - ch, tid);
          for (int it = bx; it < N_ATT_ITEMS; it += G) attn_item(lds, Q, Q, KV, ck, cv, inp(12) + l * 16, N_ATT_ITEMS - 1 - it, tid, lane, wave);
          if (!conv_first) for (int ch = bx; ch < MT / 32; ch += G) conv_chunk(BG, U, inp(13) + (size_t)l * 3 * DM, inp(4) + (size_t)l * 16 * 2 * DM, MT / 32 - 1 - ch, tid);
          state_copies(a, l, KV, U, bx * NTHR + tid, G * NTHR); }
#endif
        xcd_barrier(bar);
        if (MK_DUP & 8) xcd_barrier(bar);
#if !(MK_SKIP & 32)
        { SEpiGate SE{SA, nullptr}; sample_gemm(lds, Q, Wl + E_WOA, DM, DM / 64, SE, bx, G);
          pg8::Gemm g{Q, Wl + E_WOA, MP, DM, DM}; pg8::StaticOrder S; S.init(MP, DM, G, bx); pg8::EpiGate E{SA, nullptr};
          stagger(bx);
          pg8::gemm_phase<pg8::EpiGate, pg8::StaticOrder, MK_ALIGN, MK_SP2>(lds, g, S, E); }
        { SEpiGate SE{SC, SA}; sample_gemm(lds, BG, Wl + E_WOC, DM, DM / 64, SE, bx, G);
          pg8::Gemm g{BG, Wl + E_WOC, MP, DM, DM}; pg8::StaticOrder S; S.init(MP, DM, G, bx); pg8::EpiGate E{SC, SA};
          stagger(bx);
          pg8::gemm_phase<pg8::EpiGate, pg8::StaticOrder, MK_ALIGN, MK_SP2>(lds, g, S, E); }
#endif
        xcd_barrier(bar);
        if (MK_DUP & 8) xcd_barrier(bar);
#if !(MK_SKIP & 64)
        { SEpiResid SE{XB, ss + (size_t)(3 * l + 2) * MT * 16, 1.0f}; sample_gemm(lds, SC, Wl + E_WO, DM, DM / 64, SE, bx, G);
          pg8::Gemm g{SC, Wl + E_WO, MP, DM, DM}; pg8::StaticOrder S; S.init(MP, DM, G, bx, MK_REV);
          pg8::EpiResid E{XB, ss + (size_t)(3 * l + 2) * MT * 16, 1.0f};
          stagger(bx);
          pg8::gemm_phase<pg8::EpiResid, pg8::StaticOrder, MK_ALIGN, MK_SP2>(lds, g, S, E); }
#endif
        xcd_barrier(bar);
        if (MK_DUP & 8) xcd_barrier(bar);
#if !(MK_SKIP & 128)
        { SEpiSwiGLU SE{H, ss + (size_t)(3 * l + 2) * MT * 16}; sample_gemm(lds, XB, Wl + E_W2GU, DM, DFF / 32, SE, bx, G);
          pg8::Gemm g{XB, Wl + E_W2GU, MP, 2 * DFF, DM}; pg8::StaticOrder S; S.init(MP, 2 * DFF, G, bx); pg8::EpiSwiGLU E{H, ss + (size_t)(3 * l + 2) * MT * 16, (LAS float*)(lds + 131072 + 1024)};
          stagger(bx);
          pg8::gemm_phase<pg8::EpiSwiGLU, pg8::StaticOrder, MK_ALIGN, MK_SP2>(lds, g, S, E); }
#endif
        xcd_barrier(bar);
        if (MK_DUP & 8) xcd_barrier(bar);
#if !(MK_SKIP & 256)
        { SEpiResid SE{XB, ss + (size_t)(3 * l + 3) * MT * 16, 0.5f}; sample_gemm(lds, H, Wl + E_W2D, DFF, DM / 64, SE, bx, G);
          pg8::Gemm g{H, Wl + E_W2D, MP, DM, DFF}; pg8::StaticOrder S; S.init(MP, DM, G, bx, MK_REV);
          pg8::EpiResid E{XB, ss + (size_t)(3 * l + 3) * MT * 16, 0.5f};
          stagger(bx);
          pg8::gemm_phase<pg8::EpiResid, pg8::StaticOrder, MK_ALIGN, MK_SP2>(lds, g, S, E); }
#endif
        xcd_barrier(bar);
        if (MK_DUP & 8) xcd_barrier(bar);
    }
    { const int tid = opaque_tid(), lane = tid & 63, wave = __builtin_amdgcn_readfirstlane(tid >> 6);
      const int gw = bx * NWAVES + wave, NGW = G * NWAVES; const float* ssf = ss + (size_t)6 * MT * 16;
      f32x4 gv[4];
#pragma unroll
      for (int j = 0; j < 4; ++j) gv[j] = ((const f32x4*)inp(21))[lane + 64 * j];
      for (int m2 = gw; m2 < MT / 2; m2 += NGW) {
          uint2 w[2][4]; float rs[2];
#pragma unroll
          for (int r = 0; r < 2; ++r) { const int m = 2 * m2 + r; rs[r] = pg8::row_rs(ssf, m); const uint2* xr = (const uint2*)(XB + (size_t)m * DM);
#pragma unroll
              for (int j = 0; j < 4; ++j) w[r][j] = xr[lane + 64 * j]; }
#pragma unroll
          for (int r = 0; r < 2; ++r) { f32x4* yr = (f32x4*)(xout + (size_t)(2 * m2 + r) * DM);
#pragma unroll
              for (int j = 0; j < 4; ++j) { const f32x4 v = (f32x4){bflo(w[r][j].x), bfhi(w[r][j].x), bflo(w[r][j].y), bfhi(w[r][j].y)}; yr[lane + 64 * j] = v * rs[r] * gv[j]; } } } }
}

#undef ws
#undef ss
#undef XB
#undef H
#undef Q
#undef BG
#undef U
#undef SA
#undef SC
#undef KV
#undef xout
extern "C" void kernel_launch(void* const* d_in, const int* in_sizes, int n_in, void* d_out, int out_size, void* d_ws, size_t ws_size, hipStream_t stream) {
    static int grid = 0;
    if (grid == 0) {
        if (n_in != 22 || in_sizes[0] != MP * DM || (size_t)out_size != O_END || ws_size < WS_SS + (size_t)7 * MT * 64) { fprintf(stderr, "kernel_launch: unexpected shapes (n_in %d, in0 %d, out %d, ws %zu)\n", n_in, n_in > 0 ? in_sizes[0] : -1, out_size, ws_size); grid = -1; return; }
        int dev = 0, cus = 0, per_cu = 0;
        hipGetDevice(&dev); hipDeviceGetAttribute(&cus, hipDeviceAttributeMultiprocessorCount, dev);
        if (hipFuncSetAttribute((const void*)fwd_megakernel, hipFuncAttributeMaxDynamicSharedMemorySize, LDS_BYTES) != hipSuccess) { fprintf(stderr, "kernel_launch: hipFuncSetAttribute failed\n"); grid = -1; return; }
        if (hipOccupancyMaxActiveBlocksPerMultiprocessor(&per_cu, (const void*)fwd_megakernel, NTHR, LDS_BYTES) != hipSuccess || per_cu < 1) { fprintf(stderr, "kernel_launch: occupancy query says %d\n", per_cu); per_cu = 1; }
        (void)hipGetLastError();
        grid = cus;
    }
    if (grid < 0) return;
    Args a{};
    a.x_prompt = (const float*)d_in[0]; a.x_sample = (const float*)d_in[1]; a.cache_k = (const float*)d_in[2]; a.cache_v = (const float*)d_in[3]; a.state_conv = (const float*)d_in[4];
    a.norm_ffn1 = (const float*)d_in[5]; a.w1_gate = (const float*)d_in[6]; a.w1_up = (const float*)d_in[7]; a.w1_down = (const float*)d_in[8];
    a.norm_mix = (const float*)d_in[9]; a.w_in = (const float*)d_in[10]; a.b_in = (const float*)d_in[11]; a.sinks = (const float*)d_in[12]; a.conv_w = (const float*)d_in[13];
    a.w_o_attn = (const float*)d_in[14]; a.w_o_conv = (const float*)d_in[15]; a.w_o = (const float*)d_in[16];
    a.norm_ffn2 = (const float*)d_in[17]; a.w2_gate = (const float*)d_in[18]; a.w2_up = (const float*)d_in[19]; a.w2_down = (const float*)d_in[20]; a.norm_final = (const float*)d_in[21];
    a.out = (float*)d_out; a.ws = (unsigned char*)d_ws;
    void* args[] = {&a};
    hipError_t e = hipLaunchCooperativeKernel((const void*)fwd_megakernel, dim3(grid), dim3(NTHR), args, LDS_BYTES, stream);
    if (e != hipSuccess) fprintf(stderr, "kernel_launch: cooperative launch failed: %s (grid %d)\n", hipGetErrorString(e), grid);
}
```

```cpp
#include <hip/hip_runtime.h>
#include <hip/hip_cooperative_groups.h>
#include <cstdio>
#include <cstdint>
namespace cg = cooperative_groups;

constexpr int DM = 1024, DFF = 2816, NIN = 6400;
constexpr int NB = 8, SEQ = 8192, SBAT = 16, SSEQ = 32;
constexpr int MP = NB * SEQ, MS = SBAT * SSEQ, MT = MP + MS;
constexpr float EPS = 1e-6f, LOG2E = 1.4426950408889634f;
constexpr float QSCALE = 0.125f * LOG2E;

typedef float f32x2_t __attribute__((ext_vector_type(2)));
typedef __bf16 bf16x2_t __attribute__((ext_vector_type(2)));
__device__ __forceinline__ unsigned cvtpk(float lo, float hi) { f32x2_t v = {lo, hi}; bf16x2_t b = __builtin_convertvector(v, bf16x2_t); return __builtin_bit_cast(unsigned, b); }
__device__ __forceinline__ float bflo(unsigned w) { return __uint_as_float(w << 16); }
__device__ __forceinline__ float bfhi(unsigned w) { return __uint_as_float(w & 0xffff0000u); }
__device__ __forceinline__ float sig_scaled(float zs) { return __builtin_amdgcn_rcpf(1.0f + __builtin_amdgcn_exp2f(zs)); }
__device__ __forceinline__ float fast_sigmoid(float z) { return __builtin_amdgcn_rcpf(1.0f + __builtin_amdgcn_exp2f(-z * LOG2E)); }

namespace pg8 {
#define PG8_LAS __attribute__((address_space(3)))
typedef unsigned short bf16_t;
typedef short bf16x8 __attribute__((ext_vector_type(8)));
typedef float f32x4 __attribute__((ext_vector_type(4)));
typedef unsigned u32x4 __attribute__((ext_vector_type(4)));
constexpr int BM = 256, BK = 64, HALF = 128, HTB = HALF * BK * 2  , STAGE_BYTES = 8 * HTB, NXCD = 8, WGM = 8;

__host__ __device__ __forceinline__ int lds_byte(int r, int c) { const int st = (r >> 4) * 2 + (c >> 5), rr = r & 15, cc = c & 31, ob = rr * 64 + cc * 2; return st * 1024 + (ob ^ (((ob >> 9) & 1) << 5)); }
__host__ __device__ __forceinline__ void stage_rc(int b, int& R, int& C) { const int st = b / 1024, sb = b % 1024, swz = sb ^ (((sb >> 9) & 1) << 5); R = (st >> 1) * 16 + swz / 64; C = (st & 1) * 32 + (swz % 64) / 2; }
__host__ __device__ __forceinline__ int perm32(int rho) { const int n = rho >> 4, i = rho & 15; return 8 * (i >> 2) + 4 * n + (i & 3); }

struct Unit { int pm, pn; };
struct Gemm { const bf16_t* A; const bf16_t* Bt; int M, N, K; };

struct StaticOrder {
    int nM, nN, nwg, G, c, rev;
    __host__ __device__ void init(int M, int N, int G_, int c_, int rev_ = 0) { nM = M / BM; nN = N / BM; nwg = nM * nN; G = G_; c = c_; rev = rev_; }
    __host__ __device__ bool next(int i, Unit& u) const {
        const long L = (long)i * G + c; if (L >= nwg) return false;
        int wgid = (int)L; { const int q = nwg / NXCD, r = nwg % NXCD, xcd = wgid % NXCD, off = wgid / NXCD; wgid = (xcd < r ? xcd * (q + 1) : r * (q + 1) + (xcd - r) * q) + off; }
        const int nig = WGM * nN, gid = wgid / nig, fm = gid * WGM, gsz = (nM - fm) < WGM ? (nM - fm) : WGM;
        u.pm = fm + ((wgid % nig) % gsz); u.pn = (wgid % nig) / gsz; if (rev) u.pm = nM - 1 - u.pm; return true;
    }
    __device__ __forceinline__ void a_ready(const Unit&) const {}
    __device__ __forceinline__ void done(const Unit&) const {}
};

__device__ __forceinline__ float row_rs(const float* ss, int row) { const f32x4* p = (const f32x4*)(ss + (size_t)row * 16); const f32x4 a = p[0], b = p[1], c = p[2], d = p[3];
    const float s = ((a[0] + a[1]) + (a[2] + a[3])) + ((b[0] + b[1]) + (b[2] + b[3])) + ((c[0] + c[1]) + (c[2] + c[3])) + ((d[0] + d[1]) + (d[2] + d[3]));
    return __builtin_amdgcn_rsqf(s * (1.0f / 1024.0f) + EPS); }

__device__ __forceinline__ void wave_rs_table(PG8_LAS float* tab, const float* ss, int row_base, int lane) {
    f32x4 pv[2][4];
#pragma unroll
    for (int h = 0; h < 2; ++h) { const int j = lane + 64 * h; const f32x4* p = (const f32x4*)(ss + (size_t)(row_base + (j >> 6) * HALF + (j & 63)) * 16);
#pragma unroll
        for (int q = 0; q < 4; ++q) pv[h][q] = p[q]; }
#pragma unroll
    for (int h = 0; h < 2; ++h) { const f32x4 a = pv[h][0], b = pv[h][1], c = pv[h][2], d = pv[h][3];
        const float s = ((a[0] + a[1]) + (a[2] + a[3])) + ((b[0] + b[1]) + (b[2] + b[3])) + ((c[0] + c[1]) + (c[2] + c[3])) + ((d[0] + d[1]) + (d[2] + d[3]));
        tab[lane + 64 * h] = __builtin_amdgcn_rsqf(s * (1.0f / 1024.0f) + EPS); }
    asm volatile("s_waitcnt lgkmcnt(0)" ::: "memory"); __builtin_amdgcn_wave_barrier(); asm volatile("" ::: "memory");
}

struct EpiSwiGLU {
    static constexpr bool PERM = true, AFTER_DRAIN = false;
    static __device__ __forceinline__ int store_class(const Unit&) { return 0; }
    static constexpr int RELAX = 6;
    bf16_t* H; const float* ss; PG8_LAS float* tabs;
    __device__ __forceinline__ void operator()(const f32x4 (&acc)[2][2][4][2], const Unit& u, int wr, int wc, int fr, int fq) const {
        const int row0 = u.pm * BM + wr * 64 + fr, col0 = u.pn * 128 + wc * 32 + 8 * fq;
        PG8_LAS float* tab = tabs + (wr * 4 + wc) * 128; wave_rs_table(tab, ss, u.pm * BM + wr * 64, fq * 16 + fr);
#pragma unroll
        for (int ai = 0; ai < 2; ++ai)
#pragma unroll
            for (int m = 0; m < 4; ++m) {
                const int row = row0 + ai * HALF + m * 16; const float rs = tab[ai * 64 + m * 16 + fr];
                float h[8];
#pragma unroll
                for (int n = 0; n < 2; ++n)
#pragma unroll
                    for (int e = 0; e < 4; ++e) { const float g = acc[ai][0][m][n][e] * rs, up = acc[ai][1][m][n][e] * rs; h[n * 4 + e] = g * fast_sigmoid(g) * up; }
                u32x4 w; w.x = cvtpk(h[0], h[1]); w.y = cvtpk(h[2], h[3]); w.z = cvtpk(h[4], h[5]); w.w = cvtpk(h[6], h[7]);
                *(u32x4*)(H + (size_t)row * DFF + col0) = w;
            }
    }
};

struct EpiResid {
    static constexpr bool PERM = true, AFTER_DRAIN = false;
    static __device__ __forceinline__ int store_class(const Unit&) { return 0; }
    static constexpr int RELAX = 22;
    bf16_t* xb; float* ssn; float scale;
    __device__ __forceinline__ void operator()(const f32x4 (&acc)[2][2][4][2], const Unit& u, int wr, int wc, int fr, int fq) const {
        const int row0 = u.pm * BM + wr * 64 + fr, col0 = u.pn * BM + wc * 32 + 8 * fq;
#pragma unroll
        for (int ai = 0; ai < 2; ++ai) {
            u32x4 gl[4][2];
#pragma unroll
            for (int m = 0; m < 4; ++m) { const bf16_t* xr = xb + (size_t)(row0 + ai * HALF + m * 16) * DM + col0; gl[m][0] = *(const u32x4*)xr; gl[m][1] = *(const u32x4*)(xr + HALF); }
#pragma unroll
            for (int m = 0; m < 4; ++m) {
                const int row = row0 + ai * HALF + m * 16;
                bf16_t* xr = xb + (size_t)row * DM + col0;
                const u32x4 g0 = gl[m][0], g1 = gl[m][1];
                float sq = 0.f;
#pragma unroll
                for (int bj = 0; bj < 2; ++bj) {
                    const u32x4 g = bj ? g1 : g0; const f32x4 p0 = acc[ai][bj][m][0], p1 = acc[ai][bj][m][1];
                    const float o0 = bflo(g.x) + scale * p0[0], o1 = bfhi(g.x) + scale * p0[1], o2 = bflo(g.y) + scale * p0[2], o3 = bfhi(g.y) + scale * p0[3];
                    const float o4 = bflo(g.z) + scale * p1[0], o5 = bfhi(g.z) + scale * p1[1], o6 = bflo(g.w) + scale * p1[2], o7 = bfhi(g.w) + scale * p1[3];
                    u32x4 w; w.x = cvtpk(o0, o1); w.y = cvtpk(o2, o3); w.z = cvtpk(o4, o5); w.w = cvtpk(o6, o7);
                    *(u32x4*)(xr + bj * HALF) = w;
                    sq += (o0 * o0 + o1 * o1) + (o2 * o2 + o3 * o3) + (o4 * o4 + o5 * o5) + (o6 * o6 + o7 * o7);
                }
                sq += __shfl_xor(sq, 16); sq += __shfl_xor(sq, 32);
                if (fq == 0) ssn[(size_t)row * 16 + u.pn * 4 + wc] = sq;
            }
        }
    }
};

struct EpiMixIn {
    static constexpr bool PERM = true, AFTER_DRAIN = false;
    static __device__ __forceinline__ int store_class(const Unit&) { return 0; }
    static constexpr int RELAX = 6;
    const float* ss; const bf16_t* bias16; bf16_t *Q, *KV, *BG, *U, *SA, *SC; PG8_LAS float* tabs;
    __device__ __forceinline__ void operator()(const f32x4 (&acc)[2][2][4][2], const Unit& u, int wr, int wc, int fr, int fq) const {
        PG8_LAS float* tab = tabs + (wr * 4 + wc) * 128; wave_rs_table(tab, ss, u.pm * BM + wr * 64, fq * 16 + fr);
        const int pn = u.pn; bf16_t* dst; int ld, cbase, mode; float sc = 1.f;
        if (pn < 4) { dst = Q; ld = DM; cbase = pn * 256; mode = 0; }
        else if (pn == 4) { dst = KV; ld = 256; cbase = 0; mode = 0; }
        else if (pn < 9) { dst = BG; ld = DM; cbase = (pn - 5) * 256; mode = 0; }
        else if (pn < 17) { dst = U; ld = DM; cbase = (pn - 9) * 128; mode = 2; }
        else if (pn < 21) { dst = SA; ld = DM; cbase = (pn - 17) * 256; mode = 1; }
        else { dst = SC; ld = DM; cbase = (pn - 21) * 256; mode = 1; }
        const int row0 = u.pm * BM + wr * 64 + fr, cw = wc * 32 + 8 * fq;
        u32x4 bw[2];
#pragma unroll
        for (int bj = 0; bj < 2; ++bj) bw[bj] = *(const u32x4*)(bias16 + pn * 256 + bj * HALF + cw);
#define BV(bj, n) ((n) == 0 ? (f32x4){bflo(bw[bj].x), bfhi(bw[bj].x), bflo(bw[bj].y), bfhi(bw[bj].y)} : (f32x4){bflo(bw[bj].z), bfhi(bw[bj].z), bflo(bw[bj].w), bfhi(bw[bj].w)})
#pragma unroll
        for (int ai = 0; ai < 2; ++ai)
#pragma unroll
            for (int m = 0; m < 4; ++m) {
                const int row = row0 + ai * HALF + m * 16; const float rs = tab[ai * 64 + m * 16 + fr];
                bf16_t* rowp = dst + (size_t)row * ld + cbase + cw;
                if (mode == 2) {
                    const f32x4 z0 = (acc[ai][0][m][0] * rs + BV(0, 0)) * (acc[ai][1][m][0] * rs + BV(1, 0));
                    const f32x4 z1 = (acc[ai][0][m][1] * rs + BV(0, 1)) * (acc[ai][1][m][1] * rs + BV(1, 1));
                    u32x4 w; w.x = cvtpk(z0[0], z0[1]); w.y = cvtpk(z0[2], z0[3]); w.z = cvtpk(z1[0], z1[1]); w.w = cvtpk(z1[2], z1[3]);
                    *(u32x4*)rowp = w;
                } else {
#pragma unroll
                    for (int bj = 0; bj < 2; ++bj) {
                        f32x4 z0 = acc[ai][bj][m][0] * rs + BV(bj, 0), z1 = acc[ai][bj][m][1] * rs + BV(bj, 1);
                        if (mode == 1) {
#pragma unroll
                            for (int e = 0; e < 4; ++e) { z0[e] = sig_scaled(z0[e]); z1[e] = sig_scaled(z1[e]); }
                        }
                        u32x4 w; w.x = cvtpk(z0[0], z0[1]); w.y = cvtpk(z0[2], z0[3]); w.z = cvtpk(z1[0], z1[1]); w.w = cvtpk(z1[2], z1[3]);
                        *(u32x4*)(rowp + bj * HALF) = w;
                    }
                }
            }
    }
};

#undef BV
struct EpiGate {
    static constexpr bool PERM = true, AFTER_DRAIN = false;
    static __device__ __forceinline__ int store_class(const Unit&) { return 0; }
    static constexpr int RELAX = 14;
    bf16_t* G; const bf16_t* ADD;
    __device__ __forceinline__ void operator()(const f32x4 (&acc)[2][2][4][2], const Unit& u, int wr, int wc, int fr, int fq) const {
        const int row0 = u.pm * BM + wr * 64 + fr, col0 = u.pn * BM + wc * 32 + 8 * fq;
#pragma unroll
        for (int ai = 0; ai < 2; ++ai)
#pragma unroll
          for (int mp = 0; mp < 2; ++mp) {
            u32x4 gl[2][2], al[2][2];
#pragma unroll
            for (int mm = 0; mm < 2; ++mm)
#pragma unroll
                for (int bj = 0; bj < 2; ++bj) { const size_t idx = (size_t)(row0 + ai * HALF + (2 * mp + mm) * 16) * DM + col0 + bj * HALF;
                    gl[mm][bj] = *(const u32x4*)(G + idx); al[mm][bj] = (u32x4){0u, 0u, 0u, 0u}; if (ADD) al[mm][bj] = *(const u32x4*)(ADD + idx); }
#pragma unroll
            for (int mm = 0; mm < 2; ++mm) {
                const int m = 2 * mp + mm;
                const int row = row0 + ai * HALF + m * 16;
#pragma unroll
                for (int bj = 0; bj < 2; ++bj) {
                    const size_t idx = (size_t)row * DM + col0 + bj * HALF;
                    const u32x4 g = gl[mm][bj];
                    const u32x4 a = al[mm][bj];
                    const f32x4 p0 = acc[ai][bj][m][0], p1 = acc[ai][bj][m][1];
                    u32x4 w;
                    w.x = cvtpk(bflo(a.x) + bflo(g.x) * p0[0], bfhi(a.x) + bfhi(g.x) * p0[1]);
                    w.y = cvtpk(bflo(a.y) + bflo(g.y) * p0[2], bfhi(a.y) + bfhi(g.y) * p0[3]);
                    w.z = cvtpk(bflo(a.z) + bflo(g.z) * p1[0], bfhi(a.z) + bfhi(g.z) * p1[1]);
                    w.w = cvtpk(bflo(a.w) + bflo(g.w) * p1[2], bfhi(a.w) + bfhi(g.w) * p1[3]);
                    *(u32x4*)(G + idx) = w;
                }
            }
          }
    }
};

template <class Epi, class Sched, bool ALIGN_EPI = false, bool SP2 = false>
__device__ __forceinline__ void gemm_phase(PG8_LAS unsigned char* lds, const Gemm g, const Sched& S, const Epi& E) {
    int tid_ = threadIdx.x; asm volatile("" : "+v"(tid_));
    const int tid = tid_, wid = __builtin_amdgcn_readfirstlane(tid >> 6), lane = tid & 63, wr = wid >> 2, wc = wid & 3, fr = lane & 15, fq = lane >> 4;
    const int K = g.K, nt = K / BK;
    unsigned voffA[2], voffB[2];
#pragma unroll
    for (int i = 0; i < 2; ++i) { int R, C; stage_rc(tid * 16 + i * 8192, R, C); const int Rb = Epi::PERM ? ((R & ~31) + perm32(R & 31)) : R;
        voffA[i] = (unsigned)(R * K + C) * 2u; voffB[i] = (unsigned)(Rb * K + C) * 2u; }
    const size_t kstep = (size_t)(BK * 2);
    const size_t hstep = (size_t)HALF * K * 2;
    const size_t tstep = 2 * hstep;
    const unsigned ldsw = (unsigned)wid * 1024u;
    const int aoff = lds_byte(wr * 64 + fr, fq * 8), boff = lds_byte(wc * 32 + fr, fq * 8);
#define PG8_SA(b, h) (((b) * 2 + (h)) * HTB)
#define PG8_SB(b, h) ((4 + (b) * 2 + (h)) * HTB)
    const unsigned ldsb = (unsigned)__builtin_amdgcn_readfirstlane((int)((unsigned)(unsigned long long)(__attribute__((address_space(3))) unsigned char*)lds + ldsw));
#define PG8_GLDS(vo, sbase, off) asm volatile("s_add_u32 m0, %2, %3\n\ts_nop 0\n\tglobal_load_lds_dwordx4 %0, %1" :: "v"(vo), "s"(sbase), "s"(ldsb), "i"(off) : "memory", "m0", "scc")
#define PG8_STAGE(bufoff, gbase, voff) do { PG8_GLDS((voff)[0], (const char*)(gbase), (bufoff)); PG8_GLDS((voff)[1], (const char*)(gbase), (bufoff) + 8192); } while (0)
#define PG8_LDA(dst, b, h) do { _Pragma("unroll") for (int m = 0; m < 4; ++m) _Pragma("unroll") for (int k = 0; k < 2; ++k) dst[m][k] = *(const PG8_LAS bf16x8*)(lds + PG8_SA(b, h) + aoff + m * 2048 + k * 1024); } while (0)
#define PG8_LDB(dst, b, h) do { _Pragma("unroll") for (int n = 0; n < 2; ++n) _Pragma("unroll") for (int k = 0; k < 2; ++k) dst[n][k] = *(const PG8_LAS bf16x8*)(lds + PG8_SB(b, h) + boff + n * 2048 + k * 1024); } while (0)
#define PG8_MMA(ai, bj, At, Bt) do { __builtin_amdgcn_s_setprio(1); _Pragma("unroll") for (int m = 0; m < 4; ++m) _Pragma("unroll") for (int n = 0; n < 2; ++n) _Pragma("unroll") for (int k = 0; k < 2; ++k) \
        acc[ai][bj][m][n] = __builtin_amdgcn_mfma_f32_16x16x32_bf16(Bt[n][k], At[m][k], acc[ai][bj][m][n], 0, 0, 0); __builtin_amdgcn_s_setprio(0); } while (0)
#define PG8_WAIT_V(n) asm volatile("s_waitcnt vmcnt(" #n ")" ::: "memory")
#define PG8_WAIT_VX(rx) PG8_WAIT_V(8)
#define PG8_WAIT_L(n) asm volatile("s_waitcnt lgkmcnt(" #n ")" ::: "memory")
#define PG8_BAR __builtin_amdgcn_s_barrier()
#define PG8_SCHED __builtin_amdgcn_sched_barrier(0)
    Unit cur, nxt; int ui = 0; int rcls = 0;
    if (!S.next(0, cur)) return;
    f32x4 acc[2][2][4][2];
#pragma unroll
    for (int a = 0; a < 2; ++a)
#pragma unroll
        for (int b = 0; b < 2; ++b)
#pragma unroll
            for (int m = 0; m < 4; ++m)
#pragma unroll
                for (int n = 0; n < 2; ++n) acc[a][b][m][n] = (f32x4){0.f, 0.f, 0.f, 0.f};
    bf16x8 At[4][2], B0[2][2], B1[2][2];
    const char* cA = (const char*)g.A + (size_t)cur.pm * tstep; const char* cB = (const char*)g.Bt + (size_t)cur.pn * tstep;
    S.a_ready(cur);
    if constexpr (SP2) {
        PG8_STAGE(PG8_SB(0, 0), cB, voffB); PG8_STAGE(PG8_SB(0, 1), cB + hstep, voffB); PG8_STAGE(PG8_SA(0, 0), cA, voffA); PG8_STAGE(PG8_SA(0, 1), cA + hstep, voffA);
        if (wr == 1) PG8_BAR;
        PG8_WAIT_V(2); PG8_BAR;
        PG8_STAGE(PG8_SB(1, 0), cB + kstep, voffB); PG8_STAGE(PG8_SA(1, 0), cA + kstep, voffA); PG8_STAGE(PG8_SB(1, 1), cB + hstep + kstep, voffB);
        PG8_WAIT_V(6); PG8_BAR;
    } else {
        PG8_STAGE(PG8_SB(0, 0), cB, voffB); PG8_STAGE(PG8_SA(0, 0), cA, voffA); PG8_STAGE(PG8_SB(0, 1), cB + hstep, voffB); PG8_STAGE(PG8_SA(0, 1), cA + hstep, voffA);
        if (wr == 1) PG8_BAR;
        PG8_WAIT_V(4); PG8_BAR;
        PG8_STAGE(PG8_SB(1, 0), cB + kstep, voffB); PG8_STAGE(PG8_SA(1, 0), cA + kstep, voffA); PG8_STAGE(PG8_SB(1, 1), cB + hstep + kstep, voffB);
        PG8_WAIT_V(6); PG8_BAR;
    }
    for (;;) {
        const bool has_next = S.next(ui + 1, nxt);
        const char* nA = has_next ? (const char*)g.A + (size_t)nxt.pm * tstep : cA; const char* nB = has_next ? (const char*)g.Bt + (size_t)nxt.pn * tstep : cB;
        for (int t = 0; t < nt; t += 2) {
            const bool last = (t == nt - 2);
            const char* a1 = cA + (size_t)(t + 1) * kstep;
            const char* a2 = last ? nA : cA + (size_t)(t + 2) * kstep; const char* b2 = last ? nB : cB + (size_t)(t + 2) * kstep;
            const char* a3 = a2 + kstep; const char* b3 = b2 + kstep;
            if (last && has_next) S.a_ready(nxt);
            if constexpr (SP2) {
            const int rx = (t == 0) ? rcls : 0;
            PG8_LDB(B0, 0, 0); PG8_LDB(B1, 0, 1); PG8_SCHED; PG8_LDA(At, 0, 0); PG8_STAGE(PG8_SA(1, 1), a1 + hstep, voffA);
            PG8_WAIT_VX(rx); PG8_WAIT_L(0); PG8_BAR; PG8_MMA(0, 0, At, B0); PG8_MMA(0, 1, At, B1); PG8_BAR; PG8_SCHED;
            PG8_LDA(At, 0, 1); PG8_STAGE(PG8_SB(0, 0), b2, voffB); PG8_STAGE(PG8_SB(0, 1), b2 + hstep, voffB); PG8_STAGE(PG8_SA(0, 0), a2, voffA);
            PG8_WAIT_VX(rx); PG8_WAIT_L(0); PG8_BAR; PG8_MMA(1, 0, At, B0); PG8_MMA(1, 1, At, B1); PG8_BAR; PG8_SCHED;
            PG8_LDB(B0, 1, 0); PG8_LDB(B1, 1, 1); PG8_SCHED; PG8_LDA(At, 1, 0); PG8_STAGE(PG8_SA(0, 1), a2 + hstep, voffA);
            PG8_WAIT_V(8); PG8_WAIT_L(0); PG8_BAR; PG8_MMA(0, 0, At, B0); PG8_MMA(0, 1, At, B1); PG8_BAR; PG8_SCHED;
            PG8_LDA(At, 1, 1); PG8_STAGE(PG8_SB(1, 0), b3, voffB); PG8_STAGE(PG8_SB(1, 1), b3 + hstep, voffB); PG8_STAGE(PG8_SA(1, 0), a3, voffA);
            PG8_WAIT_V(8); PG8_WAIT_L(0); PG8_BAR; PG8_MMA(1, 0, At, B0); PG8_MMA(1, 1, At, B1); PG8_BAR; PG8_SCHED;
            } else {
            PG8_LDB(B0, 0, 0); PG8_SCHED; PG8_LDA(At, 0, 0); PG8_STAGE(PG8_SA(1, 1), a1 + hstep, voffA);
            PG8_WAIT_L(8); PG8_BAR; PG8_WAIT_L(0); PG8_MMA(0, 0, At, B0); PG8_BAR; PG8_SCHED;
            PG8_LDB(B1, 0, 1); PG8_STAGE(PG8_SB(0, 0), b2, voffB);
            PG8_BAR; PG8_WAIT_L(0); PG8_MMA(0, 1, At, B1); PG8_BAR;
            PG8_LDA(At, 0, 1); PG8_STAGE(PG8_SA(0, 0), a2, voffA);
            PG8_BAR; PG8_WAIT_L(0); PG8_MMA(1, 0, At, B0); PG8_BAR; PG8_SCHED;
            PG8_STAGE(PG8_SB(0, 1), b2 + hstep, voffB);
            PG8_WAIT_V(6); PG8_BAR; PG8_MMA(1, 1, At, B1); PG8_BAR;
            PG8_LDB(B0, 1, 0); PG8_SCHED; PG8_LDA(At, 1, 0); PG8_STAGE(PG8_SA(0, 1), a2 + hstep, voffA);
            PG8_WAIT_L(8); PG8_BAR; PG8_WAIT_L(0); PG8_MMA(0, 0, At, B0); PG8_BAR; PG8_SCHED;
            PG8_LDB(B1, 1, 1); PG8_STAGE(PG8_SB(1, 0), b3, voffB);
            PG8_BAR; PG8_WAIT_L(0); PG8_MMA(0, 1, At, B1); PG8_BAR;
            PG8_LDA(At, 1, 1); PG8_STAGE(PG8_SA(1, 0), a3, voffA);
            PG8_BAR; PG8_WAIT_L(0); PG8_MMA(1, 0, At, B0); PG8_BAR; PG8_SCHED;
            PG8_STAGE(PG8_SB(1, 1), b3 + hstep, voffB);
            PG8_WAIT_V(6); PG8_BAR; PG8_MMA(1, 1, At, B1); PG8_BAR;
            }
        }
        if constexpr (ALIGN_EPI) { if (wr == 0) PG8_BAR; }
        if constexpr (!Epi::AFTER_DRAIN) { E(acc, cur, wr, wc, fr, fq); S.done(cur); rcls = 1 + Epi::store_class(cur); }
        if (!has_next) break;
#pragma unroll
        for (int a = 0; a < 2; ++a)
#pragma unroll
            for (int b = 0; b < 2; ++b)
#pragma unroll
                for (int m = 0; m < 4; ++m)
#pragma unroll
                    for (int n = 0; n < 2; ++n) acc[a][b][m][n] = (f32x4){0.f, 0.f, 0.f, 0.f};
        cur = nxt; cA = nA; cB = nB; ++ui;
        if constexpr (ALIGN_EPI) { if (wr == 1) PG8_BAR; }
    }
    PG8_WAIT_V(0);
    if constexpr (!ALIGN_EPI) { if (wr == 0) PG8_BAR; }
    PG8_BAR;
    if constexpr (Epi::AFTER_DRAIN) { E.fused(acc, cur, wr, wc, fr, fq, lds, wid, lane); S.done(cur); }
#undef PG8_SA
#undef PG8_SB
#undef PG8_STAGE
#undef PG8_LDA
#undef PG8_LDB
#undef PG8_MMA
#undef PG8_WAIT_V
#undef PG8_WAIT_VX
#undef PG8_GLDS
#undef PG8_WAIT_L
#undef PG8_BAR
#undef PG8_SCHED
}
}

#define GAS __attribute__((address_space(1)))
#define LAS __attribute__((address_space(3)))
typedef unsigned short bf16;
typedef float f32x4 __attribute__((ext_vector_type(4)));
typedef float f32x16 __attribute__((ext_vector_type(16)));
typedef unsigned u32x4 __attribute__((ext_vector_type(4)));
typedef short bf16x8 __attribute__((ext_vector_type(8)));
typedef short s16x4 __attribute__((ext_vector_type(4)));
constexpr size_t MiB = 1u << 20;
constexpr size_t WS_SS = 960 * MiB;
constexpr size_t WS_BAR = 2 * MiB;
constexpr size_t WS_BIAS = 3 * MiB;
constexpr size_t WS_W = 4 * MiB;
constexpr size_t E_W1GU = 0, E_W1D = E_W1GU + (size_t)2 * DFF * DM, E_WIN = E_W1D + (size_t)DM * DFF, E_WOA = E_WIN + (size_t)NIN * DM, E_WOC = E_WOA + (size_t)DM * DM,
                 E_WO = E_WOC + (size_t)DM * DM, E_W2GU = E_WO + (size_t)DM * DM, E_W2D = E_W2GU + (size_t)2 * DFF * DM, E_LAYER = E_W2D + (size_t)DM * DFF;
constexpr size_t WS_XB = 116 * MiB;
constexpr size_t ACT = (size_t)MT * DM * 2;
constexpr size_t WS_Q = 246 * MiB, WS_BG = WS_Q + ACT, WS_U = WS_BG + ACT, WS_SA = WS_U + ACT, WS_SC = WS_SA + ACT, WS_KV = WS_SC + ACT, WS_END = WS_KV + (size_t)MT * 256 * 2;
constexpr size_t WS_H = WS_Q;
static_assert(WS_W + 2 * E_LAYER * 2 <= WS_XB && WS_XB + ACT <= WS_Q && WS_H + (size_t)MT * DFF * 2 <= WS_SA && WS_END <= WS_SS && WS_SS + (size_t)7 * MT * 64 <= (size_t)1024 * MiB, "d_ws map");
constexpr size_t O_YP = 0, O_YS = (size_t)MP * DM, O_KP = O_YS + (size_t)MS * DM, O_VP = O_KP + 2 * 8 * 128 * 128, O_CP = O_VP + 2 * 8 * 128 * 128, O_KS = O_CP + 2 * 8 * 2 * 1024,
                 O_VS = O_KS + 2 * 16 * 128 * 128, O_CS = O_VS + 2 * 16 * 128 * 128, O_END = O_CS + 2 * 16 * 2 * 1024;

#ifndef MK_SKIP
#define MK_SKIP 0
#endif
#ifndef MK_DUP
#define MK_DUP 0
#endif
constexpr int NWAVES = 8, NTHR = 512;
constexpr int LDS_BYTES = 139264;

struct Args {
    const float* x_prompt; const float* x_sample; const float* cache_k; const float* cache_v; const float* state_conv;
    const float* norm_ffn1; const float* w1_gate; const float* w1_up; const float* w1_down;
    const float* norm_mix; const float* w_in; const float* b_in; const float* sinks; const float* conv_w; const float* w_o_attn; const float* w_o_conv; const float* w_o;
    const float* norm_ffn2; const float* w2_gate; const float* w2_up; const float* w2_down; const float* norm_final;
    float* out; unsigned char* ws;
};

__device__ __forceinline__ const float* inp(int k) { int z = 0; asm volatile("" : "+v"(z)); z = __builtin_amdgcn_readfirstlane(z);
    return ((const float* const __attribute__((address_space(4)))*)__builtin_amdgcn_kernarg_segment_ptr())[k + z]; }
__device__ __forceinline__ float wave_sum(float v) {
#pragma unroll
    for (int o = 1; o < 64; o <<= 1) v += __shfl_xor(v, o);
    return v;
}
#define LDS_WAIT() asm volatile("s_waitcnt lgkmcnt(0)" ::: "memory")

__device__ __forceinline__ void transpose_item(const float* W, int K, int N, const float* gain, bf16* WT, int dst_row0, LAS float* scr, int k0, int n0, int lane, float cs = 1.0f) {
    float v[32];
#pragma unroll
    for (int i = 0; i < 32; ++i) v[i] = W[(size_t)(k0 + 2 * i + (lane >> 5)) * N + n0 + (lane & 31)];
    const int c = lane & 7;
    f32x4 g0 = (f32x4){1.f, 1.f, 1.f, 1.f}, g1 = g0;
    if (gain) { g0 = *(const f32x4*)(gain + k0 + 8 * c); g1 = *(const f32x4*)(gain + k0 + 8 * c + 4); }
    g0 = g0 * cs; g1 = g1 * cs;
#pragma unroll
    for (int i = 0; i < 32; ++i) scr[(2 * i + (lane >> 5)) * 33 + (lane & 31)] = v[i];
    LDS_WAIT(); asm volatile("" ::: "memory");
#pragma unroll
    for (int j = 0; j < 4; ++j) { const int n = (lane >> 3) + 8 * j; const LAS float* s = scr + (8 * c) * 33 + n;
        u32x4 o; o.x = cvtpk(s[0 * 33] * g0[0], s[1 * 33] * g0[1]); o.y = cvtpk(s[2 * 33] * g0[2], s[3 * 33] * g0[3]); o.z = cvtpk(s[4 * 33] * g1[0], s[5 * 33] * g1[1]); o.w = cvtpk(s[6 * 33] * g1[2], s[7 * 33] * g1[3]);
        *(u32x4*)(WT + (size_t)(dst_row0 + n) * K + k0 + 8 * c) = o; }
    LDS_WAIT(); asm volatile("" ::: "memory");
}
__device__ __forceinline__ int win_map(int n) {
    if (n < 2304 || n >= 4352) return n;
    if (n < 3328) { const int f = n - 2304; return 2304 + 256 * (f >> 7) + (f & 127); }
    const int f = n - 3328; return 2304 + 256 * (f >> 7) + 128 + (f & 127);
}
__device__ __forceinline__ int gu_map(int f, int up) { return 256 * (f >> 7) + 128 * up + (f & 127); }

__device__ __forceinline__ void prologue(const Args& a, LAS unsigned char* lds, int tid, int lane, int wave) {
    LAS float* scr = (LAS float*)(lds + wave * 16384);
    const int gw = blockIdx.x * NWAVES + wave, NGW = gridDim.x * NWAVES;
    bf16* Wb = (bf16*)(a.ws + WS_W);
    constexpr int I_G = 16 * 88, I_D = 44 * 32, I_IN = 16 * 200, I_O = 16 * 32, I_LAYER = 6 * I_G + I_IN + 3 * I_O;
    static_assert(I_G == I_D, "item counts");
    for (int it = gw; it < 2 * I_LAYER; it += NGW) {
        const int l = it / I_LAYER; int r = it - l * I_LAYER; bf16* Wl = Wb + (size_t)l * E_LAYER;
        if (r < 2 * I_G) { const int up = r >= I_G; if (up) r -= I_G; const int kb = r / 88, nb = r % 88;
            transpose_item((up ? inp(7) : inp(6)) + (size_t)l * DM * DFF, DM, DFF, inp(5) + l * DM, Wl + E_W1GU, gu_map(nb * 32, up), scr, kb * 64, nb * 32, lane); continue; } r -= 2 * I_G;
        if (r < I_D) { const int kb = r / 32, nb = r % 32; transpose_item(inp(8) + (size_t)l * DFF * DM, DFF, DM, nullptr, Wl + E_W1D, nb * 32, scr, kb * 64, nb * 32, lane); continue; } r -= I_D;
        if (r < I_IN) { const int kb = r / 200, nb = r % 200; transpose_item(inp(10) + (size_t)l * DM * NIN, DM, NIN, inp(9) + l * DM, Wl + E_WIN, win_map(nb * 32), scr, kb * 64, nb * 32, lane, nb * 32 < 1024 ? QSCALE : (nb * 32 >= 4352 ? -LOG2E : 1.0f)); continue; } r -= I_IN;
        if (r < 3 * I_O) { const int w = r / I_O; r -= w * I_O; const int kb = r / 32, nb = r % 32; const float* src = (w == 0 ? inp(14) : w == 1 ? inp(15) : inp(16)) + (size_t)l * DM * DM;
            transpose_item(src, DM, DM, nullptr, Wl + (w == 0 ? E_WOA : w == 1 ? E_WOC : E_WO), nb * 32, scr, kb * 64, nb * 32, lane); continue; } r -= 3 * I_O;
        if (r < 2 * I_G) { const int up = r >= I_G; if (up) r -= I_G; const int kb = r / 88, nb = r % 88;
            transpose_item((up ? inp(19) : inp(18)) + (size_t)l * DM * DFF, DM, DFF, inp(17) + l * DM, Wl + E_W2GU, gu_map(nb * 32, up), scr, kb * 64, nb * 32, lane); continue; } r -= 2 * I_G;
        { const int kb = r / 32, nb = r % 32; transpose_item(inp(20) + (size_t)l * DFF * DM, DFF, DM, nullptr, Wl + E_W2D, nb * 32, scr, kb * 64, nb * 32, lane); }
    }
    float* ss = (float*)(a.ws + WS_SS); bf16* XB = (bf16*)(a.ws + WS_XB);
    static_assert(MT % 2 == 0 && MP % 2 == 0, "row pairs");
    for (int m2 = gw; m2 < MT / 2; m2 += NGW) {
        f32x4 v[2][4];
#pragma unroll
        for (int r = 0; r < 2; ++r) { const int m = 2 * m2 + r; const float* xr = (m < MP) ? inp(0) + (size_t)m * DM : inp(1) + (size_t)(m - MP) * DM;
#pragma unroll
            for (int j = 0; j < 4; ++j) v[r][j] = ((const f32x4*)xr)[lane + 64 * j]; }
#pragma unroll
        for (int r = 0; r < 2; ++r) { const int m = 2 * m2 + r; float s = 0.f;
#pragma unroll
            for (int j = 0; j < 4; ++j) s += (v[r][j].x * v[r][j].x + v[r][j].y * v[r][j].y) + (v[r][j].z * v[r][j].z + v[r][j].w * v[r][j].w);
            s = wave_sum(s); if (lane < 16) ss[(size_t)m * 16 + lane] = (lane == 0) ? s : 0.f;
            unsigned long long* o8 = (unsigned long long*)(XB + (size_t)m * DM) + lane;
#pragma unroll
            for (int j = 0; j < 4; ++j) o8[64 * j] = (unsigned long long)cvtpk(v[r][j].x, v[r][j].y) | ((unsigned long long)cvtpk(v[r][j].z, v[r][j].w) << 32); }
    }
    const int gt = blockIdx.x * NTHR + tid, NGT = gridDim.x * NTHR;
    { unsigned* bw = (unsigned*)(a.ws + WS_BAR); for (int i = gt; i < 3456  ; i += NGT) bw[i] = 0u; }
    float* bp = (float*)(a.ws + WS_BIAS);
    bf16* bp16 = (bf16*)(a.ws + WS_BIAS + 65536);
    for (int i = gt; i < 2 * NIN; i += NGT) { const int l = i / NIN, n = i - l * NIN; const float bvl = inp(11)[i] * (n < 1024 ? QSCALE : (n >= 4352 ? -LOG2E : 1.0f)); bp[l * NIN + win_map(n)] = bvl; bp16[l * NIN + win_map(n)] = (bf16)(cvtpk(bvl, 0.f) & 0xffffu); }
}

constexpr int KS_STRIDE = 144, VT_STRIDE = 408;
constexpr int LDS_KS = 0, LDS_VT = 192 * KS_STRIDE, LDS_WSF = LDS_VT + 64 * VT_STRIDE, ATT_LDS = LDS_WSF + NWAVES * 32 * 4;
constexpr int N_ATT_ITEMS = 32 + NB * 128 * 2;
__device__ __forceinline__ int crow(int r, int hi) { return (r & 3) + 8 * (r >> 2) + 4 * hi; }

__device__ __forceinline__ void attn_item(LAS unsigned char* lds, const bf16* QI, bf16* AO, const bf16* KV, const float* ck, const float* cv, const float* sinks, int item, int tid, int lane, int wave) {
    int qrow0, nqb, blo, bhi, h, sb = 0; long kvrow0 = 0; bool sample;
    if (item < 32) { sample = true; sb = item >> 1; h = item & 1; qrow0 = MP + sb * 32; nqb = 1; blo = 0; bhi = 5; }
    else { sample = false; const int it = item - 32; h = it & 1; const int c = (it >> 1) & 127, b = it >> 8; qrow0 = b * SEQ + c * 64; nqb = 2; blo = c >= 2 ? 0 : 2 * (2 - c); bhi = 6; kvrow0 = (long)b * SEQ + (long)(c - 2) * 64; }
    const int r32 = lane & 31, hi = lane >> 5, head = h * 8 + wave;
    const bf16* qbase = QI + (size_t)(qrow0 + r32) * DM + head * 64 + hi * 8;
    bf16x8 qf[4];
#pragma unroll
    for (int d0 = 0; d0 < 4; ++d0) qf[d0] = *(const bf16x8*)(qbase + d0 * 16);
    { const int jb = tid >> 3, dg = tid & 7, tb = tid >> 8;
      u32x4 kx[3], vx[3];
#pragma unroll
      for (int i = 0; i < 3; ++i) { const int j = jb + 64 * i;
          if (tb + 2 * i >= blo && tb + 2 * i < bhi) {
              if (sample && j < 128) {
                  const size_t o = ((size_t)(sb * 128 + j)) * 128 + h * 64 + dg * 8;
                  const f32x4 k0 = *(const f32x4*)(ck + o), k1 = *(const f32x4*)(ck + o + 4), v0 = *(const f32x4*)(cv + o), v1 = *(const f32x4*)(cv + o + 4);
                  kx[i].x = cvtpk(k0[0], k0[1]); kx[i].y = cvtpk(k0[2], k0[3]); kx[i].z = cvtpk(k1[0], k1[1]); kx[i].w = cvtpk(k1[2], k1[3]);
                  vx[i].x = cvtpk(v0[0], v0[1]); vx[i].y = cvtpk(v0[2], v0[3]); vx[i].z = cvtpk(v1[0], v1[1]); vx[i].w = cvtpk(v1[2], v1[3]);
              } else {
                  const long row = sample ? (long)(MP + sb * 32 + (j - 128)) : kvrow0 + j;
                  const bf16* p = KV + (size_t)row * 256 + h * 64 + dg * 8;
                  kx[i] = *(const u32x4*)p; vx[i] = *(const u32x4*)(p + 128);
              }
          }
      }
#pragma unroll
      for (int i = 0; i < 3; ++i) { const int j = jb + 64 * i;
          if (tb + 2 * i >= blo && tb + 2 * i < bhi) {
              *(LAS u32x4*)(lds + LDS_KS + j * KS_STRIDE + dg * 16) = kx[i];
              LAS unsigned short* vt = (LAS unsigned short*)(lds + LDS_VT + (dg * 8) * VT_STRIDE + j * 2); const u32x4 v4 = vx[i];
              vt[0 * (VT_STRIDE / 2)] = (unsigned short)(v4.x & 0xffffu); vt[1 * (VT_STRIDE / 2)] = (unsigned short)(v4.x >> 16);
              vt[2 * (VT_STRIDE / 2)] = (unsigned short)(v4.y & 0xffffu); vt[3 * (VT_STRIDE / 2)] = (unsigned short)(v4.y >> 16);
              vt[4 * (VT_STRIDE / 2)] = (unsigned short)(v4.z & 0xffffu); vt[5 * (VT_STRIDE / 2)] = (unsigned short)(v4.z >> 16);
              vt[6 * (VT_STRIDE / 2)] = (unsigned short)(v4.w & 0xffffu); vt[7 * (VT_STRIDE / 2)] = (unsigned short)(v4.w >> 16);
          }
      } }
    __syncthreads();
    const float sink2 = sinks[head] * LOG2E;
    LAS float* wsf = (LAS float*)(lds + LDS_WSF) + wave * 32;
    for (int qb = 0; qb < nqb; ++qb) {
        f32x16 s[6];
#pragma unroll
        for (int kvb = 0; kvb < 6; ++kvb) {
            if (kvb >= blo && kvb < bhi) {
                f32x16 acc;
#pragma unroll
                for (int i = 0; i < 16; ++i) acc[i] = 0.f;
#pragma unroll
                for (int d0 = 0; d0 < 4; ++d0) { const bf16x8 kf = *(const LAS bf16x8*)(lds + LDS_KS + (kvb * 32 + r32) * KS_STRIDE + d0 * 32 + hi * 16);
                    acc = __builtin_amdgcn_mfma_f32_32x32x16_bf16(kf, qf[d0], acc, 0, 0, 0); }
                s[kvb] = acc;
            } else {
#pragma unroll
                for (int i = 0; i < 16; ++i) s[kvb][i] = -1e30f;
            }
        }
        if (qb + 1 < nqb) {
#pragma unroll
            for (int d0 = 0; d0 < 4; ++d0) qf[d0] = *(const bf16x8*)(qbase + (size_t)32 * DM + d0 * 16);
        }
        float mx = sink2;
#pragma unroll
        for (int kvb = 0; kvb < 6; ++kvb)
#pragma unroll
            for (int i = 0; i < 16; ++i) mx = fmaxf(mx, s[kvb][i]);
        mx = fmaxf(mx, __shfl_xor(mx, 32));
        float sum = 0.f;
#pragma unroll
        for (int kvb = 0; kvb < 6; ++kvb)
#pragma unroll
            for (int i = 0; i < 16; ++i) { const float e = __builtin_amdgcn_exp2f(s[kvb][i] - mx); s[kvb][i] = e; sum += e; }
        sum += __shfl_xor(sum, 32);
        const float l = sum + __builtin_amdgcn_exp2f(sink2 - mx);
        f32x16 o[2];
#pragma unroll
        for (int i = 0; i < 16; ++i) { o[0][i] = 0.f; o[1][i] = 0.f; }
#pragma unroll
        for (int kvb = 0; kvb < 6; ++kvb) {
            if (kvb >= blo && kvb < bhi) {
#pragma unroll
                for (int st = 0; st < 2; ++st) {
                    u32x4 pw; pw.x = cvtpk(s[kvb][8 * st + 0], s[kvb][8 * st + 1]); pw.y = cvtpk(s[kvb][8 * st + 2], s[kvb][8 * st + 3]);
                    pw.z = cvtpk(s[kvb][8 * st + 4], s[kvb][8 * st + 5]); pw.w = cvtpk(s[kvb][8 * st + 6], s[kvb][8 * st + 7]);
                    const bf16x8 pf = __builtin_bit_cast(bf16x8, pw);
#pragma unroll
                    for (int db = 0; db < 2; ++db) {
                        const LAS unsigned char* vp = lds + LDS_VT + (db * 32 + r32) * VT_STRIDE + (kvb * 32 + 16 * st + 4 * hi) * 2;
                        const s16x4 lo = *(const LAS s16x4*)vp, hh = *(const LAS s16x4*)(vp + 16);
                        const bf16x8 vf = __builtin_shufflevector(lo, hh, 0, 1, 2, 3, 4, 5, 6, 7);
                        o[db] = __builtin_amdgcn_mfma_f32_32x32x16_bf16(pf, vf, o[db], 0, 0, 0);
                    }
                }
            }
        }
        if (hi == 0) wsf[r32] = l;
        LDS_WAIT(); __builtin_amdgcn_wave_barrier(); asm volatile("" ::: "memory");
        bf16* op = AO + (size_t)(qrow0 + qb * 32) * DM + head * 64 + r32;
#pragma unroll
        for (int i = 0; i < 16; ++i) {
            const int q = crow(i, hi); const float rl = __builtin_amdgcn_rcpf(wsf[q]);
            const unsigned w0 = cvtpk(o[0][i] * rl, o[1][i] * rl);
            op[(size_t)q * DM] = (unsigned short)(w0 & 0xffffu); op[(size_t)q * DM + 32] = (unsigned short)(w0 >> 16);
        }
        LDS_WAIT(); __builtin_amdgcn_wave_barrier(); asm volatile("" ::: "memory");
    }
    __syncthreads();
}

__device__ __forceinline__ void conv_chunk(bf16* BG, const bf16* U, const float* cw, const float* st  , int chunk, int tid) {
    const int cgp = tid & 127, rsub = tid >> 7, c0 = cgp * 8;
    const int t0 = chunk * 32 + rsub * 8;
    float w[3][8];
#pragma unroll
    for (int j = 0; j < 3; ++j) { const f32x4 a = *(const f32x4*)(cw + j * DM + c0), b = *(const f32x4*)(cw + j * DM + c0 + 4);
#pragma unroll
        for (int e = 0; e < 4; ++e) { w[j][e] = a[e]; w[j][4 + e] = b[e]; } }
    float p2[8], p1[8];
    const int pos = (t0 < MP) ? (t0 & (SEQ - 1)) : ((t0 - MP) & (SSEQ - 1));
    if (pos == 0) {
        if (t0 < MP) {
#pragma unroll
            for (int e = 0; e < 8; ++e) { p2[e] = 0.f; p1[e] = 0.f; }
        } else {
            const float* s0 = st + (size_t)((t0 - MP) / SSEQ) * 2 * DM + c0;
            const f32x4 a = *(const f32x4*)s0, b = *(const f32x4*)(s0 + 4), c = *(const f32x4*)(s0 + DM), d = *(const f32x4*)(s0 + DM + 4);
#pragma unroll
            for (int e = 0; e < 4; ++e) { p2[e] = a[e]; p2[4 + e] = b[e]; p1[e] = c[e]; p1[4 + e] = d[e]; }
        }
    } else {
        const u32x4 a = *(const u32x4*)(U + (size_t)(t0 - 2) * DM + c0), b = *(const u32x4*)(U + (size_t)(t0 - 1) * DM + c0);
        p2[0] = bflo(a.x); p2[1] = bfhi(a.x); p2[2] = bflo(a.y); p2[3] = bfhi(a.y); p2[4] = bflo(a.z); p2[5] = bfhi(a.z); p2[6] = bflo(a.w); p2[7] = bfhi(a.w);
        p1[0] = bflo(b.x); p1[1] = bfhi(b.x); p1[2] = bflo(b.y); p1[3] = bfhi(b.y); p1[4] = bflo(b.z); p1[5] = bfhi(b.z); p1[6] = bflo(b.w); p1[7] = bfhi(b.w);
    }
    u32x4 ur[8], gr[8];
#pragma unroll
    for (int r = 0; r < 8; ++r) { const size_t idx = (size_t)(t0 + r) * DM + c0; ur[r] = *(const u32x4*)(U + idx); gr[r] = *(const u32x4*)(BG + idx); }
#pragma unroll
    for (int r = 0; r < 8; ++r) {
        const size_t idx = (size_t)(t0 + r) * DM + c0;
        const u32x4 uu = ur[r], gg = gr[r];
        float cu[8], g[8], o[8];
        cu[0] = bflo(uu.x); cu[1] = bfhi(uu.x); cu[2] = bflo(uu.y); cu[3] = bfhi(uu.y); cu[4] = bflo(uu.z); cu[5] = bfhi(uu.z); cu[6] = bflo(uu.w); cu[7] = bfhi(uu.w);
        g[0] = bflo(gg.x); g[1] = bfhi(gg.x); g[2] = bflo(gg.y); g[3] = bfhi(gg.y); g[4] = bflo(gg.z); g[5] = bfhi(gg.z); g[6] = bflo(gg.w); g[7] = bfhi(gg.w);
#pragma unroll
        for (int e = 0; e < 8; ++e) { o[e] = g[e] * (w[0][e] * p2[e] + w[1][e] * p1[e] + w[2][e] * cu[e]); p2[e] = p1[e]; p1[e] = cu[e]; }
        u32x4 ww; ww.x = cvtpk(o[0], o[1]); ww.y = cvtpk(o[2], o[3]); ww.z = cvtpk(o[4], o[5]); ww.w = cvtpk(o[6], o[7]);
        *(u32x4*)(BG + idx) = ww;
    }
}

__device__ __forceinline__ f32x4 bf4(const bf16* p) { const uint2 w = *(const uint2*)p; return (f32x4){bflo(w.x), bfhi(w.x), bflo(w.y), bfhi(w.y)}; }
__device__ __forceinline__ void state_copies(const Args& a, int l, const bf16* KV, const bf16* U, int gt, int NGT) {
    constexpr int N_KP = 8 * 128 * 128 / 4, N_CP = 8 * 2 * 1024 / 4, N_KS = 16 * 128 * 128 / 4, N_CS = 16 * 2 * 1024 / 4;
    constexpr int TOT = 2 * N_KP + N_CP + 2 * N_KS + N_CS;
    float* out = a.out;
    for (int i = gt; i < TOT; i += NGT) {
        int r = i;
        if (r < 2 * N_KP) { const int v = r >= N_KP; if (v) r -= N_KP; const int e = r * 4, hd = e & 127, j = (e >> 7) & 127, b = e >> 14;
            *(f32x4*)(out + (v ? O_VP : O_KP) + (size_t)l * 8 * 128 * 128 + e) = bf4(KV + (size_t)(b * SEQ + SEQ - 128 + j) * 256 + v * 128 + hd); continue; } r -= 2 * N_KP;
        if (r < N_CP) { const int e = r * 4, c = e & 1023, ii = (e >> 10) & 1, b = e >> 11;
            *(f32x4*)(out + O_CP + (size_t)l * 8 * 2 * 1024 + e) = bf4(U + (size_t)(b * SEQ + SEQ - 2 + ii) * DM + c); continue; } r -= N_CP;
        if (r < 2 * N_KS) { const int v = r >= N_KS; if (v) r -= N_KS; const int e = r * 4, hd = e & 127, j = (e >> 7) & 127, b = e >> 14;
            f32x4 val;
            if (j < 96) val = *(const f32x4*)((v ? inp(3) : inp(2)) + ((size_t)(l * 16 + b) * 128 + 32 + j) * 128 + hd);
            else val = bf4(KV + (size_t)(MP + b * SSEQ + j - 96) * 256 + v * 128 + hd);
            *(f32x4*)(out + (v ? O_VS : O_KS) + (size_t)l * 16 * 128 * 128 + e) = val; continue; } r -= 2 * N_KS;
        { const int e = r * 4, c = e & 1023, ii = (e >> 10) & 1, b = e >> 11;
            *(f32x4*)(out + O_CS + (size_t)l * 16 * 2 * 1024 + e) = bf4(U + (size_t)(MP + b * SSEQ + SSEQ - 2 + ii) * DM + c); }
    }
}

__device__ __forceinline__ int opaque_tid() { int t = threadIdx.x; asm volatile("" : "+v"(t)); return t; }

typedef float f32x4s __attribute__((ext_vector_type(4)));
__device__ __forceinline__ uint2 pack4(const f32x4s& v) { uint2 w; w.x = cvtpk(v[0], v[1]); w.y = cvtpk(v[2], v[3]); return w; }
__device__ __forceinline__ f32x4s unpack4(const uint2 w) { return (f32x4s){bflo(w.x), bfhi(w.x), bflo(w.y), bfhi(w.y)}; }

struct SEpiSwiGLU {
    bf16* H; const float* ss;
    __device__ __forceinline__ void brows(int sl, int& b0, int& b1) const { b0 = gu_map(32 * sl, 0); b1 = b0 + 128; }
    __device__ __forceinline__ void operator()(const f32x4s& c0, const f32x4s& c1, int row, int sl, int cw, int rit, int wc2, int fq, LAS float* xch) const {
        const float rs = pg8::row_rs(ss, row); f32x4s h;
#pragma unroll
        for (int e = 0; e < 4; ++e) { const float g = c0[e] * rs, u = c1[e] * rs; h[e] = g * fast_sigmoid(g) * u; }
        *(uint2*)(H + (size_t)row * DFF + 32 * sl + cw) = pack4(h);
    }
};
struct SEpiResid {
    bf16* xb; float* ssn; float scale;
    __device__ __forceinline__ void brows(int sl, int& b0, int& b1) const { b0 = 64 * sl; b1 = b0 + 32; }
    __device__ __forceinline__ void operator()(const f32x4s& c0, const f32x4s& c1, int row, int sl, int cw, int rit, int wc2, int fq, LAS float* xch) const {
        bf16* p = xb + (size_t)row * DM + 64 * sl + cw;
        const f32x4s o0 = unpack4(*(const uint2*)p) + c0 * scale, o1 = unpack4(*(const uint2*)(p + 32)) + c1 * scale;
        *(uint2*)p = pack4(o0); *(uint2*)(p + 32) = pack4(o1);
        float sq = (o0[0] * o0[0] + o0[1] * o0[1]) + (o0[2] * o0[2] + o0[3] * o0[3]) + (o1[0] * o1[0] + o1[1] * o1[1]) + (o1[2] * o1[2] + o1[3] * o1[3]);
        sq += __shfl_xor(sq, 16); sq += __shfl_xor(sq, 32);
        if (fq == 0) xch[wc2 * 64 + rit] = sq;
        __syncthreads();
        if (fq == 0 && wc2 == 0) ssn[(size_t)row * 16 + sl] = xch[rit] + xch[64 + rit];
    }
};
struct SEpiMixIn {
    const float* ss; const float* bias; bf16 *Q, *KV, *BG, *U, *SA, *SC;
    __device__ __forceinline__ void brows(int sl, int& b0, int& b1) const {
        if (sl < 36) { b0 = 64 * sl; b1 = b0 + 32; }
        else if (sl < 68) { const int f0 = 32 * (sl - 36); b0 = 2304 + 256 * (f0 >> 7) + (f0 & 127); b1 = b0 + 128; }
        else { b0 = 4352 + 64 * (sl - 68); b1 = b0 + 32; }
    }
    __device__ __forceinline__ void operator()(const f32x4s& c0, const f32x4s& c1, int row, int sl, int cw, int rit, int wc2, int fq, LAS float* xch) const {
        int b0, b1; brows(sl, b0, b1);
        bf16* dst; int ld, cb, mode; float sc = 1.f;
        if (sl < 16) { dst = Q; ld = DM; cb = 64 * sl; mode = 0; }
        else if (sl < 20) { dst = KV; ld = 256; cb = 64 * (sl - 16); mode = 0; }
        else if (sl < 36) { dst = BG; ld = DM; cb = 64 * (sl - 20); mode = 0; }
        else if (sl < 68) { dst = U; ld = DM; cb = 32 * (sl - 36); mode = 2; }
        else if (sl < 84) { dst = SA; ld = DM; cb = 64 * (sl - 68); mode = 1; }
        else { dst = SC; ld = DM; cb = 64 * (sl - 84); mode = 1; }
        const float rs = pg8::row_rs(ss, row);
        f32x4s z0 = c0 * rs + *(const f32x4s*)(bias + b0 + cw), z1 = c1 * rs + *(const f32x4s*)(bias + b1 + cw);
        bf16* p = dst + (size_t)row * ld + cb + cw;
        if (mode == 2) { *(uint2*)p = pack4(z0 * z1); }
        else {
            if (mode == 1) {
#pragma unroll
                for (int e = 0; e < 4; ++e) { z0[e] = sig_scaled(z0[e]); z1[e] = sig_scaled(z1[e]); }
            }
            *(uint2*)p = pack4(z0); *(uint2*)(p + 32) = pack4(z1);
        }
    }
};
struct SEpiGate {
    bf16* Gt; const bf16* ADD;
    __device__ __forceinline__ void brows(int sl, int& b0, int& b1) const { b0 = 64 * sl; b1 = b0 + 32; }
    __device__ __forceinline__ void operator()(const f32x4s& c0, const f32x4s& c1, int row, int sl, int cw, int rit, int wc2, int fq, LAS float* xch) const {
        const size_t idx = (size_t)row * DM + 64 * sl + cw;
        f32x4s a0 = (f32x4s){0.f, 0.f, 0.f, 0.f}, a1 = a0;
        if (ADD) { a0 = unpack4(*(const uint2*)(ADD + idx)); a1 = unpack4(*(const uint2*)(ADD + idx + 32)); }
        const f32x4s g0 = unpack4(*(const uint2*)(Gt + idx)), g1 = unpack4(*(const uint2*)(Gt + idx + 32));
        *(uint2*)(Gt + idx) = pack4(a0 + g0 * c0); *(uint2*)(Gt + idx + 32) = pack4(a1 + g1 * c1);
    }
};

template <class Epi>
__device__ __forceinline__ void sample_gemm(LAS unsigned char* lds, const bf16* A, const bf16* Bt, int K, int nslices, const Epi& E, int bx, int G) {
    const int tid = opaque_tid(), lane = tid & 63, wave = __builtin_amdgcn_readfirstlane(tid >> 6), fr = lane & 15, fq = lane >> 4, wr4 = wave >> 1, wc2 = wave & 1;
    constexpr int RS = 528;
    LAS unsigned char* As = lds; LAS unsigned char* Bs = lds + 64 * RS; LAS float* xch = (LAS float*)(lds + 2 * 64 * RS);
    const int srow = tid >> 3, sch = tid & 7, nst = K >> 8, ntasks = nslices * 8;
    const int pbx = (G % 8 == 0) ? (bx & 7) * (G >> 3) + (bx >> 3) : bx;
    for (int t = pbx; t < ntasks; t += G) {
        const int sl = t >> 3, tm = t & 7;
        int br0, br1; E.brows(sl, br0, br1);
        const bf16* ag = A + (size_t)(MP + tm * 64 + srow) * K + sch * 8;
        const bf16* bg = Bt + (size_t)((srow < 32) ? br0 + srow : br1 + (srow - 32)) * K + sch * 8;
        u32x4 ra[4], rb[4];
#pragma unroll
        for (int q = 0; q < 4; ++q) { ra[q] = *(const u32x4*)(ag + 64 * q); rb[q] = *(const u32x4*)(bg + 64 * q); }
        f32x4s c0 = (f32x4s){0.f, 0.f, 0.f, 0.f}, c1 = c0;
        for (int s = 0; s < nst; ++s) {
            __syncthreads();
#pragma unroll
            for (int q = 0; q < 4; ++q) { *(LAS u32x4*)(As + srow * RS + (sch + 8 * q) * 16) = ra[q]; *(LAS u32x4*)(Bs + srow * RS + (sch + 8 * q) * 16) = rb[q]; }
            __syncthreads();
            if (s + 1 < nst) { const int o = (s + 1) * 256;
#pragma unroll
                for (int q = 0; q < 4; ++q) { ra[q] = *(const u32x4*)(ag + o + 64 * q); rb[q] = *(const u32x4*)(bg + o + 64 * q); } }
#pragma unroll
            for (int ks = 0; ks < 8; ++ks) {
                const bf16x8 af = *(const LAS bf16x8*)(As + (wr4 * 16 + fr) * RS + ks * 64 + fq * 16);
                const bf16x8 bf0 = *(const LAS bf16x8*)(Bs + (wc2 * 16 + fr) * RS + ks * 64 + fq * 16), bf1 = *(const LAS bf16x8*)(Bs + (32 + wc2 * 16 + fr) * RS + ks * 64 + fq * 16);
                c0 = __builtin_amdgcn_mfma_f32_16x16x32_bf16(bf0, af, c0, 0, 0, 0); c1 = __builtin_amdgcn_mfma_f32_16x16x32_bf16(bf1, af, c1, 0, 0, 0);
            }
        }
        E(c0, c1, MP + tm * 64 + wr4 * 16 + fr, sl, wc2 * 16 + 4 * fq, wr4 * 16 + fr, wc2, fq, xch);
    }
    __syncthreads();
}

#define RLX_AGENT __ATOMIC_RELAXED, __HIP_MEMORY_SCOPE_AGENT
#define XB_TMO      128
#define XB_XCNT(j)  (256  + 64 * (j))
#define XB_XSUB(j)  (1280 + 64 * (j))
#define XB_XGEN(j)  (2304 + 64 * (j))
#define XB_TOP      3328
#define XB_TOPGEN   3392
#define XCD_BAR_WORDS 3456
#define XB_SPIN_CAP (1u << 18)

__device__ __forceinline__ unsigned xb_ld(unsigned* p)              { return __hip_atomic_load(p, __ATOMIC_RELAXED, __HIP_MEMORY_SCOPE_AGENT); }
__device__ __forceinline__ unsigned xb_add(unsigned* p, unsigned v) { return __hip_atomic_fetch_add(p, v, __ATOMIC_RELAXED, __HIP_MEMORY_SCOPE_AGENT); }
__device__ __forceinline__ unsigned xb_xcc_id() { return (unsigned)__builtin_amdgcn_s_getreg((3 << 11) | 20) & 0xFu; }
#define XB_SPIN(cond, bar) do { unsigned _sp = 0; while (cond) { __builtin_amdgcn_s_sleep(1); \
    if ((++_sp & 255u) == 0u) { if (xb_ld(&(bar)[XB_TMO])) break; if (_sp > XB_SPIN_CAP) { atomicAdd(&(bar)[XB_TMO], 1u); break; } } } } while (0)

struct XcdBarrier {
    unsigned* bar; unsigned x;
    volatile LAS unsigned* st;
};

__device__ __forceinline__ XcdBarrier xcd_barrier_post(unsigned* bar, volatile LAS unsigned* st) {
    XcdBarrier b; b.bar = bar; b.x = xb_xcc_id(); b.st = st;
    if (threadIdx.x == 0) (void)xb_add(&bar[XB_XCNT(b.x)], 1u);
    return b;
}
__device__ __forceinline__ void xcd_barrier_complete(unsigned* bar, unsigned x, unsigned& nloc, unsigned& nx) {
    const unsigned G = gridDim.x * gridDim.y * gridDim.z;
    unsigned sum, cnt, mine, sp = 0u;
    for (;;) {
        sum = 0u; cnt = 0u; mine = 0u;
#pragma unroll
        for (unsigned j = 0; j < 16; ++j) { const unsigned c = xb_ld(&bar[XB_XCNT(j)]); sum += c; cnt += (c > 0u) ? 1u : 0u; mine = (j == x) ? c : mine; }
        if (sum == G) break;
        __builtin_amdgcn_s_sleep(1);
        if ((++sp & 255u) == 0u) { if (xb_ld(&bar[XB_TMO])) break; if (sp > XB_SPIN_CAP) { atomicAdd(&bar[XB_TMO], 1u); break; } }
    }
    nloc = mine > 0u ? mine : 1u; nx = cnt > 0u ? cnt : 1u;
}

__device__ __forceinline__ void xcd_barrier(const XcdBarrier& b) {
    asm volatile("s_waitcnt vmcnt(0)" ::: "memory");
    __syncthreads();
    if (threadIdx.x == 0) {
        unsigned* bar = b.bar;
        __builtin_amdgcn_s_waitcnt(0);
        unsigned nloc = b.st[0], nx = b.st[1];
        if (nloc == 0u) { xcd_barrier_complete(bar, b.x, nloc, nx); b.st[0] = nloc; b.st[1] = nx; }
        const unsigned old = xb_add(&bar[XB_XSUB(b.x)], 1u);
        const unsigned gen = old / nloc;
        if (old + 1u == (gen + 1u) * nloc) {
            __builtin_amdgcn_fence(__ATOMIC_RELEASE, "agent");
            asm volatile("s_waitcnt vmcnt(0)" ::: "memory");
            const unsigned og = xb_add(&bar[XB_TOP], 1u);
            const unsigned tg = og / nx;
            if (og + 1u == (tg + 1u) * nx) xb_add(&bar[XB_TOPGEN], 1u);
            else XB_SPIN(xb_ld(&bar[XB_TOPGEN]) == tg, bar);
            __builtin_amdgcn_fence(__ATOMIC_ACQUIRE, "agent");
            xb_add(&bar[XB_XGEN(b.x)], 1u);
            asm volatile("s_waitcnt vmcnt(0)" ::: "memory");
        } else {
            XB_SPIN(xb_ld(&bar[XB_XGEN(b.x)]) == gen, bar);
            __builtin_amdgcn_fence(__ATOMIC_ACQUIRE, "agent");
            asm volatile("s_waitcnt vmcnt(0)" ::: "memory");
        }
    }
    __syncthreads();
}

#ifndef MK_REV
#define MK_REV 1
#endif
#ifndef MK_SP2
#define MK_SP2 true
#endif
#ifndef MK_ALIGN
#define MK_ALIGN true
#endif
#ifndef MK_STAGGER
#define MK_STAGGER 0
#endif
__device__ __forceinline__ void stagger(int bx) { const unsigned lvl = (unsigned)(bx >> 3) & 3u; if (MK_STAGGER > 0 && lvl) { const unsigned long long t0 = __builtin_amdgcn_s_memrealtime(); while (__builtin_amdgcn_s_memrealtime() - t0 < (unsigned long long)(lvl * MK_STAGGER)) __builtin_amdgcn_s_sleep(4); } }
__global__ void __launch_bounds__(NTHR, 2) fwd_megakernel(Args a) {
    extern __shared__ __attribute__((aligned(16))) unsigned char lds_raw[];
    LAS unsigned char* lds = (LAS unsigned char*)lds_raw;
    cg::grid_group grid = cg::this_grid();
    volatile LAS unsigned* bar_st = (volatile LAS unsigned*)(lds + 131072 + 64);
    if (threadIdx.x < 2) bar_st[threadIdx.x] = 0u;
    __syncthreads();
    const int G = gridDim.x, bx = blockIdx.x;
    unsigned char* ws = a.ws;
    float* ss = (float*)(ws + WS_SS);
    bf16* XB = (bf16*)(ws + WS_XB); bf16* H = (bf16*)(ws + WS_H);
    bf16 *Q = (bf16*)(ws + WS_Q), *BG = (bf16*)(ws + WS_BG), *U = (bf16*)(ws + WS_U), *SA = (bf16*)(ws + WS_SA), *SC = (bf16*)(ws + WS_SC), *KV = (bf16*)(ws + WS_KV);
    float* xout = a.out;

#if !(MK_SKIP & 1)
    { const int tid = opaque_tid(), lane = tid & 63, wave = __builtin_amdgcn_readfirstlane(tid >> 6); prologue(a, lds, tid, lane, wave);
      if (MK_DUP & 1) { __syncthreads(); prologue(a, lds, tid, lane, wave); } }
#endif
    grid.sync();
    const XcdBarrier bar = xcd_barrier_post((unsigned*)(a.ws + WS_BAR), bar_st);

#pragma nounroll
    for (int l = 0; l < 2; ++l) {
        const bf16* Wl = (const bf16*)(ws + WS_W) + (size_t)l * E_LAYER;
#if !(MK_SKIP & 2)
        { SEpiSwiGLU SE{H, ss + (size_t)(3 * l) * MT * 16}; sample_gemm(lds, XB, Wl + E_W1GU, DM, DFF / 32, SE, bx, G);
          pg8::Gemm g{XB, Wl + E_W1GU, MP, 2 * DFF, DM}; pg8::StaticOrder S; S.init(MP, 2 * DFF, G, bx); pg8::EpiSwiGLU E{H, ss + (size_t)(3 * l) * MT * 16, (LAS float*)(lds + 131072 + 1024)};
          stagger(bx);
          pg8::gemm_phase<pg8::EpiSwiGLU, pg8::StaticOrder, MK_ALIGN, MK_SP2>(lds, g, S, E);
          if (MK_DUP & 2) pg8::gemm_phase<pg8::EpiSwiGLU, pg8::StaticOrder, MK_ALIGN, MK_SP2>(lds, g, S, E); }
#endif
        xcd_barrier(bar);
        if (MK_DUP & 8) xcd_barrier(bar);
#if !(MK_SKIP & 4)
        { SEpiResid SE{XB, ss + (size_t)(3 * l + 1) * MT * 16, 0.5f}; sample_gemm(lds, H, Wl + E_W1D, DFF, DM / 64, SE, bx, G);
          pg8::Gemm g{H, Wl + E_W1D, MP, DM, DFF}; pg8::StaticOrder S; S.init(MP, DM, G, bx, MK_REV);
          pg8::EpiResid E{XB, ss + (size_t)(3 * l + 1) * MT * 16, (MK_DUP & 32) ? 0.25f : 0.5f};
          stagger(bx);
          pg8::gemm_phase<pg8::EpiResid, pg8::StaticOrder, MK_ALIGN, MK_SP2>(lds, g, S, E);
          if (MK_DUP & 32) pg8::gemm_phase<pg8::EpiResid, pg8::StaticOrder, MK_ALIGN, MK_SP2>(lds, g, S, E); }
#endif
        xcd_barrier(bar);
        if (MK_DUP & 8) xcd_barrier(bar);
#if !(MK_SKIP & 8)
        { SEpiMixIn SE{ss + (size_t)(3 * l + 1) * MT * 16, (const float*)(ws + WS_BIAS) + l * NIN, Q, KV, BG, U, SA, SC}; sample_gemm(lds, XB, Wl + E_WIN, DM, 100, SE, bx, G);
          pg8::Gemm g{XB, Wl + E_WIN, MP, NIN, DM}; pg8::StaticOrder S; S.init(MP, NIN, G, bx);
          pg8::EpiMixIn E{ss + (size_t)(3 * l + 1) * MT * 16, (const bf16*)(ws + WS_BIAS + 65536) + l * NIN, Q, KV, BG, U, SA, SC, (LAS float*)(lds + 131072 + 1024)};
          stagger(bx);
          pg8::gemm_phase<pg8::EpiMixIn, pg8::StaticOrder, MK_ALIGN, MK_SP2>(lds, g, S, E);
          if (MK_DUP & 16) pg8::gemm_phase<pg8::EpiMixIn, pg8::StaticOrder, MK_ALIGN, MK_SP2>(lds, g, S, E); }
#endif
        xcd_barrier(bar);
        if (MK_DUP & 8) xcd_barrier(bar);
#if !(MK_SKIP & 16)
        { const int tid = opaque_tid(), lane = tid & 63, wave = __builtin_amdgcn_readfirstlane(tid >> 6);
          const float* ck = inp(2) + (size_t)l * 16 * 128 * 128; const float* cv = inp(3) + (size_t)l * 16 * 128 * 128;
          const bool conv_first = ((bx >> 3) & 1) != 0;
          if (conv_first) for (int ch = bx; ch < MT / 32; ch += G) conv_chunk(BG, U, inp(13) + (size_t)l * 3 * DM, inp(4) + (size_t)l * 16 * 2 * DM, MT / 32 - 1 - ch, tid);
          for (int it = bx; it < N_ATT_ITEMS; it += G) attn_item(lds, Q, Q, KV, ck, cv, inp(12) + l * 16, N_ATT_ITEMS - 1 - it, tid, lane, wave);
          if (!conv_first) for (int ch = bx; ch < MT / 32; ch += G) conv_chunk(BG, U, inp(13) + (size_t)l * 3 * DM, inp(4) + (size_t)l * 16 * 2 * DM, MT / 32 - 1 - ch, tid);
          state_copies(a, l, KV, U, bx * NTHR + tid, G * NTHR); }
#endif
        xcd_barrier(bar);
        if (MK_DUP & 8) xcd_barrier(bar);
#if !(MK_SKIP & 32)
        { SEpiGate SE{SA, nullptr}; sample_gemm(lds, Q, Wl + E_WOA, DM, DM / 64, SE, bx, G);
          pg8::Gemm g{Q, Wl + E_WOA, MP, DM, DM}; pg8::StaticOrder S; S.init(MP, DM, G, bx); pg8::EpiGate E{SA, nullptr};
          stagger(bx);
          pg8::gemm_phase<pg8::EpiGate, pg8::StaticOrder, MK_ALIGN, MK_SP2>(lds, g, S, E); }
        { SEpiGate SE{SC, SA}; sample_gemm(lds, BG, Wl + E_WOC, DM, DM / 64, SE, bx, G);
          pg8::Gemm g{BG, Wl + E_WOC, MP, DM, DM}; pg8::StaticOrder S; S.init(MP, DM, G, bx); pg8::EpiGate E{SC, SA};
          stagger(bx);
          pg8::gemm_phase<pg8::EpiGate, pg8::StaticOrder, MK_ALIGN, MK_SP2>(lds, g, S, E); }
#endif
        xcd_barrier(bar);
        if (MK_DUP & 8) xcd_barrier(bar);
#if !(MK_SKIP & 64)
        { SEpiResid SE{XB, ss + (size_t)(3 * l + 2) * MT * 16, 1.0f}; sample_gemm(lds, SC, Wl + E_WO, DM, DM / 64, SE, bx, G);
          pg8::Gemm g{SC, Wl + E_WO, MP, DM, DM}; pg8::StaticOrder S; S.init(MP, DM, G, bx, MK_REV);
          pg8::EpiResid E{XB, ss + (size_t)(3 * l + 2) * MT * 16, 1.0f};
          stagger(bx);
          pg8::gemm_phase<pg8::EpiResid, pg8::StaticOrder, MK_ALIGN, MK_SP2>(lds, g, S, E); }
#endif
        xcd_barrier(bar);
        if (MK_DUP & 8) xcd_barrier(bar);
#if !(MK_SKIP & 128)
        { SEpiSwiGLU SE{H, ss + (size_t)(3 * l + 2) * MT * 16}; sample_gemm(lds, XB, Wl + E_W2GU, DM, DFF / 32, SE, bx, G);
          pg8::Gemm g{XB, Wl + E_W2GU, MP, 2 * DFF, DM}; pg8::StaticOrder S; S.init(MP, 2 * DFF, G, bx); pg8::EpiSwiGLU E{H, ss + (size_t)(3 * l + 2) * MT * 16, (LAS float*)(lds + 131072 + 1024)};
          stagger(bx);
          pg8::gemm_phase<pg8::EpiSwiGLU, pg8::StaticOrder, MK_ALIGN, MK_SP2>(lds, g, S, E); }
#endif
        xcd_barrier(bar);
        if (MK_DUP & 8) xcd_barrier(bar);
#if !(MK_SKIP & 256)
        { SEpiResid SE{XB, ss + (size_t)(3 * l + 3) * MT * 16, 0.5f}; sample_gemm(lds, H, Wl + E_W2D, DFF, DM / 64, SE, bx, G);
          pg8::Gemm g{H, Wl + E_W2D, MP, DM, DFF}; pg8::StaticOrder S; S.init(MP, DM, G, bx, MK_REV);
          pg8::EpiResid E{XB, ss + (size_t)(3 * l + 3) * MT * 16, 0.5f};
          stagger(bx);
          pg8::gemm_phase<pg8::EpiResid, pg8::StaticOrder, MK_ALIGN, MK_SP2>(lds, g, S, E); }
#endif
        xcd_barrier(bar);
        if (MK_DUP & 8) xcd_barrier(bar);
    }
    { const int tid = opaque_tid(), lane = tid & 63, wave = __builtin_amdgcn_readfirstlane(tid >> 6);
      const int gw = bx * NWAVES + wave, NGW = G * NWAVES; const float* ssf = ss + (size_t)6 * MT * 16;
      f32x4 gv[4];
#pragma unroll
      for (int j = 0; j < 4; ++j) gv[j] = ((const f32x4*)inp(21))[lane + 64 * j];
      for (int m2 = gw; m2 < MT / 2; m2 += NGW) {
          uint2 w[2][4]; float rs[2];
#pragma unroll
          for (int r = 0; r < 2; ++r) { const int m = 2 * m2 + r; rs[r] = pg8::row_rs(ssf, m); const uint2* xr = (const uint2*)(XB + (size_t)m * DM);
#pragma unroll
              for (int j = 0; j < 4; ++j) w[r][j] = xr[lane + 64 * j]; }
#pragma unroll
          for (int r = 0; r < 2; ++r) { f32x4* yr = (f32x4*)(xout + (size_t)(2 * m2 + r) * DM);
#pragma unroll
              for (int j = 0; j < 4; ++j) { const f32x4 v = (f32x4){bflo(w[r][j].x), bfhi(w[r][j].x), bflo(w[r][j].y), bfhi(w[r][j].y)}; yr[lane + 64 * j] = v * rs[r] * gv[j]; } } } }
}

extern "C" void kernel_launch(void* const* d_in, const int* in_sizes, int n_in, void* d_out, int out_size, void* d_ws, size_t ws_size, hipStream_t stream) {
    static int grid = 0;
    if (grid == 0) {
        if (n_in != 22 || in_sizes[0] != MP * DM || (size_t)out_size != O_END || ws_size < WS_SS + (size_t)7 * MT * 64) { fprintf(stderr, "kernel_launch: unexpected shapes (n_in %d, in0 %d, out %d, ws %zu)\n", n_in, n_in > 0 ? in_sizes[0] : -1, out_size, ws_size); grid = -1; return; }
        int dev = 0, cus = 0, per_cu = 0;
        hipGetDevice(&dev); hipDeviceGetAttribute(&cus, hipDeviceAttributeMultiprocessorCount, dev);
        if (hipFuncSetAttribute((const void*)fwd_megakernel, hipFuncAttributeMaxDynamicSharedMemorySize, LDS_BYTES) != hipSuccess) { fprintf(stderr, "kernel_launch: hipFuncSetAttribute failed\n"); grid = -1; return; }
        if (hipOccupancyMaxActiveBlocksPerMultiprocessor(&per_cu, (const void*)fwd_megakernel, NTHR, LDS_BYTES) != hipSuccess || per_cu < 1) { fprintf(stderr, "kernel_launch: occupancy query says %d\n", per_cu); per_cu = 1; }
        (void)hipGetLastError();
        grid = cus;
    }
    if (grid < 0) return;
    Args a{};
    a.x_prompt = (const float*)d_in[0]; a.x_sample = (const float*)d_in[1]; a.cache_k = (const float*)d_in[2]; a.cache_v = (const float*)d_in[3]; a.state_conv = (const float*)d_in[4];
    a.norm_ffn1 = (const float*)d_in[5]; a.w1_gate = (const float*)d_in[6]; a.w1_up = (const float*)d_in[7]; a.w1_down = (const float*)d_in[8];
    a.norm_mix = (const float*)d_in[9]; a.w_in = (const float*)d_in[10]; a.b_in = (const float*)d_in[11]; a.sinks = (const float*)d_in[12]; a.conv_w = (const float*)d_in[13];
    a.w_o_attn = (const float*)d_in[14]; a.w_o_conv = (const float*)d_in[15]; a.w_o = (const float*)d_in[16];
    a.norm_ffn2 = (const float*)d_in[17]; a.w2_gate = (const float*)d_in[18]; a.w2_up = (const float*)d_in[19]; a.w2_down = (const float*)d_in[20]; a.norm_final = (const float*)d_in[21];
    a.out = (float*)d_out; a.ws = (unsigned char*)d_ws;
    void* args[] = {&a};
    hipError_t e = hipLaunchCooperativeKernel((const void*)fwd_megakernel, dim3(grid), dim3(NTHR), args, LDS_BYTES, stream);
    if (e != hipSuccess) fprintf(stderr, "kernel_launch: cooperative launch failed: %s (grid %d)\n", hipGetErrorString(e), grid);
}
```

```cpp
#include <hip/hip_runtime.h>
#include <hip/hip_cooperative_groups.h>
#include <cstdio>
#include <cstdint>
namespace cg = cooperative_groups;

constexpr int DM = 1024, DFF = 2816, NIN = 6400;
constexpr int NB = 8, SEQ = 8192, SBAT = 16, SSEQ = 32;
constexpr int MP = NB * SEQ, MS = SBAT * SSEQ, MT = MP + MS;
constexpr float EPS = 1e-6f, LOG2E = 1.4426950408889634f;
constexpr float QSCALE = 0.125f * LOG2E;

typedef float f32x2_t __attribute__((ext_vector_type(2)));
typedef __bf16 bf16x2_t __attribute__((ext_vector_type(2)));
__device__ __forceinline__ unsigned cvtpk(float lo, float hi) { f32x2_t v = {lo, hi}; bf16x2_t b = __builtin_convertvector(v, bf16x2_t); return __builtin_bit_cast(unsigned, b); }
__device__ __forceinline__ float bflo(unsigned w) { return __uint_as_float(w << 16); }
__device__ __forceinline__ float bfhi(unsigned w) { return __uint_as_float(w & 0xffff0000u); }
__device__ __forceinline__ float sig_scaled(float zs) { return __builtin_amdgcn_rcpf(1.0f + __builtin_amdgcn_exp2f(zs)); }
__device__ __forceinline__ float fast_sigmoid(float z) { return __builtin_amdgcn_rcpf(1.0f + __builtin_amdgcn_exp2f(-z * LOG2E)); }

namespace pg8 {
#define PG8_LAS __attribute__((address_space(3)))
typedef unsigned short bf16_t;
typedef short bf16x8 __attribute__((ext_vector_type(8)));
typedef float f32x4 __attribute__((ext_vector_type(4)));
typedef unsigned u32x4 __attribute__((ext_vector_type(4)));
constexpr int BM = 256, BK = 64, HALF = 128, HTB = HALF * BK * 2  , STAGE_BYTES = 8 * HTB, NXCD = 8, WGM = 8;

__host__ __device__ __forceinline__ int lds_byte(int r, int c) { const int st = (r >> 4) * 2 + (c >> 5), rr = r & 15, cc = c & 31, ob = rr * 64 + cc * 2; return st * 1024 + (ob ^ (((ob >> 9) & 1) << 5)); }
__host__ __device__ __forceinline__ void stage_rc(int b, int& R, int& C) { const int st = b / 1024, sb = b % 1024, swz = sb ^ (((sb >> 9) & 1) << 5); R = (st >> 1) * 16 + swz / 64; C = (st & 1) * 32 + (swz % 64) / 2; }
__host__ __device__ __forceinline__ int perm32(int rho) { const int n = rho >> 4, i = rho & 15; return 8 * (i >> 2) + 4 * n + (i & 3); }

struct Unit { int pm, pn; };
struct Gemm { const bf16_t* A; const bf16_t* Bt; int M, N, K; };

struct StaticOrder {
    int nM, nN, nwg, G, c, rev;
    __host__ __device__ void init(int M, int N, int G_, int c_, int rev_ = 0) { nM = M / BM; nN = N / BM; nwg = nM * nN; G = G_; c = c_; rev = rev_; }
    __host__ __device__ bool next(int i, Unit& u) const {
        const long L = (long)i * G + c; if (L >= nwg) return false;
        int wgid = (int)L; { const int q = nwg / NXCD, r = nwg % NXCD, xcd = wgid % NXCD, off = wgid / NXCD; wgid = (xcd < r ? xcd * (q + 1) : r * (q + 1) + (xcd - r) * q) + off; }
        const int nig = WGM * nN, gid = wgid / nig, fm = gid * WGM, gsz = (nM - fm) < WGM ? (nM - fm) : WGM;
        u.pm = fm + ((wgid % nig) % gsz); u.pn = (wgid % nig) / gsz; if (rev) u.pm = nM - 1 - u.pm; return true;
    }
    __device__ __forceinline__ void a_ready(const Unit&) const {}
    __device__ __forceinline__ void done(const Unit&) const {}
};

__device__ __forceinline__ float row_rs(const float* ss, int row) { const f32x4* p = (const f32x4*)(ss + (size_t)row * 16); const f32x4 a = p[0], b = p[1], c = p[2], d = p[3];
    const float s = ((a[0] + a[1]) + (a[2] + a[3])) + ((b[0] + b[1]) + (b[2] + b[3])) + ((c[0] + c[1]) + (c[2] + c[3])) + ((d[0] + d[1]) + (d[2] + d[3]));
    return __builtin_amdgcn_rsqf(s * (1.0f / 1024.0f) + EPS); }

__device__ __forceinline__ void wave_rs_table(PG8_LAS float* tab, const float* ss, int row_base, int lane) {
    f32x4 pv[2][4];
#pragma unroll
    for (int h = 0; h < 2; ++h) { const int j = lane + 64 * h; const f32x4* p = (const f32x4*)(ss + (size_t)(row_base + (j >> 6) * HALF + (j & 63)) * 16);
#pragma unroll
        for (int q = 0; q < 4; ++q) pv[h][q] = p[q]; }
#pragma unroll
    for (int h = 0; h < 2; ++h) { const f32x4 a = pv[h][0], b = pv[h][1], c = pv[h][2], d = pv[h][3];
        const float s = ((a[0] + a[1]) + (a[2] + a[3])) + ((b[0] + b[1]) + (b[2] + b[3])) + ((c[0] + c[1]) + (c[2] + c[3])) + ((d[0] + d[1]) + (d[2] + d[3]));
        tab[lane + 64 * h] = __builtin_amdgcn_rsqf(s * (1.0f / 1024.0f) + EPS); }
    asm volatile("s_waitcnt lgkmcnt(0)" ::: "memory"); __builtin_amdgcn_wave_barrier(); asm volatile("" ::: "memory");
}

struct EpiSwiGLU {
    static constexpr bool PERM = true, AFTER_DRAIN = false;
    static __device__ __forceinline__ int store_class(const Unit&) { return 0; }
    static constexpr int RELAX = 6;
    bf16_t* H; const float* ss; PG8_LAS float* tabs;
    __device__ __forceinline__ void operator()(const f32x4 (&acc)[2][2][4][2], const Unit& u, int wr, int wc, int fr, int fq) const {
        const int row0 = u.pm * BM + wr * 64 + fr, col0 = u.pn * 128 + wc * 32 + 8 * fq;
        PG8_LAS float* tab = tabs + (wr * 4 + wc) * 128; wave_rs_table(tab, ss, u.pm * BM + wr * 64, fq * 16 + fr);
#pragma unroll
        for (int ai = 0; ai < 2; ++ai)
#pragma unroll
            for (int m = 0; m < 4; ++m) {
                const int row = row0 + ai * HALF + m * 16; const float rs = tab[ai * 64 + m * 16 + fr];
                float h[8];
#pragma unroll
                for (int n = 0; n < 2; ++n)
#pragma unroll
                    for (int e = 0; e < 4; ++e) { const float g = acc[ai][0][m][n][e] * rs, up = acc[ai][1][m][n][e] * rs; h[n * 4 + e] = g * fast_sigmoid(g) * up; }
                u32x4 w; w.x = cvtpk(h[0], h[1]); w.y = cvtpk(h[2], h[3]); w.z = cvtpk(h[4], h[5]); w.w = cvtpk(h[6], h[7]);
                *(u32x4*)(H + (size_t)row * DFF + col0) = w;
            }
    }
};

struct EpiResid {
    static constexpr bool PERM = true, AFTER_DRAIN = false;
    static __device__ __forceinline__ int store_class(const Unit&) { return 0; }
    static constexpr int RELAX = 22;
    bf16_t* xb; float* ssn; float scale;
    __device__ __forceinline__ void operator()(const f32x4 (&acc)[2][2][4][2], const Unit& u, int wr, int wc, int fr, int fq) const {
        const int row0 = u.pm * BM + wr * 64 + fr, col0 = u.pn * BM + wc * 32 + 8 * fq;
#pragma unroll
        for (int ai = 0; ai < 2; ++ai) {
            u32x4 gl[4][2];
#pragma unroll
            for (int m = 0; m < 4; ++m) { const bf16_t* xr = xb + (size_t)(row0 + ai * HALF + m * 16) * DM + col0; gl[m][0] = *(const u32x4*)xr; gl[m][1] = *(const u32x4*)(xr + HALF); }
#pragma unroll
            for (int m = 0; m < 4; ++m) {
                const int row = row0 + ai * HALF + m * 16;
                bf16_t* xr = xb + (size_t)row * DM + col0;
                const u32x4 g0 = gl[m][0], g1 = gl[m][1];
                float sq = 0.f;
#pragma unroll
                for (int bj = 0; bj < 2; ++bj) {
                    const u32x4 g = bj ? g1 : g0; const f32x4 p0 = acc[ai][bj][m][0], p1 = acc[ai][bj][m][1];
                    const float o0 = bflo(g.x) + scale * p0[0], o1 = bfhi(g.x) + scale * p0[1], o2 = bflo(g.y) + scale * p0[2], o3 = bfhi(g.y) + scale * p0[3];
                    const float o4 = bflo(g.z) + scale * p1[0], o5 = bfhi(g.z) + scale * p1[1], o6 = bflo(g.w) + scale * p1[2], o7 = bfhi(g.w) + scale * p1[3];
                    u32x4 w; w.x = cvtpk(o0, o1); w.y = cvtpk(o2, o3); w.z = cvtpk(o4, o5); w.w = cvtpk(o6, o7);
                    *(u32x4*)(xr + bj * HALF) = w;
                    sq += (o0 * o0 + o1 * o1) + (o2 * o2 + o3 * o3) + (o4 * o4 + o5 * o5) + (o6 * o6 + o7 * o7);
                }
                sq += __shfl_xor(sq, 16); sq += __shfl_xor(sq, 32);
                if (fq == 0) ssn[(size_t)row * 16 + u.pn * 4 + wc] = sq;
            }
        }
    }
};

struct EpiMixIn {
    static constexpr bool PERM = true, AFTER_DRAIN = false;
    static __device__ __forceinline__ int store_class(const Unit&) { return 0; }
    static constexpr int RELAX = 6;
    const float* ss; const bf16_t* bias16; bf16_t *Q, *KV, *BG, *U, *SA, *SC; PG8_LAS float* tabs;
    __device__ __forceinline__ void operator()(const f32x4 (&acc)[2][2][4][2], const Unit& u, int wr, int wc, int fr, int fq) const {
        PG8_LAS float* tab = tabs + (wr * 4 + wc) * 128; wave_rs_table(tab, ss, u.pm * BM + wr * 64, fq * 16 + fr);
        const int pn = u.pn; bf16_t* dst; int ld, cbase, mode; float sc = 1.f;
        if (pn < 4) { dst = Q; ld = DM; cbase = pn * 256; mode = 0; }
        else if (pn == 4) { dst = KV; ld = 256; cbase = 0; mode = 0; }
        else if (pn < 9) { dst = BG; ld = DM; cbase = (pn - 5) * 256; mode = 0; }
        else if (pn < 17) { dst = U; ld = DM; cbase = (pn - 9) * 128; mode = 2; }
        else if (pn < 21) { dst = SA; ld = DM; cbase = (pn - 17) * 256; mode = 1; }
        else { dst = SC; ld = DM; cbase = (pn - 21) * 256; mode = 1; }
        const int row0 = u.pm * BM + wr * 64 + fr, cw = wc * 32 + 8 * fq;
        u32x4 bw[2];
#pragma unroll
        for (int bj = 0; bj < 2; ++bj) bw[bj] = *(const u32x4*)(bias16 + pn * 256 + bj * HALF + cw);
#define BV(bj, n) ((n) == 0 ? (f32x4){bflo(bw[bj].x), bfhi(bw[bj].x), bflo(bw[bj].y), bfhi(bw[bj].y)} : (f32x4){bflo(bw[bj].z), bfhi(bw[bj].z), bflo(bw[bj].w), bfhi(bw[bj].w)})
#pragma unroll
        for (int ai = 0; ai < 2; ++ai)
#pragma unroll
            for (int m = 0; m < 4; ++m) {
                const int row = row0 + ai * HALF + m * 16; const float rs = tab[ai * 64 + m * 16 + fr];
                bf16_t* rowp = dst + (size_t)row * ld + cbase + cw;
                if (mode == 2) {
                    const f32x4 z0 = (acc[ai][0][m][0] * rs + BV(0, 0)) * (acc[ai][1][m][0] * rs + BV(1, 0));
                    const f32x4 z1 = (acc[ai][0][m][1] * rs + BV(0, 1)) * (acc[ai][1][m][1] * rs + BV(1, 1));
                    u32x4 w; w.x = cvtpk(z0[0], z0[1]); w.y = cvtpk(z0[2], z0[3]); w.z = cvtpk(z1[0], z1[1]); w.w = cvtpk(z1[2], z1[3]);
                    *(u32x4*)rowp = w;
                } else {
#pragma unroll
                    for (int bj = 0; bj < 2; ++bj) {
                        f32x4 z0 = acc[ai][bj][m][0] * rs + BV(bj, 0), z1 = acc[ai][bj][m][1] * rs + BV(bj, 1);
                        if (mode == 1) {
#pragma unroll
                            for (int e = 0; e < 4; ++e) { z0[e] = sig_scaled(z0[e]); z1[e] = sig_scaled(z1[e]); }
                        }
                        u32x4 w; w.x = cvtpk(z0[0], z0[1]); w.y = cvtpk(z0[2], z0[3]); w.z = cvtpk(z1[0], z1[1]); w.w = cvtpk(z1[2], z1[3]);
                        *(u32x4*)(rowp + bj * HALF) = w;
                    }
                }
            }
    }
};

#undef BV
struct EpiGate {
    static constexpr bool PERM = true, AFTER_DRAIN = false;
    static __device__ __forceinline__ int store_class(const Unit&) { return 0; }
    static constexpr int RELAX = 14;
    bf16_t* G; const bf16_t* ADD;
    __device__ __forceinline__ void operator()(const f32x4 (&acc)[2][2][4][2], const Unit& u, int wr, int wc, int fr, int fq) const {
        const int row0 = u.pm * BM + wr * 64 + fr, col0 = u.pn * BM + wc * 32 + 8 * fq;
#pragma unroll
        for (int ai = 0; ai < 2; ++ai)
#pragma unroll
          for (int mp = 0; mp < 2; ++mp) {
            u32x4 gl[2][2], al[2][2];
#pragma unroll
            for (int mm = 0; mm < 2; ++mm)
#pragma unroll
                for (int bj = 0; bj < 2; ++bj) { const size_t idx = (size_t)(row0 + ai * HALF + (2 * mp + mm) * 16) * DM + col0 + bj * HALF;
                    gl[mm][bj] = *(const u32x4*)(G + idx); al[mm][bj] = (u32x4){0u, 0u, 0u, 0u}; if (ADD) al[mm][bj] = *(const u32x4*)(ADD + idx); }
#pragma unroll
            for (int mm = 0; mm < 2; ++mm) {
                const int m = 2 * mp + mm;
                const int row = row0 + ai * HALF + m * 16;
#pragma unroll
                for (int bj = 0; bj < 2; ++bj) {
                    const size_t idx = (size_t)row * DM + col0 + bj * HALF;
                    const u32x4 g = gl[mm][bj];
                    const u32x4 a = al[mm][bj];
                    const f32x4 p0 = acc[ai][bj][m][0], p1 = acc[ai][bj][m][1];
                    u32x4 w;
                    w.x = cvtpk(bflo(a.x) + bflo(g.x) * p0[0], bfhi(a.x) + bfhi(g.x) * p0[1]);
                    w.y = cvtpk(bflo(a.y) + bflo(g.y) * p0[2], bfhi(a.y) + bfhi(g.y) * p0[3]);
                    w.z = cvtpk(bflo(a.z) + bflo(g.z) * p1[0], bfhi(a.z) + bfhi(g.z) * p1[1]);
                    w.w = cvtpk(bflo(a.w) + bflo(g.w) * p1[2], bfhi(a.w) + bfhi(g.w) * p1[3]);
                    *(u32x4*)(G + idx) = w;
                }
            }
          }
    }
};

template <class Epi, class Sched, bool ALIGN_EPI = false, bool SP2 = false>
__device__ __forceinline__ void gemm_phase(PG8_LAS unsigned char* lds, const Gemm g, const Sched& S, const Epi& E) {
    int tid_ = threadIdx.x; asm volatile("" : "+v"(tid_));
    const int tid = tid_, wid = __builtin_amdgcn_readfirstlane(tid >> 6), lane = tid & 63, wr = wid >> 2, wc = wid & 3, fr = lane & 15, fq = lane >> 4;
    const int K = g.K, nt = K / BK;
    unsigned voffA[2], voffB[2];
#pragma unroll
    for (int i = 0; i < 2; ++i) { int R, C; stage_rc(tid * 16 + i * 8192, R, C); const int Rb = Epi::PERM ? ((R & ~31) + perm32(R & 31)) : R;
        voffA[i] = (unsigned)(R * K + C) * 2u; voffB[i] = (unsigned)(Rb * K + C) * 2u; }
    const size_t kstep = (size_t)(BK * 2);
    const size_t hstep = (size_t)HALF * K * 2;
    const size_t tstep = 2 * hstep;
    const unsigned ldsw = (unsigned)wid * 1024u;
    const int aoff = lds_byte(wr * 64 + fr, fq * 8), boff = lds_byte(wc * 32 + fr, fq * 8);
#define PG8_SA(b, h) (((b) * 2 + (h)) * HTB)
#define PG8_SB(b, h) ((4 + (b) * 2 + (h)) * HTB)
    const unsigned ldsb = (unsigned)__builtin_amdgcn_readfirstlane((int)((unsigned)(unsigned long long)(__attribute__((address_space(3))) unsigned char*)lds + ldsw));
#define PG8_GLDS(vo, sbase, off) asm volatile("s_add_u32 m0, %2, %3\n\ts_nop 0\n\tglobal_load_lds_dwordx4 %0, %1" :: "v"(vo), "s"(sbase), "s"(ldsb), "i"(off) : "memory", "m0", "scc")
#define PG8_STAGE(bufoff, gbase, voff) do { PG8_GLDS((voff)[0], (const char*)(gbase), (bufoff)); PG8_GLDS((voff)[1], (const char*)(gbase), (bufoff) + 8192); } while (0)
#define PG8_LDA(dst, b, h) do { _Pragma("unroll") for (int m = 0; m < 4; ++m) _Pragma("unroll") for (int k = 0; k < 2; ++k) dst[m][k] = *(const PG8_LAS bf16x8*)(lds + PG8_SA(b, h) + aoff + m * 2048 + k * 1024); } while (0)
#define PG8_LDB(dst, b, h) do { _Pragma("unroll") for (int n = 0; n < 2; ++n) _Pragma("unroll") for (int k = 0; k < 2; ++k) dst[n][k] = *(const PG8_LAS bf16x8*)(lds + PG8_SB(b, h) + boff + n * 2048 + k * 1024); } while (0)
#define PG8_MMA(ai, bj, At, Bt) do { __builtin_amdgcn_s_setprio(1); _Pragma("unroll") for (int m = 0; m < 4; ++m) _Pragma("unroll") for (int n = 0; n < 2; ++n) _Pragma("unroll") for (int k = 0; k < 2; ++k) \
        acc[ai][bj][m][n] = __builtin_amdgcn_mfma_f32_16x16x32_bf16(Bt[n][k], At[m][k], acc[ai][bj][m][n], 0, 0, 0); __builtin_amdgcn_s_setprio(0); } while (0)
#define PG8_WAIT_V(n) asm volatile("s_waitcnt vmcnt(" #n ")" ::: "memory")
#define PG8_WAIT_VX(rx) PG8_WAIT_V(8)
#define PG8_WAIT_L(n) asm volatile("s_waitcnt lgkmcnt(" #n ")" ::: "memory")
#define PG8_BAR __builtin_amdgcn_s_barrier()
#define PG8_SCHED __builtin_amdgcn_sched_barrier(0)
    Unit cur, nxt; int ui = 0; int rcls = 0;
    if (!S.next(0, cur)) return;
    f32x4 acc[2][2][4][2];
#pragma unroll
    for (int a = 0; a < 2; ++a)
#pragma unroll
        for (int b = 0; b < 2; ++b)
#pragma unroll
            for (int m = 0; m < 4; ++m)
#pragma unroll
                for (int n = 0; n < 2; ++n) acc[a][b][m][n] = (f32x4){0.f, 0.f, 0.f, 0.f};
    bf16x8 At[4][2], B0[2][2], B1[2][2];
    const char* cA = (const char*)g.A + (size_t)cur.pm * tstep; const char* cB = (const char*)g.Bt + (size_t)cur.pn * tstep;
    S.a_ready(cur);
    if constexpr (SP2) {
        PG8_STAGE(PG8_SB(0, 0), cB, voffB); PG8_STAGE(PG8_SB(0, 1), cB + hstep, voffB); PG8_STAGE(PG8_SA(0, 0), cA, voffA); PG8_STAGE(PG8_SA(0, 1), cA + hstep, voffA);
        if (wr == 1) PG8_BAR;
        PG8_WAIT_V(2); PG8_BAR;
        PG8_STAGE(PG8_SB(1, 0), cB + kstep, voffB); PG8_STAGE(PG8_SA(1, 0), cA + kstep, voffA); PG8_STAGE(PG8_SB(1, 1), cB + hstep + kstep, voffB);
        PG8_WAIT_V(6); PG8_BAR;
    } else {
        PG8_STAGE(PG8_SB(0, 0), cB, voffB); PG8_STAGE(PG8_SA(0, 0), cA, voffA); PG8_STAGE(PG8_SB(0, 1), cB + hstep, voffB); PG8_STAGE(PG8_SA(0, 1), cA + hstep, voffA);
        if (wr == 1) PG8_BAR;
        PG8_WAIT_V(4); PG8_BAR;
        PG8_STAGE(PG8_SB(1, 0), cB + kstep, voffB); PG8_STAGE(PG8_SA(1, 0), cA + kstep, voffA); PG8_STAGE(PG8_SB(1, 1), cB + hstep + kstep, voffB);
        PG8_WAIT_V(6); PG8_BAR;
    }
    for (;;) {
        const bool has_next = S.next(ui + 1, nxt);
        const char* nA = has_next ? (const char*)g.A + (size_t)nxt.pm * tstep : cA; const char* nB = has_next ? (const char*)g.Bt + (size_t)nxt.pn * tstep : cB;
        for (int t = 0; t < nt; t += 2) {
            const bool last = (t == nt - 2);
            const char* a1 = cA + (size_t)(t + 1) * kstep;
            const char* a2 = last ? nA : cA + (size_t)(t + 2) * kstep; const char* b2 = last ? nB : cB + (size_t)(t + 2) * kstep;
            const char* a3 = a2 + kstep; const char* b3 = b2 + kstep;
            if (last && has_next) S.a_ready(nxt);
            if constexpr (SP2) {
            const int rx = (t == 0) ? rcls : 0;
            PG8_LDB(B0, 0, 0); PG8_LDB(B1, 0, 1); PG8_SCHED; PG8_LDA(At, 0, 0); PG8_STAGE(PG8_SA(1, 1), a1 + hstep, voffA);
            PG8_WAIT_VX(rx); PG8_WAIT_L(0); PG8_BAR; PG8_MMA(0, 0, At, B0); PG8_MMA(0, 1, At, B1); PG8_BAR; PG8_SCHED;
            PG8_LDA(At, 0, 1); PG8_STAGE(PG8_SB(0, 0), b2, voffB); PG8_STAGE(PG8_SB(0, 1), b2 + hstep, voffB); PG8_STAGE(PG8_SA(0, 0), a2, voffA);
            PG8_WAIT_VX(rx); PG8_WAIT_L(0); PG8_BAR; PG8_MMA(1, 0, At, B0); PG8_MMA(1, 1, At, B1); PG8_BAR; PG8_SCHED;
            PG8_LDB(B0, 1, 0); PG8_LDB(B1, 1, 1); PG8_SCHED; PG8_LDA(At, 1, 0); PG8_STAGE(PG8_SA(0, 1), a2 + hstep, voffA);
            PG8_WAIT_V(8); PG8_WAIT_L(0); PG8_BAR; PG8_MMA(0, 0, At, B0); PG8_MMA(0, 1, At, B1); PG8_BAR; PG8_SCHED;
            PG8_LDA(At, 1, 1); PG8_STAGE(PG8_SB(1, 0), b3, voffB); PG8_STAGE(PG8_SB(1, 1), b3 + hstep, voffB); PG8_STAGE(PG8_SA(1, 0), a3, voffA);
            PG8_WAIT_V(8); PG8_WAIT_L(0); PG8_BAR; PG8_MMA(1, 0, At, B0); PG8_MMA(1, 1, At, B1); PG8_BAR; PG8_SCHED;
            } else {
            PG8_LDB(B0, 0, 0); PG8_SCHED; PG8_LDA(At, 0, 0); PG8_STAGE(PG8_SA(1, 1), a1 + hstep, voffA);
            PG8_WAIT_L(8); PG8_BAR; PG8_WAIT_L(0); PG8_MMA(0, 0, At, B0); PG8_BAR; PG8_SCHED;
            PG8_LDB(B1, 0, 1); PG8_STAGE(PG8_SB(0, 0), b2, voffB);
            PG8_BAR; PG8_WAIT_L(0); PG8_MMA(0, 1, At, B1); PG8_BAR;
            PG8_LDA(At, 0, 1); PG8_STAGE(PG8_SA(0, 0), a2, voffA);
            PG8_BAR; PG8_WAIT_L(0); PG8_MMA(1, 0, At, B0); PG8_BAR; PG8_SCHED;
            PG8_STAGE(PG8_SB(0, 1), b2 + hstep, voffB);
            PG8_WAIT_V(6); PG8_BAR; PG8_MMA(1, 1, At, B1); PG8_BAR;
            PG8_LDB(B0, 1, 0); PG8_SCHED; PG8_LDA(At, 1, 0); PG8_STAGE(PG8_SA(0, 1), a2 + hstep, voffA);
            PG8_WAIT_L(8); PG8_BAR; PG8_WAIT_L(0); PG8_MMA(0, 0, At, B0); PG8_BAR; PG8_SCHED;
            PG8_LDB(B1, 1, 1); PG8_STAGE(PG8_SB(1, 0), b3, voffB);
            PG8_BAR; PG8_WAIT_L(0); PG8_MMA(0, 1, At, B1); PG8_BAR;
            PG8_LDA(At, 1, 1); PG8_STAGE(PG8_SA(1, 0), a3, voffA);
            PG8_BAR; PG8_WAIT_L(0); PG8_MMA(1, 0, At, B0); PG8_BAR; PG8_SCHED;
            PG8_STAGE(PG8_SB(1, 1), b3 + hstep, voffB);
            PG8_WAIT_V(6); PG8_BAR; PG8_MMA(1, 1, At, B1); PG8_BAR;
            }
        }
        if constexpr (ALIGN_EPI) { if (wr == 0) PG8_BAR; }
        if constexpr (!Epi::AFTER_DRAIN) { E(acc, cur, wr, wc, fr, fq); S.done(cur); rcls = 1 + Epi::store_class(cur); }
        if (!has_next) break;
#pragma unroll
        for (int a = 0; a < 2; ++a)
#pragma unroll
            for (int b = 0; b < 2; ++b)
#pragma unroll
                for (int m = 0; m < 4; ++m)
#pragma unroll
                    for (int n = 0; n < 2; ++n) acc[a][b][m][n] = (f32x4){0.f, 0.f, 0.f, 0.f};
        cur = nxt; cA = nA; cB = nB; ++ui;
        if constexpr (ALIGN_EPI) { if (wr == 1) PG8_BAR; }
    }
    PG8_WAIT_V(0);
    if constexpr (!ALIGN_EPI) { if (wr == 0) PG8_BAR; }
    PG8_BAR;
    if constexpr (Epi::AFTER_DRAIN) { E.fused(acc, cur, wr, wc, fr, fq, lds, wid, lane); S.done(cur); }
#undef PG8_SA
#undef PG8_SB
#undef PG8_STAGE
#undef PG8_LDA
#undef PG8_LDB
#undef PG8_MMA
#undef PG8_WAIT_V
#undef PG8_WAIT_VX
#undef PG8_GLDS
#undef PG8_WAIT_L
#undef PG8_BAR
#undef PG8_SCHED
}
}

#define GAS __attribute__((address_space(1)))
#define LAS __attribute__((address_space(3)))
typedef unsigned short bf16;
typedef float f32x4 __attribute__((ext_vector_type(4)));
typedef float f32x16 __attribute__((ext_vector_type(16)));
typedef unsigned u32x4 __attribute__((ext_vector_type(4)));
typedef short bf16x8 __attribute__((ext_vector_type(8)));
typedef short s16x4 __attribute__((ext_vector_type(4)));
constexpr size_t MiB = 1u << 20;
constexpr size_t WS_SS = 960 * MiB;
constexpr size_t WS_BAR = 2 * MiB;
constexpr size_t WS_BIAS = 3 * MiB;
constexpr size_t WS_W = 4 * MiB;
constexpr size_t E_W1GU = 0, E_W1D = E_W1GU + (size_t)2 * DFF * DM, E_WIN = E_W1D + (size_t)DM * DFF, E_WOA = E_WIN + (size_t)NIN * DM, E_WOC = E_WOA + (size_t)DM * DM,
                 E_WO = E_WOC + (size_t)DM * DM, E_W2GU = E_WO + (size_t)DM * DM, E_W2D = E_W2GU + (size_t)2 * DFF * DM, E_LAYER = E_W2D + (size_t)DM * DFF;
constexpr size_t WS_XB = 116 * MiB;
constexpr size_t ACT = (size_t)MT * DM * 2;
constexpr size_t WS_Q = 246 * MiB, WS_BG = WS_Q + ACT, WS_U = WS_BG + ACT, WS_SA = WS_U + ACT, WS_SC = WS_SA + ACT, WS_KV = WS_SC + ACT, WS_END = WS_KV + (size_t)MT * 256 * 2;
constexpr size_t WS_H = WS_Q;
static_assert(WS_W + 2 * E_LAYER * 2 <= WS_XB && WS_XB + ACT <= WS_Q && WS_H + (size_t)MT * DFF * 2 <= WS_SA && WS_END <= WS_SS && WS_SS + (size_t)7 * MT * 64 <= (size_t)1024 * MiB, "d_ws map");
constexpr size_t O_YP = 0, O_YS = (size_t)MP * DM, O_KP = O_YS + (size_t)MS * DM, O_VP = O_KP + 2 * 8 * 128 * 128, O_CP = O_VP + 2 * 8 * 128 * 128, O_KS = O_CP + 2 * 8 * 2 * 1024,
                 O_VS = O_KS + 2 * 16 * 128 * 128, O_CS = O_VS + 2 * 16 * 128 * 128, O_END = O_CS + 2 * 16 * 2 * 1024;

#ifndef MK_SKIP
#define MK_SKIP 0
#endif
#ifndef MK_DUP
#define MK_DUP 0
#endif
constexpr int NWAVES = 8, NTHR = 512;
constexpr int LDS_BYTES = 139264;

struct Args {
    const float* x_prompt; const float* x_sample; const float* cache_k; const float* cache_v; const float* state_conv;
    const float* norm_ffn1; const float* w1_gate; const float* w1_up; const float* w1_down;
    const float* norm_mix; const float* w_in; const float* b_in; const float* sinks; const float* conv_w; const float* w_o_attn; const float* w_o_conv; const float* w_o;
    const float* norm_ffn2; const float* w2_gate; const float* w2_up; const float* w2_down; const float* norm_final;
    float* out; unsigned char* ws;
};

__device__ __forceinline__ const float* inp(int k) { int z = 0; asm volatile("" : "+v"(z)); z = __builtin_amdgcn_readfirstlane(z);
    return ((const float* const __attribute__((address_space(4)))*)__builtin_amdgcn_kernarg_segment_ptr())[k + z]; }
__device__ __forceinline__ float wave_sum(float v) {
#pragma unroll
    for (int o = 1; o < 64; o <<= 1) v += __shfl_xor(v, o);
    return v;
}
#define LDS_WAIT() asm volatile("s_waitcnt lgkmcnt(0)" ::: "memory")

__device__ __forceinline__ void transpose_item(const float* W, int K, int N, const float* gain, bf16* WT, int dst_row0, LAS float* scr, int k0, int n0, int lane, float cs = 1.0f) {
    float v[32];
#pragma unroll
    for (int i = 0; i < 32; ++i) v[i] = W[(size_t)(k0 + 2 * i + (lane >> 5)) * N + n0 + (lane & 31)];
    const int c = lane & 7;
    f32x4 g0 = (f32x4){1.f, 1.f, 1.f, 1.f}, g1 = g0;
    if (gain) { g0 = *(const f32x4*)(gain + k0 + 8 * c); g1 = *(const f32x4*)(gain + k0 + 8 * c + 4); }
    g0 = g0 * cs; g1 = g1 * cs;
#pragma unroll
    for (int i = 0; i < 32; ++i) scr[(2 * i + (lane >> 5)) * 33 + (lane & 31)] = v[i];
    LDS_WAIT(); asm volatile("" ::: "memory");
#pragma unroll
    for (int j = 0; j < 4; ++j) { const int n = (lane >> 3) + 8 * j; const LAS float* s = scr + (8 * c) * 33 + n;
        u32x4 o; o.x = cvtpk(s[0 * 33] * g0[0], s[1 * 33] * g0[1]); o.y = cvtpk(s[2 * 33] * g0[2], s[3 * 33] * g0[3]); o.z = cvtpk(s[4 * 33] * g1[0], s[5 * 33] * g1[1]); o.w = cvtpk(s[6 * 33] * g1[2], s[7 * 33] * g1[3]);
        *(u32x4*)(WT + (size_t)(dst_row0 + n) * K + k0 + 8 * c) = o; }
    LDS_WAIT(); asm volatile("" ::: "memory");
}
__device__ __forceinline__ int win_map(int n) {
    if (n < 2304 || n >= 4352) return n;
    if (n < 3328) { const int f = n - 2304; return 2304 + 256 * (f >> 7) + (f & 127); }
    const int f = n - 3328; return 2304 + 256 * (f >> 7) + 128 + (f & 127);
}
__device__ __forceinline__ int gu_map(int f, int up) { return 256 * (f >> 7) + 128 * up + (f & 127); }

__device__ __forceinline__ void prologue(const Args& a, LAS unsigned char* lds, int tid, int lane, int wave) {
    LAS float* scr = (LAS float*)(lds + wave * 16384);
    const int gw = blockIdx.x * NWAVES + wave, NGW = gridDim.x * NWAVES;
    bf16* Wb = (bf16*)(a.ws + WS_W);
    constexpr int I_G = 16 * 88, I_D = 44 * 32, I_IN = 16 * 200, I_O = 16 * 32, I_LAYER = 6 * I_G + I_IN + 3 * I_O;
    static_assert(I_G == I_D, "item counts");
    for (int it = gw; it < 2 * I_LAYER; it += NGW) {
        const int l = it / I_LAYER; int r = it - l * I_LAYER; bf16* Wl = Wb + (size_t)l * E_LAYER;
        if (r < 2 * I_G) { const int up = r >= I_G; if (up) r -= I_G; const int kb = r / 88, nb = r % 88;
            transpose_item((up ? inp(7) : inp(6)) + (size_t)l * DM * DFF, DM, DFF, inp(5) + l * DM, Wl + E_W1GU, gu_map(nb * 32, up), scr, kb * 64, nb * 32, lane); continue; } r -= 2 * I_G;
        if (r < I_D) { const int kb = r / 32, nb = r % 32; transpose_item(inp(8) + (size_t)l * DFF * DM, DFF, DM, nullptr, Wl + E_W1D, nb * 32, scr, kb * 64, nb * 32, lane); continue; } r -= I_D;
        if (r < I_IN) { const int kb = r / 200, nb = r % 200; transpose_item(inp(10) + (size_t)l * DM * NIN, DM, NIN, inp(9) + l * DM, Wl + E_WIN, win_map(nb * 32), scr, kb * 64, nb * 32, lane, nb * 32 < 1024 ? QSCALE : (nb * 32 >= 4352 ? -LOG2E : 1.0f)); continue; } r -= I_IN;
        if (r < 3 * I_O) { const int w = r / I_O; r -= w * I_O; const int kb = r / 32, nb = r % 32; const float* src = (w == 0 ? inp(14) : w == 1 ? inp(15) : inp(16)) + (size_t)l * DM * DM;
            transpose_item(src, DM, DM, nullptr, Wl + (w == 0 ? E_WOA : w == 1 ? E_WOC : E_WO), nb * 32, scr, kb * 64, nb * 32, lane); continue; } r -= 3 * I_O;
        if (r < 2 * I_G) { const int up = r >= I_G; if (up) r -= I_G; const int kb = r / 88, nb = r % 88;
            transpose_item((up ? inp(19) : inp(18)) + (size_t)l * DM * DFF, DM, DFF, inp(17) + l * DM, Wl + E_W2GU, gu_map(nb * 32, up), scr, kb * 64, nb * 32, lane); continue; } r -= 2 * I_G;
        { const int kb = r / 32, nb = r % 32; transpose_item(inp(20) + (size_t)l * DFF * DM, DFF, DM, nullptr, Wl + E_W2D, nb * 32, scr, kb * 64, nb * 32, lane); }
    }
    float* ss = (float*)(a.ws + WS_SS); bf16* XB = (bf16*)(a.ws + WS_XB);
    static_assert(MT % 2 == 0 && MP % 2 == 0, "row pairs");
    for (int m2 = gw; m2 < MT / 2; m2 += NGW) {
        f32x4 v[2][4];
#pragma unroll
        for (int r = 0; r < 2; ++r) { const int m = 2 * m2 + r; const float* xr = (m < MP) ? inp(0) + (size_t)m * DM : inp(1) + (size_t)(m - MP) * DM;
#pragma unroll
            for (int j = 0; j < 4; ++j) v[r][j] = ((const f32x4*)xr)[lane + 64 * j]; }
#pragma unroll
        for (int r = 0; r < 2; ++r) { const int m = 2 * m2 + r; float s = 0.f;
#pragma unroll
            for (int j = 0; j < 4; ++j) s += (v[r][j].x * v[r][j].x + v[r][j].y * v[r][j].y) + (v[r][j].z * v[r][j].z + v[r][j].w * v[r][j].w);
            s = wave_sum(s); if (lane < 16) ss[(size_t)m * 16 + lane] = (lane == 0) ? s : 0.f;
            unsigned long long* o8 = (unsigned long long*)(XB + (size_t)m * DM) + lane;
#pragma unroll
            for (int j = 0; j < 4; ++j) o8[64 * j] = (unsigned long long)cvtpk(v[r][j].x, v[r][j].y) | ((unsigned long long)cvtpk(v[r][j].z, v[r][j].w) << 32); }
    }
    const int gt = blockIdx.x * NTHR + tid, NGT = gridDim.x * NTHR;
    { unsigned* bw = (unsigned*)(a.ws + WS_BAR); for (int i = gt; i < 3456  ; i += NGT) bw[i] = 0u; }
    float* bp = (float*)(a.ws + WS_BIAS);
    bf16* bp16 = (bf16*)(a.ws + WS_BIAS + 65536);
    for (int i = gt; i < 2 * NIN; i += NGT) { const int l = i / NIN, n = i - l * NIN; const float bvl = inp(11)[i] * (n < 1024 ? QSCALE : (n >= 4352 ? -LOG2E : 1.0f)); bp[l * NIN + win_map(n)] = bvl; bp16[l * NIN + win_map(n)] = (bf16)(cvtpk(bvl, 0.f) & 0xffffu); }
}

constexpr int KS_STRIDE = 144, VT_STRIDE = 408;
constexpr int LDS_KS = 0, LDS_VT = 192 * KS_STRIDE, LDS_WSF = LDS_VT + 64 * VT_STRIDE, ATT_LDS = LDS_WSF + NWAVES * 32 * 4;
constexpr int N_ATT_ITEMS = 32 + NB * 128 * 2;
__device__ __forceinline__ int crow(int r, int hi) { return (r & 3) + 8 * (r >> 2) + 4 * hi; }

__device__ __forceinline__ void attn_item(LAS unsigned char* lds, const bf16* QI, bf16* AO, const bf16* KV, const float* ck, const float* cv, const float* sinks, int item, int tid, int lane, int wave) {
    int qrow0, nqb, blo, bhi, h, sb = 0; long kvrow0 = 0; bool sample;
    if (item < 32) { sample = true; sb = item >> 1; h = item & 1; qrow0 = MP + sb * 32; nqb = 1; blo = 0; bhi = 5; }
    else { sample = false; const int it = item - 32; h = it & 1; const int c = (it >> 1) & 127, b = it >> 8; qrow0 = b * SEQ + c * 64; nqb = 2; blo = c >= 2 ? 0 : 2 * (2 - c); bhi = 6; kvrow0 = (long)b * SEQ + (long)(c - 2) * 64; }
    const int r32 = lane & 31, hi = lane >> 5, head = h * 8 + wave;
    const bf16* qbase = QI + (size_t)(qrow0 + r32) * DM + head * 64 + hi * 8;
    bf16x8 qf[4];
#pragma unroll
    for (int d0 = 0; d0 < 4; ++d0) qf[d0] = *(const bf16x8*)(qbase + d0 * 16);
    { const int jb = tid >> 3, dg = tid & 7, tb = tid >> 8;
      u32x4 kx[3], vx[3];
#pragma unroll
      for (int i = 0; i < 3; ++i) { const int j = jb + 64 * i;
          if (tb + 2 * i >= blo && tb + 2 * i < bhi) {
              if (sample && j < 128) {
                  const size_t o = ((size_t)(sb * 128 + j)) * 128 + h * 64 + dg * 8;
                  const f32x4 k0 = *(const f32x4*)(ck + o), k1 = *(const f32x4*)(ck + o + 4), v0 = *(const f32x4*)(cv + o), v1 = *(const f32x4*)(cv + o + 4);
                  kx[i].x = cvtpk(k0[0], k0[1]); kx[i].y = cvtpk(k0[2], k0[3]); kx[i].z = cvtpk(k1[0], k1[1]); kx[i].w = cvtpk(k1[2], k1[3]);
                  vx[i].x = cvtpk(v0[0], v0[1]); vx[i].y = cvtpk(v0[2], v0[3]); vx[i].z = cvtpk(v1[0], v1[1]); vx[i].w = cvtpk(v1[2], v1[3]);
              } else {
                  const long row = sample ? (long)(MP + sb * 32 + (j - 128)) : kvrow0 + j;
                  const bf16* p = KV + (size_t)row * 256 + h * 64 + dg * 8;
                  kx[i] = *(const u32x4*)p; vx[i] = *(const u32x4*)(p + 128);
              }
          }
      }
#pragma unroll
      for (int i = 0; i < 3; ++i) { const int j = jb + 64 * i;
          if (tb + 2 * i >= blo && tb + 2 * i < bhi) {
              *(LAS u32x4*)(lds + LDS_KS + j * KS_STRIDE + dg * 16) = kx[i];
              LAS unsigned short* vt = (LAS unsigned short*)(lds + LDS_VT + (dg * 8) * VT_STRIDE + j * 2); const u32x4 v4 = vx[i];
              vt[0 * (VT_STRIDE / 2)] = (unsigned short)(v4.x & 0xffffu); vt[1 * (VT_STRIDE / 2)] = (unsigned short)(v4.x >> 16);
              vt[2 * (VT_STRIDE / 2)] = (unsigned short)(v4.y & 0xffffu); vt[3 * (VT_STRIDE / 2)] = (unsigned short)(v4.y >> 16);
              vt[4 * (VT_STRIDE / 2)] = (unsigned short)(v4.z & 0xffffu); vt[5 * (VT_STRIDE / 2)] = (unsigned short)(v4.z >> 16);
              vt[6 * (VT_STRIDE / 2)] = (unsigned short)(v4.w & 0xffffu); vt[7 * (VT_STRIDE / 2)] = (unsigned short)(v4.w >> 16);
          }
      } }
    __syncthreads();
    const float sink2 = sinks[head] * LOG2E;
    LAS float* wsf = (LAS float*)(lds + LDS_WSF) + wave * 32;
    for (int qb = 0; qb < nqb; ++qb) {
        f32x16 s[6];
#pragma unroll
        for (int kvb = 0; kvb < 6; ++kvb) {
            if (kvb >= blo && kvb < bhi) {
                f32x16 acc;
#pragma unroll
                for (int i = 0; i < 16; ++i) acc[i] = 0.f;
#pragma unroll
                for (int d0 = 0; d0 < 4; ++d0) { const bf16x8 kf = *(const LAS bf16x8*)(lds + LDS_KS + (kvb * 32 + r32) * KS_STRIDE + d0 * 32 + hi * 16);
                    acc = __builtin_amdgcn_mfma_f32_32x32x16_bf16(kf, qf[d0], acc, 0, 0, 0); }
                s[kvb] = acc;
            } else {
#pragma unroll
                for (int i = 0; i < 16; ++i) s[kvb][i] = -1e30f;
            }
        }
        if (qb + 1 < nqb) {
#pragma unroll
            for (int d0 = 0; d0 < 4; ++d0) qf[d0] = *(const bf16x8*)(qbase + (size_t)32 * DM + d0 * 16);
        }
        float mx = sink2;
#pragma unroll
        for (int kvb = 0; kvb < 6; ++kvb)
#pragma unroll
            for (int i = 0; i < 16; ++i) mx = fmaxf(mx, s[kvb][i]);
        mx = fmaxf(mx, __shfl_xor(mx, 32));
        float sum = 0.f;
#pragma unroll
        for (int kvb = 0; kvb < 6; ++kvb)
#pragma unroll
            for (int i = 0; i < 16; ++i) { const float e = __builtin_amdgcn_exp2f(s[kvb][i] - mx); s[kvb][i] = e; sum += e; }
        sum += __shfl_xor(sum, 32);
        const float l = sum + __builtin_amdgcn_exp2f(sink2 - mx);
        f32x16 o[2];
#pragma unroll
        for (int i = 0; i < 16; ++i) { o[0][i] = 0.f; o[1][i] = 0.f; }
#pragma unroll
        for (int kvb = 0; kvb < 6; ++kvb) {
            if (kvb >= blo && kvb < bhi) {
#pragma unroll
                for (int st = 0; st < 2; ++st) {
                    u32x4 pw; pw.x = cvtpk(s[kvb][8 * st + 0], s[kvb][8 * st + 1]); pw.y = cvtpk(s[kvb][8 * st + 2], s[kvb][8 * st + 3]);
                    pw.z = cvtpk(s[kvb][8 * st + 4], s[kvb][8 * st + 5]); pw.w = cvtpk(s[kvb][8 * st + 6], s[kvb][8 * st + 7]);
                    const bf16x8 pf = __builtin_bit_cast(bf16x8, pw);
#pragma unroll
                    for (int db = 0; db < 2; ++db) {
                        const LAS unsigned char* vp = lds + LDS_VT + (db * 32 + r32) * VT_STRIDE + (kvb * 32 + 16 * st + 4 * hi) * 2;
                        const s16x4 lo = *(const LAS s16x4*)vp, hh = *(const LAS s16x4*)(vp + 16);
                        const bf16x8 vf = __builtin_shufflevector(lo, hh, 0, 1, 2, 3, 4, 5, 6, 7);
                        o[db] = __builtin_amdgcn_mfma_f32_32x32x16_bf16(pf, vf, o[db], 0, 0, 0);
                    }
                }
            }
        }
        if (hi == 0) wsf[r32] = l;
        LDS_WAIT(); __builtin_amdgcn_wave_barrier(); asm volatile("" ::: "memory");
        bf16* op = AO + (size_t)(qrow0 + qb * 32) * DM + head * 64 + r32;
#pragma unroll
        for (int i = 0; i < 16; ++i) {
            const int q = crow(i, hi); const float rl = __builtin_amdgcn_rcpf(wsf[q]);
            const unsigned w0 = cvtpk(o[0][i] * rl, o[1][i] * rl);
            op[(size_t)q * DM] = (unsigned short)(w0 & 0xffffu); op[(size_t)q * DM + 32] = (unsigned short)(w0 >> 16);
        }
        LDS_WAIT(); __builtin_amdgcn_wave_barrier(); asm volatile("" ::: "memory");
    }
    __syncthreads();
}

__device__ __forceinline__ void conv_chunk(bf16* BG, const bf16* U, const float* cw, const float* st  , int chunk, int tid) {
    const int cgp = tid & 127, rsub = tid >> 7, c0 = cgp * 8;
    const int t0 = chunk * 32 + rsub * 8;
    float w[3][8];
#pragma unroll
    for (int j = 0; j < 3; ++j) { const f32x4 a = *(const f32x4*)(cw + j * DM + c0), b = *(const f32x4*)(cw + j * DM + c0 + 4);
#pragma unroll
        for (int e = 0; e < 4; ++e) { w[j][e] = a[e]; w[j][4 + e] = b[e]; } }
    float p2[8], p1[8];
    const int pos = (t0 < MP) ? (t0 & (SEQ - 1)) : ((t0 - MP) & (SSEQ - 1));
    if (pos == 0) {
        if (t0 < MP) {
#pragma unroll
            for (int e = 0; e < 8; ++e) { p2[e] = 0.f; p1[e] = 0.f; }
        } else {
            const float* s0 = st + (size_t)((t0 - MP) / SSEQ) * 2 * DM + c0;
            const f32x4 a = *(const f32x4*)s0, b = *(const f32x4*)(s0 + 4), c = *(const f32x4*)(s0 + DM), d = *(const f32x4*)(s0 + DM + 4);
#pragma unroll
            for (int e = 0; e < 4; ++e) { p2[e] = a[e]; p2[4 + e] = b[e]; p1[e] = c[e]; p1[4 + e] = d[e]; }
        }
    } else {
        const u32x4 a = *(const u32x4*)(U + (size_t)(t0 - 2) * DM + c0), b = *(const u32x4*)(U + (size_t)(t0 - 1) * DM + c0);
        p2[0] = bflo(a.x); p2[1] = bfhi(a.x); p2[2] = bflo(a.y); p2[3] = bfhi(a.y); p2[4] = bflo(a.z); p2[5] = bfhi(a.z); p2[6] = bflo(a.w); p2[7] = bfhi(a.w);
        p1[0] = bflo(b.x); p1[1] = bfhi(b.x); p1[2] = bflo(b.y); p1[3] = bfhi(b.y); p1[4] = bflo(b.z); p1[5] = bfhi(b.z); p1[6] = bflo(b.w); p1[7] = bfhi(b.w);
    }
    u32x4 ur[8], gr[8];
#pragma unroll
    for (int r = 0; r < 8; ++r) { const size_t idx = (size_t)(t0 + r) * DM + c0; ur[r] = *(const u32x4*)(U + idx); gr[r] = *(const u32x4*)(BG + idx); }
#pragma unroll
    for (int r = 0; r < 8; ++r) {
        const size_t idx = (size_t)(t0 + r) * DM + c0;
        const u32x4 uu = ur[r], gg = gr[r];
        float cu[8], g[8], o[8];
        cu[0] = bflo(uu.x); cu[1] = bfhi(uu.x); cu[2] = bflo(uu.y); cu[3] = bfhi(uu.y); cu[4] = bflo(uu.z); cu[5] = bfhi(uu.z); cu[6] = bflo(uu.w); cu[7] = bfhi(uu.w);
        g[0] = bflo(gg.x); g[1] = bfhi(gg.x); g[2] = bflo(gg.y); g[3] = bfhi(gg.y); g[4] = bflo(gg.z); g[5] = bfhi(gg.z); g[6] = bflo(gg.w); g[7] = bfhi(gg.w);
#pragma unroll
        for (int e = 0; e < 8; ++e) { o[e] = g[e] * (w[0][e] * p2[e] + w[1][e] * p1[e] + w[2][e] * cu[e]); p2[e] = p1[e]; p1[e] = cu[e]; }
        u32x4 ww; ww.x = cvtpk(o[0], o[1]); ww.y = cvtpk(o[2], o[3]); ww.z = cvtpk(o[4], o[5]); ww.w = cvtpk(o[6], o[7]);
        *(u32x4*)(BG + idx) = ww;
    }
}

__device__ __forceinline__ f32x4 bf4(const bf16* p) { const uint2 w = *(const uint2*)p; return (f32x4){bflo(w.x), bfhi(w.x), bflo(w.y), bfhi(w.y)}; }
__device__ __forceinline__ void state_copies(const Args& a, int l, const bf16* KV, const bf16* U, int gt, int NGT) {
    constexpr int N_KP = 8 * 128 * 128 / 4, N_CP = 8 * 2 * 1024 / 4, N_KS = 16 * 128 * 128 / 4, N_CS = 16 * 2 * 1024 / 4;
    constexpr int TOT = 2 * N_KP + N_CP + 2 * N_KS + N_CS;
    float* out = a.out;
    for (int i = gt; i < TOT; i += NGT) {
        int r = i;
        if (r < 2 * N_KP) { const int v = r >= N_KP; if (v) r -= N_KP; const int e = r * 4, hd = e & 127, j = (e >> 7) & 127, b = e >> 14;
            *(f32x4*)(out + (v ? O_VP : O_KP) + (size_t)l * 8 * 128 * 128 + e) = bf4(KV + (size_t)(b * SEQ + SEQ - 128 + j) * 256 + v * 128 + hd); continue; } r -= 2 * N_KP;
        if (r < N_CP) { const int e = r * 4, c = e & 1023, ii = (e >> 10) & 1, b = e >> 11;
            *(f32x4*)(out + O_CP + (size_t)l * 8 * 2 * 1024 + e) = bf4(U + (size_t)(b * SEQ + SEQ - 2 + ii) * DM + c); continue; } r -= N_CP;
        if (r < 2 * N_KS) { const int v = r >= N_KS; if (v) r -= N_KS; const int e = r * 4, hd = e & 127, j = (e >> 7) & 127, b = e >> 14;
            f32x4 val;
            if (j < 96) val = *(const f32x4*)((v ? inp(3) : inp(2)) + ((size_t)(l * 16 + b) * 128 + 32 + j) * 128 + hd);
            else val = bf4(KV + (size_t)(MP + b * SSEQ + j - 96) * 256 + v * 128 + hd);
            *(f32x4*)(out + (v ? O_VS : O_KS) + (size_t)l * 16 * 128 * 128 + e) = val; continue; } r -= 2 * N_KS;
        { const int e = r * 4, c = e & 1023, ii = (e >> 10) & 1, b = e >> 11;
            *(f32x4*)(out + O_CS + (size_t)l * 16 * 2 * 1024 + e) = bf4(U + (size_t)(MP + b * SSEQ + SSEQ - 2 + ii) * DM + c); }
    }
}

__device__ __forceinline__ int opaque_tid() { int t = threadIdx.x; asm volatile("" : "+v"(t)); return t; }

typedef float f32x4s __attribute__((ext_vector_type(4)));
__device__ __forceinline__ uint2 pack4(const f32x4s& v) { uint2 w; w.x = cvtpk(v[0], v[1]); w.y = cvtpk(v[2], v[3]); return w; }
__device__ __forceinline__ f32x4s unpack4(const uint2 w) { return (f32x4s){bflo(w.x), bfhi(w.x), bflo(w.y), bfhi(w.y)}; }

struct SEpiSwiGLU {
    bf16* H; const float* ss;
    __device__ __forceinline__ void brows(int sl, int& b0, int& b1) const { b0 = gu_map(32 * sl, 0); b1 = b0 + 128; }
    __device__ __forceinline__ void operator()(const f32x4s& c0, const f32x4s& c1, int row, int sl, int cw, int rit, int wc2, int fq, LAS float* xch) const {
        const float rs = pg8::row_rs(ss, row); f32x4s h;
#pragma unroll
        for (int e = 0; e < 4; ++e) { const float g = c0[e] * rs, u = c1[e] * rs; h[e] = g * fast_sigmoid(g) * u; }
        *(uint2*)(H + (size_t)row * DFF + 32 * sl + cw) = pack4(h);
    }
};
struct SEpiResid {
    bf16* xb; float* ssn; float scale;
    __device__ __forceinline__ void brows(int sl, int& b0, int& b1) const { b0 = 64 * sl; b1 = b0 + 32; }
    __device__ __forceinline__ void operator()(const f32x4s& c0, const f32x4s& c1, int row, int sl, int cw, int rit, int wc2, int fq, LAS float* xch) const {
        bf16* p = xb + (size_t)row * DM + 64 * sl + cw;
        const f32x4s o0 = unpack4(*(const uint2*)p) + c0 * scale, o1 = unpack4(*(const uint2*)(p + 32)) + c1 * scale;
        *(uint2*)p = pack4(o0); *(uint2*)(p + 32) = pack4(o1);
        float sq = (o0[0] * o0[0] + o0[1] * o0[1]) + (o0[2] * o0[2] + o0[3] * o0[3]) + (o1[0] * o1[0] + o1[1] * o1[1]) + (o1[2] * o1[2] + o1[3] * o1[3]);
        sq += __shfl_xor(sq, 16); sq += __shfl_xor(sq, 32);
        if (fq == 0) xch[wc2 * 64 + rit] = sq;
        __syncthreads();
        if (fq == 0 && wc2 == 0) ssn[(size_t)row * 16 + sl] = xch[rit] + xch[64 + rit];
    }
};
struct SEpiMixIn {
    const float* ss; const float* bias; bf16 *Q, *KV, *BG, *U, *SA, *SC;
    __device__ __forceinline__ void brows(int sl, int& b0, int& b1) const {
        if (sl < 36) { b0 = 64 * sl; b1 = b0 + 32; }
        else if (sl < 68) { const int f0 = 32 * (sl - 36); b0 = 2304 + 256 * (f0 >> 7) + (f0 & 127); b1 = b0 + 128; }
        else { b0 = 4352 + 64 * (sl - 68); b1 = b0 + 32; }
    }
    __device__ __forceinline__ void operator()(const f32x4s& c0, const f32x4s& c1, int row, int sl, int cw, int rit, int wc2, int fq, LAS float* xch) const {
        int b0, b1; brows(sl, b0, b1);
        bf16* dst; int ld, cb, mode; float sc = 1.f;
        if (sl < 16) { dst = Q; ld = DM; cb = 64 * sl; mode = 0; }
        else if (sl < 20) { dst = KV; ld = 256; cb = 64 * (sl - 16); mode = 0; }
        else if (sl < 36) { dst = BG; ld = DM; cb = 64 * (sl - 20); mode = 0; }
        else if (sl < 68) { dst = U; ld = DM; cb = 32 * (sl - 36); mode = 2; }
        else if (sl < 84) { dst = SA; ld = DM; cb = 64 * (sl - 68); mode = 1; }
        else { dst = SC; ld = DM; cb = 64 * (sl - 84); mode = 1; }
        const float rs = pg8::row_rs(ss, row);
        f32x4s z0 = c0 * rs + *(const f32x4s*)(bias + b0 + cw), z1 = c1 * rs + *(const f32x4s*)(bias + b1 + cw);
        bf16* p = dst + (size_t)row * ld + cb + cw;
        if (mode == 2) { *(uint2*)p = pack4(z0 * z1); }
        else {
            if (mode == 1) {
#pragma unroll
                for (int e = 0; e < 4; ++e) { z0[e] = sig_scaled(z0[e]); z1[e] = sig_scaled(z1[e]); }
            }
            *(uint2*)p = pack4(z0); *(uint2*)(p + 32) = pack4(z1);
        }
    }
};
struct SEpiGate {
    bf16* Gt; const bf16* ADD;
    __device__ __forceinline__ void brows(int sl, int& b0, int& b1) const { b0 = 64 * sl; b1 = b0 + 32; }
    __device__ __forceinline__ void operator()(const f32x4s& c0, const f32x4s& c1, int row, int sl, int cw, int rit, int wc2, int fq, LAS float* xch) const {
        const size_t idx = (size_t)row * DM + 64 * sl + cw;
        f32x4s a0 = (f32x4s){0.f, 0.f, 0.f, 0.f}, a1 = a0;
        if (ADD) { a0 = unpack4(*(const uint2*)(ADD + idx)); a1 = unpack4(*(const uint2*)(ADD + idx + 32)); }
        const f32x4s g0 = unpack4(*(const uint2*)(Gt + idx)), g1 = unpack4(*(const uint2*)(Gt + idx + 32));
        *(uint2*)(Gt + idx) = pack4(a0 + g0 * c0); *(uint2*)(Gt + idx + 32) = pack4(a1 + g1 * c1);
    }
};

template <class Epi>
__device__ __forceinline__ void sample_gemm(LAS unsigned char* lds, const bf16* A, const bf16* Bt, int K, int nslices, const Epi& E, int bx, int G) {
    const int tid = opaque_tid(), lane = tid & 63, wave = __builtin_amdgcn_readfirstlane(tid >> 6), fr = lane & 15, fq = lane >> 4, wr4 = wave >> 1, wc2 = wave & 1;
    constexpr int RS = 528;
    LAS unsigned char* As = lds; LAS unsigned char* Bs = lds + 64 * RS; LAS float* xch = (LAS float*)(lds + 2 * 64 * RS);
    const int srow = tid >> 3, sch = tid & 7, nst = K >> 8, ntasks = nslices * 8;
    const int pbx = (G % 8 == 0) ? (bx & 7) * (G >> 3) + (bx >> 3) : bx;
    for (int t = pbx; t < ntasks; t += G) {
        const int sl = t >> 3, tm = t & 7;
        int br0, br1; E.brows(sl, br0, br1);
        const bf16* ag = A + (size_t)(MP + tm * 64 + srow) * K + sch * 8;
        const bf16* bg = Bt + (size_t)((srow < 32) ? br0 + srow : br1 + (srow - 32)) * K + sch * 8;
        u32x4 ra[4], rb[4];
#pragma unroll
        for (int q = 0; q < 4; ++q) { ra[q] = *(const u32x4*)(ag + 64 * q); rb[q] = *(const u32x4*)(bg + 64 * q); }
        f32x4s c0 = (f32x4s){0.f, 0.f, 0.f, 0.f}, c1 = c0;
        for (int s = 0; s < nst; ++s) {
            __syncthreads();
#pragma unroll
            for (int q = 0; q < 4; ++q) { *(LAS u32x4*)(As + srow * RS + (sch + 8 * q) * 16) = ra[q]; *(LAS u32x4*)(Bs + srow * RS + (sch + 8 * q) * 16) = rb[q]; }
            __syncthreads();
            if (s + 1 < nst) { const int o = (s + 1) * 256;
#pragma unroll
                for (int q = 0; q < 4; ++q) { ra[q] = *(const u32x4*)(ag + o + 64 * q); rb[q] = *(const u32x4*)(bg + o + 64 * q); } }
#pragma unroll
            for (int ks = 0; ks < 8; ++ks) {
                const bf16x8 af = *(const LAS bf16x8*)(As + (wr4 * 16 + fr) * RS + ks * 64 + fq * 16);
                const bf16x8 bf0 = *(const LAS bf16x8*)(Bs + (wc2 * 16 + fr) * RS + ks * 64 + fq * 16), bf1 = *(const LAS bf16x8*)(Bs + (32 + wc2 * 16 + fr) * RS + ks * 64 + fq * 16);
                c0 = __builtin_amdgcn_mfma_f32_16x16x32_bf16(bf0, af, c0, 0, 0, 0); c1 = __builtin_amdgcn_mfma_f32_16x16x32_bf16(bf1, af, c1, 0, 0, 0);
            }
        }
        E(c0, c1, MP + tm * 64 + wr4 * 16 + fr, sl, wc2 * 16 + 4 * fq, wr4 * 16 + fr, wc2, fq, xch);
    }
    __syncthreads();
}

#define RLX_AGENT __ATOMIC_RELAXED, __HIP_MEMORY_SCOPE_AGENT
#define XB_TMO      128
#define XB_XCNT(j)  (256  + 64 * (j))
#define XB_XSUB(j)  (1280 + 64 * (j))
#define XB_XGEN(j)  (2304 + 64 * (j))
#define XB_TOP      3328
#define XB_TOPGEN   3392
#define XCD_BAR_WORDS 3456
#define XB_SPIN_CAP (1u << 18)

__device__ __forceinline__ unsigned xb_ld(unsigned* p)              { return __hip_atomic_load(p, __ATOMIC_RELAXED, __HIP_MEMORY_SCOPE_AGENT); }
__device__ __forceinline__ unsigned xb_add(unsigned* p, unsigned v) { return __hip_atomic_fetch_add(p, v, __ATOMIC_RELAXED, __HIP_MEMORY_SCOPE_AGENT); }
__device__ __forceinline__ unsigned xb_xcc_id() { return (unsigned)__builtin_amdgcn_s_getreg((3 << 11) | 20) & 0xFu; }
#define XB_SPIN(cond, bar) do { unsigned _sp = 0; while (cond) { __builtin_amdgcn_s_sleep(1); \
    if ((++_sp & 255u) == 0u) { if (xb_ld(&(bar)[XB_TMO])) break; if (_sp > XB_SPIN_CAP) { atomicAdd(&(bar)[XB_TMO], 1u); break; } } } } while (0)

struct XcdBarrier {
    unsigned* bar; unsigned x;
    volatile LAS unsigned* st;
};

__device__ __forceinline__ XcdBarrier xcd_barrier_post(unsigned* bar, volatile LAS unsigned* st) {
    XcdBarrier b; b.bar = bar; b.x = xb_xcc_id(); b.st = st;
    if (threadIdx.x == 0) (void)xb_add(&bar[XB_XCNT(b.x)], 1u);
    return b;
}
__device__ __forceinline__ void xcd_barrier_complete(unsigned* bar, unsigned x, unsigned& nloc, unsigned& nx) {
    const unsigned G = gridDim.x * gridDim.y * gridDim.z;
    unsigned sum, cnt, mine, sp = 0u;
    for (;;) {
        sum = 0u; cnt = 0u; mine = 0u;
#pragma unroll
        for (unsigned j = 0; j < 16; ++j) { const unsigned c = xb_ld(&bar[XB_XCNT(j)]); sum += c; cnt += (c > 0u) ? 1u : 0u; mine = (j == x) ? c : mine; }
        if (sum == G) break;
        __builtin_amdgcn_s_sleep(1);
        if ((++sp & 255u) == 0u) { if (xb_ld(&bar[XB_TMO])) break; if (sp > XB_SPIN_CAP) { atomicAdd(&bar[XB_TMO], 1u); break; } }
    }
    nloc = mine > 0u ? mine : 1u; nx = cnt > 0u ? cnt : 1u;
}

__device__ __forceinline__ void xcd_barrier(const XcdBarrier& b) {
    asm volatile("s_waitcnt vmcnt(0)" ::: "memory");
    __syncthreads();
    if (threadIdx.x == 0) {
        unsigned* bar = b.bar;
        __builtin_amdgcn_s_waitcnt(0);
        unsigned nloc = b.st[0], nx = b.st[1];
        if (nloc == 0u) { xcd_barrier_complete(bar, b.x, nloc, nx); b.st[0] = nloc; b.st[1] = nx; }
        const unsigned old = xb_add(&bar[XB_XSUB(b.x)], 1u);
        const unsigned gen = old / nloc;
        if (old + 1u == (gen + 1u) * nloc) {
            __builtin_amdgcn_fence(__ATOMIC_RELEASE, "agent");
            asm volatile("s_waitcnt vmcnt(0)" ::: "memory");
            const unsigned og = xb_add(&bar[XB_TOP], 1u);
            const unsigned tg = og / nx;
            if (og + 1u == (tg + 1u) * nx) xb_add(&bar[XB_TOPGEN], 1u);
            else XB_SPIN(xb_ld(&bar[XB_TOPGEN]) == tg, bar);
            __builtin_amdgcn_fence(__ATOMIC_ACQUIRE, "agent");
            xb_add(&bar[XB_XGEN(b.x)], 1u);
            asm volatile("s_waitcnt vmcnt(0)" ::: "memory");
        } else {
            XB_SPIN(xb_ld(&bar[XB_XGEN(b.x)]) == gen, bar);
            __builtin_amdgcn_fence(__ATOMIC_ACQUIRE, "agent");
            asm volatile("s_waitcnt vmcnt(0)" ::: "memory");
        }
    }
    __syncthreads();
}

#ifndef MK_REV
#define MK_REV 1
#endif
#ifndef MK_SP2
#define MK_SP2 true
#endif
#ifndef MK_ALIGN
#define MK_ALIGN true
#endif
#ifndef MK_STAGGER
#define MK_STAGGER 0
#endif
__device__ __forceinline__ void stagger(int bx) { const unsigned lvl = (unsigned)(bx >> 3) & 3u; if (MK_STAGGER > 0 && lvl) { const unsigned long long t0 = __builtin_amdgcn_s_memrealtime(); while (__builtin_amdgcn_s_memrealtime() - t0 < (unsigned long long)(lvl * MK_STAGGER)) __builtin_amdgcn_s_sleep(4); } }
__global__ void __launch_bounds__(NTHR, 2) fwd_megakernel(Args a) {
    extern __shared__ __attribute__((aligned(16))) unsigned char lds_raw[];
    LAS unsigned char* lds = (LAS unsigned char*)lds_raw;
    cg::grid_group grid = cg::this_grid();
    volatile LAS unsigned* bar_st = (volatile LAS unsigned*)(lds + 131072 + 64);
    if (threadIdx.x < 2) bar_st[threadIdx.x] = 0u;
    __syncthreads();
    const int G = gridDim.x, bx = blockIdx.x;
#define ws ((unsigned char*)inp(23))
#define ss ((float*)(ws + WS_SS))
#define XB ((bf16*)(ws + WS_XB))
#define H ((bf16*)(ws + WS_H))
#define Q ((bf16*)(ws + WS_Q))
#define BG ((bf16*)(ws + WS_BG))
#define U ((bf16*)(ws + WS_U))
#define SA ((bf16*)(ws + WS_SA))
#define SC ((bf16*)(ws + WS_SC))
#define KV ((bf16*)(ws + WS_KV))
#define xout ((float*)inp(22))

#if !(MK_SKIP & 1)
    { const int tid = opaque_tid(), lane = tid & 63, wave = __builtin_amdgcn_readfirstlane(tid >> 6); prologue(a, lds, tid, lane, wave);
      if (MK_DUP & 1) { __syncthreads(); prologue(a, lds, tid, lane, wave); } }
#endif
    grid.sync();
    const XcdBarrier bar = xcd_barrier_post((unsigned*)(ws + WS_BAR), bar_st);

#pragma nounroll
    for (int l = 0; l < 2; ++l) {
        const bf16* Wl = (const bf16*)(ws + WS_W) + (size_t)l * E_LAYER;
#if !(MK_SKIP & 2)
        { SEpiSwiGLU SE{H, ss + (size_t)(3 * l) * MT * 16}; sample_gemm(lds, XB, Wl + E_W1GU, DM, DFF / 32, SE, bx, G);
          pg8::Gemm g{XB, Wl + E_W1GU, MP, 2 * DFF, DM}; pg8::StaticOrder S; S.init(MP, 2 * DFF, G, bx); pg8::EpiSwiGLU E{H, ss + (size_t)(3 * l) * MT * 16, (LAS float*)(lds + 131072 + 1024)};
          stagger(bx);
          pg8::gemm_phase<pg8::EpiSwiGLU, pg8::StaticOrder, MK_ALIGN, MK_SP2>(lds, g, S, E);
          if (MK_DUP & 2) pg8::gemm_phase<pg8::EpiSwiGLU, pg8::StaticOrder, MK_ALIGN, MK_SP2>(lds, g, S, E); }
#endif
        xcd_barrier(bar);
        if (MK_DUP & 8) xcd_barrier(bar);
#if !(MK_SKIP & 4)
        { SEpiResid SE{XB, ss + (size_t)(3 * l + 1) * MT * 16, 0.5f}; sample_gemm(lds, H, Wl + E_W1D, DFF, DM / 64, SE, bx, G);
          pg8::Gemm g{H, Wl + E_W1D, MP, DM, DFF}; pg8::StaticOrder S; S.init(MP, DM, G, bx, MK_REV);
          pg8::EpiResid E{XB, ss + (size_t)(3 * l + 1) * MT * 16, (MK_DUP & 32) ? 0.25f : 0.5f};
          stagger(bx);
          pg8::gemm_phase<pg8::EpiResid, pg8::StaticOrder, MK_ALIGN, MK_SP2>(lds, g, S, E);
          if (MK_DUP & 32) pg8::gemm_phase<pg8::EpiResid, pg8::StaticOrder, MK_ALIGN, MK_SP2>(lds, g, S, E); }
#endif
        xcd_barrier(bar);
        if (MK_DUP & 8) xcd_barrier(bar);
#if !(MK_SKIP & 8)
        { SEpiMixIn SE{ss + (size_t)(3 * l + 1) * MT * 16, (const float*)(ws + WS_BIAS) + l * NIN, Q, KV, BG, U, SA, SC}; sample_gemm(lds, XB, Wl + E_WIN, DM, 100, SE, bx, G);
          pg8::Gemm g{XB, Wl + E_WIN, MP, NIN, DM}; pg8::StaticOrder S; S.init(MP, NIN, G, bx);
          pg8::EpiMixIn E{ss + (size_t)(3 * l + 1) * MT * 16, (const bf16*)(ws + WS_BIAS + 65536) + l * NIN, Q, KV, BG, U, SA, SC, (LAS float*)(lds + 131072 + 1024)};
          stagger(bx);
          pg8::gemm_phase<pg8::EpiMixIn, pg8::StaticOrder, MK_ALIGN, MK_SP2>(lds, g, S, E);
          if (MK_DUP & 16) pg8::gemm_phase<pg8::EpiMixIn, pg8::StaticOrder, MK_ALIGN, MK_SP2>(lds, g, S, E); }
#endif
        xcd_barrier(bar);
        if (MK_DUP & 8) xcd_barrier(bar);
#if !(MK_SKIP & 16)
        { const int tid = opaque_tid(), lane = tid & 63, wave = __builtin_amdgcn_readfirstlane(tid >> 6);
          const float* ck = inp(2) + (size_t)l * 16 * 128 * 128; const float* cv = inp(3) + (size_t)l * 16 * 128 * 128;
          const bool conv_first = ((bx >> 3) & 1) != 0;
          if (conv_first) for (int ch = (bx + 224) % G; ch < MT / 32; ch += G) conv_chunk(BG, U, inp(13) + (size_t)l * 3 * DM, inp(4) + (size_t)l * 16 * 2 * DM, MT / 32 - 1 - ch, tid);
          for (int it = bx; it < N_ATT_ITEMS; it += G) attn_item(lds, Q, Q, KV, ck, cv, inp(12) + l * 16, N_ATT_ITEMS - 1 - it, tid, lane, wave);
          if (!conv_first) for (int ch = (bx + 224) % G; ch < MT / 32; ch += G) conv_chunk(BG, U, inp(13) + (size_t)l * 3 * DM, inp(4) + (size_t)l * 16 * 2 * DM, MT / 32 - 1 - ch, tid);
          state_copies(a, l, KV, U, bx * NTHR + tid, G * NTHR); }
#endif
        xcd_barrier(bar);
        if (MK_DUP & 8) xcd_barrier(bar);
#if !(MK_SKIP & 32)
        { SEpiGate SE{SA, nullptr}; sample_gemm(lds, Q, Wl + E_WOA, DM, DM / 64, SE, bx, G);
          pg8::Gemm g{Q, Wl + E_WOA, MP, DM, DM}; pg8::StaticOrder S; S.init(MP, DM, G, bx); pg8::EpiGate E{SA, nullptr};
          stagger(bx);
          pg8::gemm_phase<pg8::EpiGate, pg8::StaticOrder, MK_ALIGN, MK_SP2>(lds, g, S, E); }
        { SEpiGate SE{SC, SA}; sample_gemm(lds, BG, Wl + E_WOC, DM, DM / 64, SE, bx, G);
          pg8::Gemm g{BG, Wl + E_WOC, MP, DM, DM}; pg8::StaticOrder S; S.init(MP, DM, G, bx); pg8::EpiGate E{SC, SA};
          stagger(bx);
          pg8::gemm_phase<pg8::EpiGate, pg8::StaticOrder, MK_ALIGN, MK_SP2>(lds, g, S, E); }
#endif
        xcd_barrier(bar);
        if (MK_DUP & 8) xcd_barrier(bar);
#if !(MK_SKIP & 64)
        { SEpiResid SE{XB, ss + (size_t)(3 * l + 2) * MT * 16, 1.0f}; sample_gemm(lds, SC, Wl + E_WO, DM, DM / 64, SE, bx, G);
          pg8::Gemm g{SC, Wl + E_WO, MP, DM, DM}; pg8::StaticOrder S; S.init(MP, DM, G, bx, MK_REV);
          pg8::EpiResid E{XB, ss + (size_t)(3 * l + 2) * MT * 16, 1.0f};
          stagger(bx);
          pg8::gemm_phase<pg8::EpiResid, pg8::StaticOrder, MK_ALIGN, MK_SP2>(lds, g, S, E); }
#endif
        xcd_barrier(bar);
        if (MK_DUP & 8) xcd_barrier(bar);
#if !(MK_SKIP & 128)
        { SEpiSwiGLU SE{H, ss + (size_t)(3 * l + 2) * MT * 16}; sample_gemm(lds, XB, Wl + E_W2GU, DM, DFF / 32, SE, bx, G);
          pg8::Gemm g{XB, Wl + E_W2GU, MP, 2 * DFF, DM}; pg8::StaticOrder S; S.init(MP, 2 * DFF, G, bx); pg8::EpiSwiGLU E{H, ss + (size_t)(3 * l + 2) * MT * 16, (LAS float*)(lds + 131072 + 1024)};
          stagger(bx);
          pg8::gemm_phase<pg8::EpiSwiGLU, pg8::StaticOrder, MK_ALIGN, MK_SP2>(lds, g, S, E); }
#endif
        xcd_barrier(bar);
        if (MK_DUP & 8) xcd_barrier(bar);
#if !(MK_SKIP & 256)
        { SEpiResid SE{XB, ss + (size_t)(3 * l + 3) * MT * 16, 0.5f}; sample_gemm(lds, H, Wl + E_W2D, DFF, DM / 64, SE, bx, G);
          pg8::Gemm g{H, Wl + E_W2D, MP, DM, DFF}; pg8::StaticOrder S; S.init(MP, DM, G, bx, MK_REV);
          pg8::EpiResid E{XB, ss + (size_t)(3 * l + 3) * MT * 16, 0.5f};
          stagger(bx);
          pg8::gemm_phase<pg8::EpiResid, pg8::StaticOrder, MK_ALIGN, MK_SP2>(lds, g, S, E); }
#endif
        xcd_barrier(bar);
        if (MK_DUP & 8) xcd_barrier(bar);
    }
    { const int tid = opaque_tid(), lane = tid & 63, wave = __builtin_amdgcn_readfirstlane(tid >> 6);
      const int gw = bx * NWAVES + wave, NGW = G * NWAVES; const float* ssf = ss + (size_t)6 * MT * 16;
      f32x4 gv[4];
#pragma unroll
      for (int j = 0; j < 4; ++j) gv[j] = ((const f32x4*)inp(21))[lane + 64 * j];
      for (int m2 = gw; m2 < MT / 2; m2 += NGW) {
          uint2 w[2][4]; float rs[2];
#pragma unroll
          for (int r = 0; r < 2; ++r) { const int m = 2 * m2 + r; rs[r] = pg8::row_rs(ssf, m); const uint2* xr = (const uint2*)(XB + (size_t)m * DM);
#pragma unroll
              for (int j = 0; j < 4; ++j) w[r][j] = xr[lane + 64 * j]; }
#pragma unroll
          for (int r = 0; r < 2; ++r) { f32x4* yr = (f32x4*)(xout + (size_t)(2 * m2 + r) * DM);
#pragma unroll
              for (int j = 0; j < 4; ++j) { const f32x4 v = (f32x4){bflo(w[r][j].x), bfhi(w[r][j].x), bflo(w[r][j].y), bfhi(w[r][j].y)}; yr[lane + 64 * j] = v * rs[r] * gv[j]; } } } }
}

#undef ws
#undef ss
#undef XB
#undef H
#undef Q
#undef BG
#undef U
#undef SA
#undef SC
#undef KV
#undef xout
extern "C" void kernel_launch(void* const* d_in, const int* in_sizes, int n_in, void* d_out, int out_size, void* d_ws, size_t ws_size, hipStream_t stream) {
    static int grid = 0;
    if (grid == 0) {
        if (n_in != 22 || in_sizes[0] != MP * DM || (size_t)out_size != O_END || ws_size < WS_SS + (size_t)7 * MT * 64) { fprintf(stderr, "kernel_launch: unexpected shapes (n_in %d, in0 %d, out %d, ws %zu)\n", n_in, n_in > 0 ? in_sizes[0] : -1, out_size, ws_size); grid = -1; return; }
        int dev = 0, cus = 0, per_cu = 0;
        hipGetDevice(&dev); hipDeviceGetAttribute(&cus, hipDeviceAttributeMultiprocessorCount, dev);
        if (hipFuncSetAttribute((const void*)fwd_megakernel, hipFuncAttributeMaxDynamicSharedMemorySize, LDS_BYTES) != hipSuccess) { fprintf(stderr, "kernel_launch: hipFuncSetAttribute failed\n"); grid = -1; return; }
        if (hipOccupancyMaxActiveBlocksPerMultiprocessor(&per_cu, (const void*)fwd_megakernel, NTHR, LDS_BYTES) != hipSuccess || per_cu < 1) { fprintf(stderr, "kernel_launch: occupancy query says %d\n", per_cu); per_cu = 1; }
        (void)hipGetLastError();
        grid = cus;
    }
    if (grid < 0) return;
    Args a{};
    a.x_prompt = (const float*)d_in[0]; a.x_sample = (const float*)d_in[1]; a.cache_k = (const float*)d_in[2]; a.cache_v = (const float*)d_in[3]; a.state_conv = (const float*)d_in[4];
    a.norm_ffn1 = (const float*)d_in[5]; a.w1_gate = (const float*)d_in[6]; a.w1_up = (const float*)d_in[7]; a.w1_down = (const float*)d_in[8];
    a.norm_mix = (const float*)d_in[9]; a.w_in = (const float*)d_in[10]; a.b_in = (const float*)d_in[11]; a.sinks = (const float*)d_in[12]; a.conv_w = (const float*)d_in[13];
    a.w_o_attn = (const float*)d_in[14]; a.w_o_conv = (const float*)d_in[15]; a.w_o = (const float*)d_in[16];
    a.norm_ffn2 = (const float*)d_in[17]; a.w2_gate = (const float*)d_in[18]; a.w2_up = (const float*)d_in[19]; a.w2_down = (const float*)d_in[20]; a.norm_final = (const float*)d_in[21];
    a.out = (float*)d_out; a.ws = (unsigned char*)d_ws;
    void* args[] = {&a};
    hipError_t e = hipLaunchCooperativeKernel((const void*)fwd_megakernel, dim3(grid), dim3(NTHR), args, LDS_BYTES, stream);
    if (e != hipSuccess) fprintf(stderr, "kernel_launch: cooperative launch failed: %s (grid %d)\n", hipGetErrorString(e), grid);
}
```
